# Optimizing an MI355X kernel written in HIP

```python
import math
import jax, jax.numpy as jnp
from jax import lax
import numpy as np

D_MODEL = 1024
BATCH = 8
SEQ = 4096
DEPTH = 2

D_RNN = 1024
RG_BLOCKS = 4
RG_BW = D_RNN // RG_BLOCKS
CONV_W = 4
RG_C = 8.0
N_HEADS = 16
N_KV = 4
HEAD_DIM = 64
HPG = N_HEADS // N_KV
CMP_LEN = 32
CMP_STRIDE = 16
CMP_HID = 256
SEL_LEN = 64
SEL_TOPN = 16
WINDOW = 512
Q_BLK = 64
D_FF = -(-8 * D_MODEL // (3 * 256)) * 256
EPS = 1e-6
FORCE_SCORE = 1e6

Q_W = N_HEADS * HEAD_DIM
KV_W = N_KV * HEAD_DIM
IN_SPLITS = (D_RNN, D_RNN, Q_W, KV_W, KV_W, KV_W, KV_W, KV_W, KV_W, 3 * N_HEADS, 2 * D_MODEL)
D_IN = sum(IN_SPLITS)

kernel_name = "hawk_nsa_parallel_gated_hybrid"


def rmsnorm(x, g):
    xf = x.astype(jnp.float32)
    y = xf * lax.rsqrt(jnp.mean(xf * xf, axis=-1, keepdims=True) + EPS)
    return (y * g.astype(jnp.float32)).astype(x.dtype)


def masked_softmax(s, mask):
    s = jnp.where(mask, s.astype(jnp.float32), -1e30)
    m = jnp.max(s, axis=-1, keepdims=True)
    e = jnp.where(mask, jnp.exp(s - m), 0.0)
    return e / jnp.maximum(jnp.sum(e, axis=-1, keepdims=True), 1e-30)


def causal_conv(x, w, b):
    S = x.shape[1]
    xp = jnp.pad(x, ((0, 0), (CONV_W - 1, 0), (0, 0)))
    y = b
    for k in range(CONV_W):
        y = y + xp[:, k:k + S] * w[k]
    return y


def rg_lru(x, w_a, b_a, w_i, b_i, lam):
    B, S, _ = x.shape
    xb = x.reshape(B, S, RG_BLOCKS, RG_BW)
    r = jax.nn.sigmoid((jnp.einsum('bsnc,ncd->bsnd', xb, w_a).reshape(B, S, D_RNN) + b_a).astype(jnp.float32))
    i = jax.nn.sigmoid((jnp.einsum('bsnc,ncd->bsnd', xb, w_i).reshape(B, S, D_RNN) + b_i).astype(jnp.float32))
    log_a = -RG_C * r * jax.nn.softplus(-lam.astype(jnp.float32))
    a = jnp.exp(log_a)
    mult = jnp.sqrt(-jnp.expm1(2.0 * log_a))
    mult = jnp.where(jnp.arange(S)[None, :, None] == 0, 1.0, mult)
    u = mult * i * x.astype(jnp.float32)

    def comb(c1, c2):
        a1, b1 = c1
        a2, b2 = c2
        return a1 * a2, a2 * b1 + b2

    _, h = lax.associative_scan(comb, (a, u), axis=1)
    return h.astype(x.dtype)


def compress(kv, pos, w1, w2):
    B, S, G, dh = kv.shape
    n_c = (S - CMP_LEN) // CMP_STRIDE + 1
    idx = jnp.arange(n_c)[:, None] * CMP_STRIDE + jnp.arange(CMP_LEN)[None, :]
    blk = kv[:, idx] + pos[None, None, :, None, :]
    blk = blk.transpose(0, 1, 3, 2, 4).reshape(B, n_c, G, CMP_LEN * dh)
    return jax.nn.gelu(blk @ w1) @ w2


def nsa(q, kc, vc, k_slc, v_slc, k_win, v_win, gates):
    B, S = q.shape[0], q.shape[1]
    n_c = kc.shape[1]
    n_sel = S // SEL_LEN
    topn = min(SEL_TOPN, n_sel)
    scale = HEAD_DIM ** -0.5
    cmp_end = jnp.arange(n_c) * CMP_STRIDE + CMP_LEN - 1
    cs = jnp.arange(n_c) * CMP_STRIDE
    ss = jnp.arange(n_sel) * SEL_LEN
    overlap = ((cs[:, None] < ss[None, :] + SEL_LEN) & (cs[:, None] + CMP_LEN > ss[None, :])).astype(jnp.float32)
    ksb = k_slc.reshape(B, n_sel, SEL_LEN, N_KV, HEAD_DIM).transpose(0, 3, 1, 2, 4)
    vsb = v_slc.reshape(B, n_sel, SEL_LEN, N_KV, HEAD_DIM).transpose(0, 3, 1, 2, 4)
    kwp = jnp.pad(k_win, ((0, 0), (WINDOW, 0), (0, 0), (0, 0)))
    vwp = jnp.pad(v_win, ((0, 0), (WINDOW, 0), (0, 0), (0, 0)))
    bi = jnp.arange(B)[:, None, None]
    gi = jnp.arange(N_KV)[None, :, None]
    blk_ids = jnp.arange(n_sel)

    def q_block(qi):
        s0 = qi * Q_BLK
        tpos = s0 + jnp.arange(Q_BLK)
        qb = lax.dynamic_slice_in_dim(q, s0, Q_BLK, axis=1).reshape(B, Q_BLK, N_KV, HPG, HEAD_DIM)
        gb = lax.dynamic_slice_in_dim(gates, s0, Q_BLK, axis=1).reshape(B, Q_BLK, 3, N_KV, HPG)[..., None]
        s_c = jnp.einsum('bqgjd,bcgd->bqgjc', qb, kc) * scale
        mask_c = (cmp_end[None, :] <= tpos[:, None])[None, :, None, None, :]
        p_c = masked_softmax(s_c, mask_c)
        o_c = jnp.einsum('bqgjc,bcgd->bqgjd', p_c.astype(vc.dtype), vc)
        imp = jnp.einsum('bqgjc,cn->bqgn', p_c, overlap)
        cur = tpos // SEL_LEN
        valid = blk_ids[None, :] <= cur[:, None]
        forced = (blk_ids[None, :] == 0) | (blk_ids[None, :] == cur[:, None]) | (blk_ids[None, :] == cur[:, None] - 1)
        score = jnp.where(forced[None, :, None, :], FORCE_SCORE, imp)
        score = jnp.where(valid[None, :, None, :], score, -1.0)
        top_v, top_i = lax.top_k(score, topn)
        sel_ok = top_v >= 0.0
        idx_t = top_i.transpose(0, 2, 1, 3).reshape(B, N_KV, Q_BLK * topn)
        ksel = ksb[bi, gi, idx_t].reshape(B, N_KV, Q_BLK, topn * SEL_LEN, HEAD_DIM)
        vsel = vsb[bi, gi, idx_t].reshape(B, N_KV, Q_BLK, topn * SEL_LEN, HEAD_DIM)
        kpos = top_i[..., None] * SEL_LEN + jnp.arange(SEL_LEN)
        mask_s = ((kpos <= tpos[None, :, None, None, None]) & sel_ok[..., None]).reshape(B, Q_BLK, N_KV, topn * SEL_LEN)
        s_s = jnp.einsum('bqgjd,bgqkd->bqgjk', qb, ksel) * scale
        p_s = masked_softmax(s_s, mask_s[:, :, :, None, :])
        o_s = jnp.einsum('bqgjk,bgqkd->bqgjd', p_s.astype(vsel.dtype), vsel)
        kw = lax.dynamic_slice_in_dim(kwp, s0, WINDOW + Q_BLK, axis=1)
        vw = lax.dynamic_slice_in_dim(vwp, s0, WINDOW + Q_BLK, axis=1)
        kp = s0 - WINDOW + jnp.arange(WINDOW + Q_BLK)
        mask_w = (kp[None, :] <= tpos[:, None]) & (tpos[:, None] - kp[None, :] < WINDOW) & (kp[None, :] >= 0)
        s_w = jnp.einsum('bqgjd,bkgd->bqgjk', qb, kw) * scale
        p_w = masked_softmax(s_w, mask_w[None, :, None, None, :])
        o_w = jnp.einsum('bqgjk,bkgd->bqgjd', p_w.astype(vw.dtype), vw)
        o = gb[:, :, 0] * o_c + gb[:, :, 1] * o_s + gb[:, :, 2] * o_w
        return o.reshape(B, Q_BLK, Q_W)

    out = lax.map(q_block, jnp.arange(S // Q_BLK))
    return out.transpose(1, 0, 2, 3).reshape(B, S, Q_W)


def setup_inputs(seed: int = 0) -> dict:
    key = jax.random.key(seed)
    ks = jax.random.split(key, 32)
    f32 = jnp.float32
    L = DEPTH

    def nrm(k, shape, fan_in):
        return jax.random.normal(k, shape, f32) * (fan_in ** -0.5)

    a0 = jax.random.uniform(ks[8], (L, D_RNN), f32, 0.9, 0.999)
    return {
        "x": jax.random.normal(ks[0], (BATCH, SEQ, D_MODEL), f32),
        "norm1": 1.0 + 0.02 * jax.random.normal(ks[1], (L, D_MODEL), f32),
        "w_in": nrm(ks[2], (L, D_MODEL, D_IN), D_MODEL),
        "conv_w": nrm(ks[3], (L, CONV_W, D_RNN), CONV_W),
        "conv_b": 0.01 * jax.random.normal(ks[4], (L, D_RNN), f32),
        "rg_wa": nrm(ks[5], (L, RG_BLOCKS, RG_BW, RG_BW), RG_BW),
        "rg_ba": 0.01 * jax.random.normal(ks[6], (L, D_RNN), f32),
        "rg_wi": nrm(ks[7], (L, RG_BLOCKS, RG_BW, RG_BW), RG_BW),
        "rg_bi": 0.01 * jax.random.normal(ks[9], (L, D_RNN), f32),
        "rg_lambda": jnp.log(a0) - jnp.log1p(-a0),
        "q_norm": 1.0 + 0.02 * jax.random.normal(ks[10], (L, HEAD_DIM), f32),
        "k_norm": 1.0 + 0.02 * jax.random.normal(ks[11], (L, 3, HEAD_DIM), f32),
        "cmp_pos_k": 0.02 * jax.random.normal(ks[12], (L, CMP_LEN, HEAD_DIM), f32),
        "cmp_pos_v": 0.02 * jax.random.normal(ks[13], (L, CMP_LEN, HEAD_DIM), f32),
        "cmp_k_w1": nrm(ks[14], (L, CMP_LEN * HEAD_DIM, CMP_HID), CMP_LEN * HEAD_DIM),
        "cmp_k_w2": nrm(ks[15], (L, CMP_HID, HEAD_DIM), CMP_HID),
        "cmp_v_w1": nrm(ks[16], (L, CMP_LEN * HEAD_DIM, CMP_HID), CMP_LEN * HEAD_DIM),
        "cmp_v_w2": nrm(ks[17], (L, CMP_HID, HEAD_DIM), CMP_HID),
        "w_rg_out": nrm(ks[18], (L, D_RNN, D_MODEL), D_RNN),
        "w_nsa_out": nrm(ks[19], (L, Q_W, D_MODEL), Q_W),
        "w_o": nrm(ks[20], (L, D_MODEL, D_MODEL), D_MODEL),
        "norm2": 1.0 + 0.02 * jax.random.normal(ks[21], (L, D_MODEL), f32),
        "w_gate": nrm(ks[22], (L, D_MODEL, D_FF), D_MODEL),
        "w_up": nrm(ks[23], (L, D_MODEL, D_FF), D_MODEL),
        "w_down": nrm(ks[24], (L, D_FF, D_MODEL), D_FF),
    }


def reference(x, norm1, w_in, conv_w, conv_b, rg_wa, rg_ba, rg_wi, rg_bi, rg_lambda, q_norm, k_norm,
              cmp_pos_k, cmp_pos_v, cmp_k_w1, cmp_k_w2, cmp_v_w1, cmp_v_w2, w_rg_out, w_nsa_out, w_o,
              norm2, w_gate, w_up, w_down):
    B, S, _ = x.shape
    bounds = np.cumsum((0,) + IN_SPLITS)
    for l in range(DEPTH):
        h = rmsnorm(x, norm1[l])
        z = h @ w_in[l]
        (z_rx, z_ry, z_q, z_kc, z_vc, z_ks, z_vs, z_kw, z_vw, z_ng, z_mg) = [
            z[..., int(bounds[i]):int(bounds[i + 1])] for i in range(len(IN_SPLITS))]
        xr = causal_conv(z_rx, conv_w[l], conv_b[l])
        xr = rg_lru(xr, rg_wa[l], rg_ba[l], rg_wi[l], rg_bi[l], rg_lambda[l])
        y_a = (xr * jax.nn.gelu(z_ry)) @ w_rg_out[l]
        kvs = lambda t: t.reshape(B, S, N_KV, HEAD_DIM)
        q = rmsnorm(z_q.reshape(B, S, N_HEADS, HEAD_DIM), q_norm[l])
        kc = rmsnorm(compress(kvs(z_kc), cmp_pos_k[l], cmp_k_w1[l], cmp_k_w2[l]), k_norm[l, 0])
        vc = compress(kvs(z_vc), cmp_pos_v[l], cmp_v_w1[l], cmp_v_w2[l])
        k_s = rmsnorm(kvs(z_ks), k_norm[l, 1])
        k_w = rmsnorm(kvs(z_kw), k_norm[l, 2])
        ng = jax.nn.sigmoid(z_ng).reshape(B, S, 3, N_HEADS)
        y_b = nsa(q, kc, vc, k_s, kvs(z_vs), k_w, kvs(z_vw), ng) @ w_nsa_out[l]
        mg = jax.nn.sigmoid(z_mg).reshape(B, S, 2, D_MODEL)
        x = x + (mg[:, :, 0] * y_a + mg[:, :, 1] * y_b) @ w_o[l]
        h2 = rmsnorm(x, norm2[l])
        x = x + (jax.nn.silu(h2 @ w_gate[l]) * (h2 @ w_up[l])) @ w_down[l]
    return x
```

```cpp
#include <hip/hip_runtime.h>
#include <hip/hip_cooperative_groups.h>
#include <cstdio>
#include <cstdint>
namespace cg = cooperative_groups;

#ifndef PROBE_SYNC2
#define PROBE_SYNC2 0
#endif
#ifndef PROBE_DUP
#define PROBE_DUP 0
#endif
#ifndef MK_MULTI
#define MK_MULTI 0
#endif

#define LAS __attribute__((address_space(3)))
typedef unsigned short bf16_t;
typedef short bf16x8 __attribute__((ext_vector_type(8)));
typedef short s16x4 __attribute__((ext_vector_type(4)));
typedef float f32x2 __attribute__((ext_vector_type(2)));
typedef float f32x4 __attribute__((ext_vector_type(4)));
typedef float f32x16 __attribute__((ext_vector_type(16)));
typedef unsigned u32x2 __attribute__((ext_vector_type(2)));
typedef unsigned u32x4 __attribute__((ext_vector_type(4)));
typedef __bf16 bf16x2_t __attribute__((ext_vector_type(2)));

constexpr int DM = 1024, NB = 8, SEQ = 4096, MTOK = NB * SEQ, DEPTH = 2;
constexpr int D_IN = 6704, D_FF = 2816;
constexpr float EPS = 1e-6f;
constexpr float LOG2E = 1.4426950408889634f;
constexpr float QSCALE = 0.125f * LOG2E;

constexpr size_t MiB = 1u << 20;
constexpr size_t WS_CTL = 0;
constexpr size_t WS_BAR = 65536;
constexpr size_t WS_W = 1 * MiB;
constexpr size_t W_INA = 0, W_INB = 4 * MiB, W_G = 14 * MiB, W_C1 = 15 * MiB, W_YA = 17 * MiB, W_YB = 19 * MiB, W_O = 21 * MiB, W_GU = 23 * MiB, W_D = 34 * MiB;
constexpr size_t WS_H = 41 * MiB;
constexpr size_t WS_RX = 105 * MiB;
constexpr size_t WS_XR = 169 * MiB;
constexpr size_t WS_LA = 233 * MiB;
constexpr size_t WS_U = 297 * MiB;
constexpr size_t WS_YO = 361 * MiB;
constexpr size_t WS_NG = 489 * MiB;
constexpr size_t WS_HID = 497 * MiB;
constexpr size_t WS_KC = 505 * MiB;
constexpr size_t WS_VC = 506 * MiB;
constexpr size_t WS_AGG = 507 * MiB;
constexpr size_t WS_END = 511 * MiB;
constexpr size_t KVBUF = (size_t)32 * 4096 * 64;

__device__ __forceinline__ int bx_opq() { int t = blockIdx.x; asm volatile("" : "+s"(t)); return t; }
__device__ __forceinline__ int gd_opq() { int t = gridDim.x; asm volatile("" : "+s"(t)); return t; }
__device__ __forceinline__ int tid_opq() { int t = threadIdx.x; asm volatile("" : "+v"(t)); return t; }
__device__ __forceinline__ unsigned pk_bf16(float lo, float hi) { f32x2 v = {lo, hi}; bf16x2_t b = __builtin_convertvector(v, bf16x2_t); return __builtin_bit_cast(unsigned, b); }
__device__ __forceinline__ float bf_lo(unsigned w) { return __uint_as_float(w << 16); }
__device__ __forceinline__ float bf_hi(unsigned w) { return __uint_as_float(w & 0xffff0000u); }
__device__ __forceinline__ float ex2(float x) { return __builtin_amdgcn_exp2f(x); }
__device__ __forceinline__ float sigm(float x) { return __builtin_amdgcn_rcpf(1.f + ex2(-LOG2E * x)); }
__device__ __forceinline__ float gelu_t(float x) { const float y = 1.5957691216057308f * (x + 0.044715f * x * x * x); return x * sigm(y); }
__device__ __forceinline__ float wave_sum(float v) {
#pragma unroll
    for (int o = 1; o < 64; o <<= 1) v += __shfl_xor(v, o);
    return v;
}
__device__ __forceinline__ float wave_max(float v) {
#pragma unroll
    for (int o = 1; o < 64; o <<= 1) v = fmaxf(v, __shfl_xor(v, o));
    return v;
}
__device__ __forceinline__ u32x4 pack8(const f32x4 a, const f32x4 b) { u32x4 w; w.x = pk_bf16(a[0], a[1]); w.y = pk_bf16(a[2], a[3]); w.z = pk_bf16(b[0], b[1]); w.w = pk_bf16(b[2], b[3]); return w; }

namespace pg8 {
constexpr int BM = 256, BK = 64, HALF = 128, HTB = HALF * BK * 2, STAGE_BYTES = 8 * HTB, NXCD = 8, WGM = 8;
__host__ __device__ __forceinline__ int lds_byte(int r, int c) { const int st = (r >> 4) * 2 + (c >> 5), rr = r & 15, cc = c & 31, ob = rr * 64 + cc * 2; return st * 1024 + (ob ^ (((ob >> 9) & 1) << 5)); }
__host__ __device__ __forceinline__ void stage_rc(int b, int& R, int& C) { const int st = b / 1024, sb = b % 1024, swz = sb ^ (((sb >> 9) & 1) << 5); R = (st >> 1) * 16 + swz / 64; C = (st & 1) * 32 + (swz % 64) / 2; }
__host__ __device__ __forceinline__ int perm32(int rho) { const int n = rho >> 4, i = rho & 15; return 8 * (i >> 2) + 4 * n + (i & 3); }

struct Unit { int pm, pn; };
struct Gemm { const bf16_t* A; const bf16_t* Bt; int M, N, K, lda, a_div, b_div; };

struct StaticOrder {
    int nM, nN, nwg, G, c;
    __device__ void init(int M, int N, int G_, int c_) { nM = M / BM; nN = N / BM; nwg = nM * nN; G = G_; c = c_; }
    __device__ bool next(int i, Unit& u) const {
        const long L = (long)i * G + c; if (L >= nwg) return false;
        int wgid = (int)L; { const int q = nwg / NXCD, r = nwg % NXCD, xcd = wgid % NXCD, off = wgid / NXCD; wgid = (xcd < r ? xcd * (q + 1) : r * (q + 1) + (xcd - r) * q) + off; }
        const int nig = WGM * nN, gid = wgid / nig, fm = gid * WGM, gsz = (nM - fm) < WGM ? (nM - fm) : WGM;
        u.pm = fm + ((wgid % nig) % gsz); u.pn = (wgid % nig) / gsz; return true;
    }
};
__device__ __forceinline__ const char* unitA(const Gemm& g, const Unit& u, size_t tstepA) { return (const char*)g.A + (size_t)u.pm * tstepA + (g.a_div ? (size_t)(u.pn / g.a_div) * (size_t)g.K * 2 : (size_t)0); }
__device__ __forceinline__ const char* unitB(const Gemm& g, const Unit& u, size_t tstepB) { return (const char*)g.Bt + (size_t)(u.pn + (g.b_div ? (u.pm / g.b_div) * (g.N / BM) : 0)) * tstepB; }

template <class Epi>
__device__ __forceinline__ void gemm_phase(LAS unsigned char* lds, const Gemm g, const StaticOrder& S, const Epi& E) {
    const int tid = tid_opq(), wid = __builtin_amdgcn_readfirstlane(tid >> 6), lane = tid & 63, wr = wid >> 2, wc = wid & 3, fr = lane & 15, fq = lane >> 4;
    const int K = g.K, nt = K / BK;
    unsigned voffA[2], voffB[2];
#pragma unroll
    for (int i = 0; i < 2; ++i) { int R, C; stage_rc(tid * 16 + i * 8192, R, C); const int Rb = Epi::PERM ? ((R & ~31) + perm32(R & 31)) : R;
        voffA[i] = (unsigned)(R * g.lda + C) * 2u; voffB[i] = (unsigned)(Rb * K + C) * 2u; }
    const size_t kstep = (size_t)(BK * 2);
    const size_t hstepA = (size_t)HALF * g.lda * 2, hstepB = (size_t)HALF * K * 2;
    const size_t tstepA = 2 * hstepA, tstepB = 2 * hstepB;
    const unsigned ldsw = (unsigned)wid * 1024u;
    const int aoff = lds_byte(wr * 64 + fr, fq * 8), boff = lds_byte(wc * 32 + fr, fq * 8);
#define PG8_SA(b, h) (((b) * 2 + (h)) * HTB)
#define PG8_SB(b, h) ((4 + (b) * 2 + (h)) * HTB)
#define PG8_STAGE(bufoff, gbase, voff) do { _Pragma("unroll") for (int _i = 0; _i < 2; ++_i) \
        __builtin_amdgcn_global_load_lds((const unsigned*)((const char*)(gbase) + (voff)[_i]), (LAS unsigned*)(lds + (bufoff) + ldsw + _i * 8192), 16, 0, 0); } while (0)
#define PG8_LDA(dst, b, h) do { _Pragma("unroll") for (int m = 0; m < 4; ++m) _Pragma("unroll") for (int k = 0; k < 2; ++k) dst[m][k] = *(const LAS bf16x8*)(lds + PG8_SA(b, h) + aoff + m * 2048 + k * 1024); } while (0)
#define PG8_LDB(dst, b, h) do { _Pragma("unroll") for (int n = 0; n < 2; ++n) _Pragma("unroll") for (int k = 0; k < 2; ++k) dst[n][k] = *(const LAS bf16x8*)(lds + PG8_SB(b, h) + boff + n * 2048 + k * 1024); } while (0)
#define PG8_MMA(ai, bj, At, Bt) do { __builtin_amdgcn_s_setprio(1); _Pragma("unroll") for (int m = 0; m < 4; ++m) _Pragma("unroll") for (int n = 0; n < 2; ++n) _Pragma("unroll") for (int k = 0; k < 2; ++k) \
        acc[ai][bj][m][n] = __builtin_amdgcn_mfma_f32_16x16x32_bf16(Bt[n][k], At[m][k], acc[ai][bj][m][n], 0, 0, 0); __builtin_amdgcn_s_setprio(0); } while (0)
#define PG8_WAIT_V(n) asm volatile("s_waitcnt vmcnt(" #n ")" ::: "memory")
#define PG8_WAIT_L(n) asm volatile("s_waitcnt lgkmcnt(" #n ")" ::: "memory")
#define PG8_BAR __builtin_amdgcn_s_barrier()
#define PG8_SCHED __builtin_amdgcn_sched_barrier(0)
    Unit cur, nxt; int ui = 0;
    if (!S.next(0, cur)) return;
    f32x4 acc[2][2][4][2];
#pragma unroll
    for (int a = 0; a < 2; ++a)
#pragma unroll
        for (int b = 0; b < 2; ++b)
#pragma unroll
            for (int m = 0; m < 4; ++m)
#pragma unroll
                for (int n = 0; n < 2; ++n) acc[a][b][m][n] = (f32x4){0.f, 0.f, 0.f, 0.f};
    bf16x8 At[4][2], B0[2][2], B1[2][2];
    const char* cA = unitA(g, cur, tstepA); const char* cB = unitB(g, cur, tstepB);
    PG8_STAGE(PG8_SB(0, 0), cB, voffB); PG8_STAGE(PG8_SB(0, 1), cB + hstepB, voffB); PG8_STAGE(PG8_SA(0, 0), cA, voffA); PG8_STAGE(PG8_SA(0, 1), cA + hstepA, voffA);
    if (wr == 1) PG8_BAR;
    PG8_WAIT_V(2); PG8_BAR;
    PG8_STAGE(PG8_SB(1, 0), cB + kstep, voffB); PG8_STAGE(PG8_SA(1, 0), cA + kstep, voffA); PG8_STAGE(PG8_SB(1, 1), cB + hstepB + kstep, voffB);
    PG8_WAIT_V(6); PG8_BAR;
    for (;;) {
        const bool has_next = S.next(ui + 1, nxt);
        const char* nA = has_next ? unitA(g, nxt, tstepA) : cA; const char* nB = has_next ? unitB(g, nxt, tstepB) : cB;
#pragma unroll 1
        for (int t = 0; t < nt; t += 2) {
            const bool last = (t == nt - 2);
            const char* a1 = cA + (size_t)(t + 1) * kstep;
            const char* a2 = last ? nA : cA + (size_t)(t + 2) * kstep; const char* b2 = last ? nB : cB + (size_t)(t + 2) * kstep;
            const char* a3 = a2 + kstep; const char* b3 = b2 + kstep;
            if constexpr (Epi::MID) { if (t == nt / 2) E.mid(acc, cur, wr, wc, fr, fq); }
            PG8_LDB(B0, 0, 0); PG8_LDB(B1, 0, 1); PG8_SCHED; PG8_LDA(At, 0, 0); PG8_STAGE(PG8_SA(1, 1), a1 + hstepA, voffA);
            PG8_WAIT_V(8); PG8_WAIT_L(0); PG8_BAR; PG8_MMA(0, 0, At, B0); PG8_MMA(0, 1, At, B1); PG8_BAR; PG8_SCHED;
            PG8_LDA(At, 0, 1); PG8_STAGE(PG8_SB(0, 0), b2, voffB); PG8_STAGE(PG8_SB(0, 1), b2 + hstepB, voffB); PG8_STAGE(PG8_SA(0, 0), a2, voffA);
            PG8_WAIT_V(8); PG8_WAIT_L(0); PG8_BAR; PG8_MMA(1, 0, At, B0); PG8_MMA(1, 1, At, B1); PG8_BAR; PG8_SCHED;
            PG8_LDB(B0, 1, 0); PG8_LDB(B1, 1, 1); PG8_SCHED; PG8_LDA(At, 1, 0); PG8_STAGE(PG8_SA(0, 1), a2 + hstepA, voffA);
            PG8_WAIT_V(8); PG8_WAIT_L(0); PG8_BAR; PG8_MMA(0, 0, At, B0); PG8_MMA(0, 1, At, B1); PG8_BAR; PG8_SCHED;
            PG8_LDA(At, 1, 1); PG8_STAGE(PG8_SB(1, 0), b3, voffB); PG8_STAGE(PG8_SB(1, 1), b3 + hstepB, voffB); PG8_STAGE(PG8_SA(1, 0), a3, voffA);
            PG8_WAIT_V(8); PG8_WAIT_L(0); PG8_BAR; PG8_MMA(1, 0, At, B0); PG8_MMA(1, 1, At, B1); PG8_BAR; PG8_SCHED;
        }
        if (wr == 0) PG8_BAR;
        E(acc, cur, wr, wc, fr, fq);
        if (!has_next) break;
#pragma unroll
        for (int a = 0; a < 2; ++a)
#pragma unroll
            for (int b = 0; b < 2; ++b)
#pragma unroll
                for (int m = 0; m < 4; ++m)
#pragma unroll
                    for (int n = 0; n < 2; ++n) acc[a][b][m][n] = (f32x4){0.f, 0.f, 0.f, 0.f};
        cur = nxt; cA = nA; cB = nB; ++ui;
        if (wr == 1) PG8_BAR;
    }
    PG8_WAIT_V(0);
    PG8_BAR;
#undef PG8_SA
#undef PG8_SB
#undef PG8_STAGE
#undef PG8_LDA
#undef PG8_LDB
#undef PG8_MMA
#undef PG8_WAIT_V
#undef PG8_WAIT_L
#undef PG8_BAR
#undef PG8_SCHED
}
}
using pg8::Unit;
typedef const f32x4 (&AccRef)[2][2][4][2];

struct EpiInA {
    static constexpr bool PERM = true, MID = false;
    bf16_t* RX; bf16_t* YO;
    __device__ __forceinline__ void operator()(AccRef acc, const Unit& u, int wr, int wc, int fr, int fq) const {
        const bool isy = u.pn >= 4; bf16_t* base = isy ? YO : RX; const int ldc = isy ? 2048 : 1024;
        const int row0 = u.pm * 256 + wr * 64 + fr, col0 = (u.pn & 3) * 256 + wc * 32 + 8 * fq;
#pragma unroll
        for (int ai = 0; ai < 2; ++ai)
#pragma unroll
            for (int m = 0; m < 4; ++m) { bf16_t* rowp = base + (size_t)(row0 + ai * 128 + m * 16) * ldc + col0;
#pragma unroll
                for (int bj = 0; bj < 2; ++bj) { f32x4 v0 = acc[ai][bj][m][0], v1 = acc[ai][bj][m][1];
                    if (isy) {
#pragma unroll
                        for (int i = 0; i < 4; ++i) { v0[i] = gelu_t(v0[i]); v1[i] = gelu_t(v1[i]); } }
                    *(u32x4*)(rowp + bj * 128) = pack8(v0, v1); } }
    }
};
struct EpiInB {
    static constexpr bool PERM = true, MID = false;
    bf16_t* YO; bf16_t* KVB; bf16_t* MG; float* NG; const float* qn; const float* kn;
    __device__ __forceinline__ void operator()(AccRef acc, const Unit& u, int wr, int wc, int fr, int fq) const {
        const int t = u.pn; const int row0 = u.pm * 256 + wr * 64 + fr;
        if (t < 10) {
            const bool isq = t < 4; const bool nrm = isq || t == 6 || t == 8;
            const float* gw = isq ? qn : (kn + (t == 6 ? 64 : 128));
            const float osc = isq ? QSCALE : 1.f;
#pragma unroll
            for (int ai = 0; ai < 2; ++ai)
#pragma unroll
                for (int m = 0; m < 4; ++m) {
                    const int row = row0 + ai * 128 + m * 16;
                    float rinv = 1.f;
                    if (nrm) { float ss = 0.f;
#pragma unroll
                        for (int bj = 0; bj < 2; ++bj)
#pragma unroll
                            for (int n = 0; n < 2; ++n) { const f32x4 x = acc[ai][bj][m][n]; ss += (x[0] * x[0] + x[1] * x[1]) + (x[2] * x[2] + x[3] * x[3]); }
                        ss += __shfl_xor(ss, 16); ss += __shfl_xor(ss, 32);
                        rinv = rsqrtf(ss * (1.f / 64.f) + EPS) * osc; }
                    bf16_t* dst;
                    if (isq) dst = YO + (size_t)row * 2048 + 1024 + (t * 4 + wc) * 64 + 8 * fq;
                    else { const int b = row >> 12, s = row & 4095; dst = KVB + (size_t)(t - 4) * KVBUF + ((size_t)(b * 4 + wc) * 4096 + s) * 64 + 8 * fq; }
#pragma unroll
                    for (int bj = 0; bj < 2; ++bj) { const f32x4 g0 = nrm ? *(const f32x4*)(gw + 32 * bj + 8 * fq) : (f32x4){1.f, 1.f, 1.f, 1.f}, g1 = nrm ? *(const f32x4*)(gw + 32 * bj + 8 * fq + 4) : (f32x4){1.f, 1.f, 1.f, 1.f};
                        const f32x4 v0 = acc[ai][bj][m][0] * rinv * g0, v1 = acc[ai][bj][m][1] * rinv * g1;
                        *(u32x4*)(dst + 32 * bj) = pack8(v0, v1); }
                }
        } else if (t < 18) {
#pragma unroll
            for (int ai = 0; ai < 2; ++ai)
#pragma unroll
                for (int m = 0; m < 4; ++m) { bf16_t* dst = MG + (size_t)(row0 + ai * 128 + m * 16) * 2048 + (t - 10) * 256 + 64 * wc + 8 * fq;
#pragma unroll
                    for (int bj = 0; bj < 2; ++bj) { f32x4 v0 = acc[ai][bj][m][0], v1 = acc[ai][bj][m][1];
#pragma unroll
                        for (int i = 0; i < 4; ++i) { v0[i] = sigm(v0[i]); v1[i] = sigm(v1[i]); }
                        *(u32x4*)(dst + 32 * bj) = pack8(v0, v1); } }
        } else if (wc == 0) {
#pragma unroll
            for (int ai = 0; ai < 2; ++ai)
#pragma unroll
                for (int m = 0; m < 4; ++m) { float* dst = NG + (size_t)(row0 + ai * 128 + m * 16) * 64 + 8 * fq;
#pragma unroll
                    for (int bj = 0; bj < 2; ++bj)
#pragma unroll
                        for (int n = 0; n < 2; ++n) { f32x4 v = acc[ai][bj][m][n];
#pragma unroll
                            for (int i = 0; i < 4; ++i) v[i] = sigm(v[i]);
                            *(f32x4*)(dst + 32 * bj + 4 * n) = v; } }
        }
    }
};
struct EpiGate {
    static constexpr bool PERM = true, MID = false;
    const bf16_t* XR; bf16_t* LA; bf16_t* U; const float* ba; const float* bi; const float* lam;
    __device__ __forceinline__ void operator()(AccRef acc, const Unit& u, int wr, int wc, int fr, int fq) const {
        const int row0 = u.pm * 256 + wr * 64 + fr;
#pragma unroll
        for (int n = 0; n < 2; ++n) {
            const int ch0 = u.pn * 128 + wc * 32 + 8 * fq + 4 * n;
            const f32x4 bav = *(const f32x4*)(ba + ch0), biv = *(const f32x4*)(bi + ch0), spv = *(const f32x4*)(lam + ch0);
#pragma unroll
            for (int ai = 0; ai < 2; ++ai) {
                u32x2 xwv[4];
#pragma unroll
                for (int m = 0; m < 4; ++m) xwv[m] = *(const u32x2*)(XR + (size_t)(row0 + ai * 128 + m * 16) * 1024 + ch0);
#pragma unroll
                for (int m = 0; m < 4; ++m) { const int row = row0 + ai * 128 + m * 16; const bool first = (row & 4095) == 0;
                    const u32x2 xw = xwv[m];
                    const float xv[4] = {bf_lo(xw.x), bf_hi(xw.x), bf_lo(xw.y), bf_hi(xw.y)};
                    float la[4], uu[4];
#pragma unroll
                    for (int i = 0; i < 4; ++i) { const float rp = acc[ai][0][m][n][i] + bav[i], ip = acc[ai][1][m][n][i] + biv[i];
                        const float l2 = sigm(rp) * spv[i];
                        const float a2 = ex2(2.f * l2); float mult = __builtin_amdgcn_sqrtf(fmaxf(1.f - a2, 0.f)); if (first) mult = 1.f;
                        la[i] = l2; uu[i] = mult * sigm(ip) * xv[i]; }
                    u32x2 w0, w1; w0.x = pk_bf16(la[0], la[1]); w0.y = pk_bf16(la[2], la[3]); w1.x = pk_bf16(uu[0], uu[1]); w1.y = pk_bf16(uu[2], uu[3]);
                    *(u32x2*)(LA + (size_t)row * 1024 + ch0) = w0; *(u32x2*)(U + (size_t)row * 1024 + ch0) = w1; } }
        }
    }
};
struct EpiCmp1 {
    static constexpr bool PERM = true, MID = false;
    bf16_t* HID; const float* bias1;
    __device__ __forceinline__ void operator()(AccRef acc, const Unit& u, int wr, int wc, int fr, int fq) const {
        const int which = u.pm >> 5; const int row0 = u.pm * 256 + wr * 64 + fr;
#pragma unroll
        for (int ai = 0; ai < 2; ++ai)
#pragma unroll
            for (int m = 0; m < 4; ++m) { bf16_t* dst = HID + (size_t)(row0 + ai * 128 + m * 16) * 256 + wc * 32 + 8 * fq;
#pragma unroll
                for (int bj = 0; bj < 2; ++bj) { const float* bp = bias1 + which * 256 + bj * 128 + wc * 32 + 8 * fq;
                    f32x4 v0 = acc[ai][bj][m][0] + *(const f32x4*)bp, v1 = acc[ai][bj][m][1] + *(const f32x4*)(bp + 4);
#pragma unroll
                    for (int i = 0; i < 4; ++i) { v0[i] = gelu_t(v0[i]); v1[i] = gelu_t(v1[i]); }
                    *(u32x4*)(dst + bj * 128) = pack8(v0, v1); } }
    }
};
template <int ADD> struct EpiMix {
    static constexpr bool PERM = true, MID = false;
    bf16_t* MB; const bf16_t* MG; int sel;
    __device__ __forceinline__ void operator()(AccRef acc, const Unit& u, int wr, int wc, int fr, int fq) const {
        const int row0 = u.pm * 256 + wr * 64 + fr, col0 = u.pn * 256 + wc * 32 + 8 * fq;
#pragma unroll
        for (int ai = 0; ai < 2; ++ai)
#pragma unroll
            for (int mp = 0; mp < 2; ++mp) {
                u32x4 gwv[2][2], owv[2][2];
#pragma unroll
                for (int mm = 0; mm < 2; ++mm)
#pragma unroll
                    for (int bj = 0; bj < 2; ++bj) { const int row = row0 + ai * 128 + (2 * mp + mm) * 16, col = col0 + bj * 128;
                        gwv[mm][bj] = *(const u32x4*)(MG + (size_t)row * 2048 + sel * 1024 + col);
                        owv[mm][bj] = ADD ? *(const u32x4*)(MB + (size_t)row * 1024 + col) : (u32x4){0u, 0u, 0u, 0u}; }
#pragma unroll
                for (int mm = 0; mm < 2; ++mm)
#pragma unroll
                    for (int bj = 0; bj < 2; ++bj) { const int row = row0 + ai * 128 + (2 * mp + mm) * 16, col = col0 + bj * 128; const u32x4 gw = gwv[mm][bj], ow = owv[mm][bj];
                        f32x4 v0 = acc[ai][bj][2 * mp + mm][0], v1 = acc[ai][bj][2 * mp + mm][1];
                        v0[0] *= bf_lo(gw.x); v0[1] *= bf_hi(gw.x); v0[2] *= bf_lo(gw.y); v0[3] *= bf_hi(gw.y);
                        v1[0] *= bf_lo(gw.z); v1[1] *= bf_hi(gw.z); v1[2] *= bf_lo(gw.w); v1[3] *= bf_hi(gw.w);
                        if (ADD) { v0[0] += bf_lo(ow.x); v0[1] += bf_hi(ow.x); v0[2] += bf_lo(ow.y); v0[3] += bf_hi(ow.y);
                            v1[0] += bf_lo(ow.z); v1[1] += bf_hi(ow.z); v1[2] += bf_lo(ow.w); v1[3] += bf_hi(ow.w); }
                        *(u32x4*)(MB + (size_t)row * 1024 + col) = pack8(v0, v1); } }
    }
};
struct EpiMixM {
    static constexpr bool PERM = true, MID = true;
    bf16_t* MB; const bf16_t* MG;
    __device__ __forceinline__ void mid(f32x4 (&acc)[2][2][4][2], const Unit& u, int wr, int wc, int fr, int fq) const {
        int row0 = u.pm * 256 + wr * 64 + fr, col0 = u.pn * 256 + wc * 32 + 8 * fq; asm volatile("" : "+v"(row0), "+v"(col0));
#pragma unroll
        for (int ai = 0; ai < 2; ++ai)
#pragma unroll
            for (int m = 0; m < 4; ++m)
#pragma unroll
                for (int bj = 0; bj < 2; ++bj) { const bf16_t* gp = MG + (size_t)(row0 + ai * 128 + m * 16) * 2048 + col0 + bj * 128;
                    const u32x4 g0 = *(const u32x4*)gp, g1 = *(const u32x4*)(gp + 1024);
                    f32x4 r0, r1;
                    r0[0] = bf_lo(g0.x) * __builtin_amdgcn_rcpf(bf_lo(g1.x)); r0[1] = bf_hi(g0.x) * __builtin_amdgcn_rcpf(bf_hi(g1.x)); r0[2] = bf_lo(g0.y) * __builtin_amdgcn_rcpf(bf_lo(g1.y)); r0[3] = bf_hi(g0.y) * __builtin_amdgcn_rcpf(bf_hi(g1.y));
                    r1[0] = bf_lo(g0.z) * __builtin_amdgcn_rcpf(bf_lo(g1.z)); r1[1] = bf_hi(g0.z) * __builtin_amdgcn_rcpf(bf_hi(g1.z)); r1[2] = bf_lo(g0.w) * __builtin_amdgcn_rcpf(bf_lo(g1.w)); r1[3] = bf_hi(g0.w) * __builtin_amdgcn_rcpf(bf_hi(g1.w));
                    acc[ai][bj][m][0] *= r0; acc[ai][bj][m][1] *= r1; }
    }
    __device__ __forceinline__ void operator()(AccRef acc, const Unit& u, int wr, int wc, int fr, int fq) const {
        const int row0 = u.pm * 256 + wr * 64 + fr, col0 = u.pn * 256 + wc * 32 + 8 * fq;
#pragma unroll
        for (int ai = 0; ai < 2; ++ai)
#pragma unroll
            for (int m = 0; m < 4; ++m)
#pragma unroll
                for (int bj = 0; bj < 2; ++bj) { const int row = row0 + ai * 128 + m * 16, col = col0 + bj * 128;
                    const u32x4 gw = *(const u32x4*)(MG + (size_t)row * 2048 + 1024 + col);
                    f32x4 v0 = acc[ai][bj][m][0], v1 = acc[ai][bj][m][1];
                    v0[0] *= bf_lo(gw.x); v0[1] *= bf_hi(gw.x); v0[2] *= bf_lo(gw.y); v0[3] *= bf_hi(gw.y);
                    v1[0] *= bf_lo(gw.z); v1[1] *= bf_hi(gw.z); v1[2] *= bf_lo(gw.w); v1[3] *= bf_hi(gw.w);
                    *(u32x4*)(MB + (size_t)row * 1024 + col) = pack8(v0, v1); }
    }
};
struct EpiRes {
    static constexpr bool PERM = false, MID = false;
    const float* base; float* out;
    __device__ __forceinline__ void operator()(AccRef acc, const Unit& u, int wr, int wc, int fr, int fq) const {
        const int row0 = u.pm * 256 + wr * 64 + fr, col0 = u.pn * 256 + wc * 32 + 4 * fq;
#pragma unroll
        for (int ai = 0; ai < 2; ++ai)
#pragma unroll
            for (int mp = 0; mp < 2; ++mp) {
                f32x4 bs[2][2][2];
#pragma unroll
                for (int mm = 0; mm < 2; ++mm) { const size_t off = (size_t)(row0 + ai * 128 + (2 * mp + mm) * 16) * 1024 + col0;
#pragma unroll
                    for (int bj = 0; bj < 2; ++bj)
#pragma unroll
                        for (int n = 0; n < 2; ++n) bs[mm][bj][n] = *(const f32x4*)(base + off + bj * 128 + n * 16); }
#pragma unroll
                for (int mm = 0; mm < 2; ++mm) { const size_t off = (size_t)(row0 + ai * 128 + (2 * mp + mm) * 16) * 1024 + col0;
#pragma unroll
                    for (int bj = 0; bj < 2; ++bj)
#pragma unroll
                        for (int n = 0; n < 2; ++n) *(f32x4*)(out + off + bj * 128 + n * 16) = bs[mm][bj][n] + acc[ai][bj][2 * mp + mm][n]; } }
    }
};
struct EpiSwi {
    static constexpr bool PERM = true, MID = false;
    bf16_t* ACT;
    __device__ __forceinline__ void operator()(AccRef acc, const Unit& u, int wr, int wc, int fr, int fq) const {
        const int row0 = u.pm * 256 + wr * 64 + fr, ch0 = u.pn * 128 + wc * 32 + 8 * fq;
#pragma unroll
        for (int ai = 0; ai < 2; ++ai)
#pragma unroll
            for (int m = 0; m < 4; ++m) { f32x4 v0, v1;
#pragma unroll
                for (int i = 0; i < 4; ++i) { const float g0 = acc[ai][0][m][0][i], g1 = acc[ai][0][m][1][i];
                    v0[i] = g0 * sigm(g0) * acc[ai][1][m][0][i]; v1[i] = g1 * sigm(g1) * acc[ai][1][m][1][i]; }
                *(u32x4*)(ACT + (size_t)(row0 + ai * 128 + m * 16) * D_FF + ch0) = pack8(v0, v1); }
    }
};

__device__ __forceinline__ void xpose_item(const float* W, int Ns, int col0, int valid, bf16_t* dst, int K, int k0, LAS float* scr, int lane) {
#pragma unroll
    for (int i = 0; i < 32; ++i) { const int kk = 2 * i + (lane >> 5), n = lane & 31; scr[kk * 33 + n] = (n < valid) ? W[(size_t)(k0 + kk) * Ns + col0 + n] : 0.f; }
    asm volatile("s_waitcnt lgkmcnt(0)" ::: "memory");
    const int c = lane & 7;
#pragma unroll
    for (int j = 0; j < 4; ++j) { const int n = (lane >> 3) + 8 * j; const LAS float* s = scr + (8 * c) * 33 + n;
        u32x4 o; o.x = pk_bf16(s[0 * 33], s[1 * 33]); o.y = pk_bf16(s[2 * 33], s[3 * 33]); o.z = pk_bf16(s[4 * 33], s[5 * 33]); o.w = pk_bf16(s[6 * 33], s[7 * 33]);
        *(u32x4*)(dst + (size_t)n * K + k0 + 8 * c) = o; }
    asm volatile("s_waitcnt lgkmcnt(0)" ::: "memory");
}

struct Args { const float* in[25]; float* out; unsigned char* ws; int ph_lo, ph_hi; };
__device__ __forceinline__ unsigned char* opq(unsigned char* p);

__device__ __forceinline__ void weights_phase(const Args& a, int l, LAS unsigned char* lds, int gw, int ngw, int wave, int lane) {
    LAS float* scr = (LAS float*)(lds + wave * 16384);
    bf16_t* Wb = (bf16_t*)(opq(a.ws) + WS_W);
    const float* w_in = a.in[2] + (size_t)l * 1024 * D_IN;
    constexpr int I1 = 16 * 64, I2 = 16 * 152, I3 = 4 * 64, I4 = 32 * 16, I5 = 16 * 32, I6 = 16 * 176, I7 = 44 * 32;
    constexpr int NIT = I1 + I2 + I3 + I4 + 3 * I5 + I6 + I7;
    for (int it = gw; it < NIT; it += ngw) {
        int r = it;
        if (r < I1) { const int kb = r / 64, gi = r % 64; xpose_item(w_in, D_IN, 32 * gi, 32, Wb + W_INA / 2 + (size_t)(32 * gi) * 1024, 1024, 64 * kb, scr, lane); continue; } r -= I1;
        if (r < I2) { const int kb = r / 152, gi = r % 152; const int t = gi >> 3, gl = gi & 7, ca = 64 * (gl & 3) + 32 * (gl >> 2);
            int col0, valid = 32;
            if (t < 10) col0 = 2048 + 256 * t + ca; else if (t < 18) col0 = 4656 + 256 * (t - 10) + ca; else { col0 = 4608 + ca; valid = 48 - ca; valid = valid < 0 ? 0 : (valid > 32 ? 32 : valid); }
            xpose_item(w_in, D_IN, col0, valid, Wb + W_INB / 2 + (size_t)(32 * gi) * 1024, 1024, 64 * kb, scr, lane); continue; } r -= I2;
        if (r < I3) { const int kb = r / 64, gi = r % 64; const int pn = gi >> 3, gl = gi & 7, bj = gl >> 2, ch = 128 * pn + 32 * (gl & 3);
            const float* W = (bj ? a.in[7] : a.in[5]) + (size_t)l * 4 * 65536 + (size_t)(ch >> 8) * 65536;
            xpose_item(W, 256, ch & 255, 32, Wb + W_G / 2 + (size_t)(32 * gi) * 256, 256, 64 * kb, scr, lane); continue; } r -= I3;
        if (r < I4) { const int kb = r / 16, gi = r % 16; const float* W = ((gi >> 3) ? a.in[16] : a.in[14]) + (size_t)l * 2048 * 256;
            xpose_item(W, 256, 32 * (gi & 7), 32, Wb + W_C1 / 2 + (size_t)(32 * gi) * 2048, 2048, 64 * kb, scr, lane); continue; } r -= I4;
        if (r < 3 * I5) { const int which = r / I5; r -= which * I5; const int kb = r / 32, gi = r % 32;
            const float* W = a.in[18 + which] + (size_t)l * 1024 * 1024;
            if (which < 2) xpose_item(W, 1024, 32 * gi, 32, Wb + W_YA / 2 + (size_t)(32 * gi) * 2048 + which * 1024, 2048, 64 * kb, scr, lane);
            else xpose_item(W, 1024, 32 * gi, 32, Wb + W_O / 2 + (size_t)(32 * gi) * 1024, 1024, 64 * kb, scr, lane);
            continue; } r -= 3 * I5;
        if (r < I6) { const int kb = r / 176, gi = r % 176; const int pn = gi >> 3, gl = gi & 7, bj = gl >> 2;
            const float* W = (bj ? a.in[23] : a.in[22]) + (size_t)l * 1024 * D_FF;
            xpose_item(W, D_FF, 128 * pn + 32 * (gl & 3), 32, Wb + W_GU / 2 + (size_t)(32 * gi) * 1024, 1024, 64 * kb, scr, lane); continue; } r -= I6;
        { const int kb = r / 32, gi = r % 32; const float* W = a.in[24] + (size_t)l * D_FF * 1024;
            xpose_item(W, 1024, 32 * gi, 32, Wb + W_D / 2 + (size_t)(32 * gi) * D_FF, D_FF, 64 * kb, scr, lane); }
    }
}

__device__ __forceinline__ void rms_phase(const float* x, const float* g, bf16_t* out, int gw, int ngw, int lane) {
    f32x4 gv[4];
#pragma unroll
    for (int j = 0; j < 4; ++j) gv[j] = ((const f32x4*)g)[lane + 64 * j];
    for (int m0 = gw; m0 < MTOK; m0 += 4 * ngw) {
        f32x4 v[4][4];
#pragma unroll
        for (int e = 0; e < 4; ++e) { const int m = m0 + e * ngw; const f32x4* xr = (const f32x4*)(x + (size_t)(m < MTOK ? m : m0) * 1024) + lane;
#pragma unroll
            for (int j = 0; j < 4; ++j) v[e][j] = xr[64 * j]; }
#pragma unroll
        for (int e = 0; e < 4; ++e) { const int m = m0 + e * ngw; float s = 0.f;
#pragma unroll
            for (int j = 0; j < 4; ++j) s += (v[e][j][0] * v[e][j][0] + v[e][j][1] * v[e][j][1]) + (v[e][j][2] * v[e][j][2] + v[e][j][3] * v[e][j][3]);
            const float rinv = rsqrtf(wave_sum(s) * (1.f / 1024.f) + EPS);
            if (m < MTOK) { u32x2* o8 = (u32x2*)(out + (size_t)m * 1024) + lane;
#pragma unroll
                for (int j = 0; j < 4; ++j) { u32x2 w; w.x = pk_bf16(v[e][j][0] * rinv * gv[j][0], v[e][j][1] * rinv * gv[j][1]); w.y = pk_bf16(v[e][j][2] * rinv * gv[j][2], v[e][j][3] * rinv * gv[j][3]); o8[64 * j] = w; } } }
    }
}

namespace att {
constexpr int NST = 5, DEPTH_INFLIGHT = 4;
constexpr int STAGE = 16384;
constexpr int OFF_WS = NST * STAGE, WS_PER_WAVE = 8192 + 256;
__device__ __forceinline__ int crow(int r, int hi) { return (r & 3) + 8 * (r >> 2) + 4 * hi; }
__device__ __forceinline__ s16x4 vtr(const LAS unsigned char* p) { typedef short v4i16_t __attribute__((ext_vector_type(4))); return __builtin_bit_cast(s16x4, __builtin_amdgcn_ds_read_tr16_b64_v4i16((LAS v4i16_t*)p)); }

__device__ __forceinline__ void job_decode(int j, int nct, int qi, int kt0, int& type, int& tile) {
    if (j < nct) { type = 1; tile = j; } else if (j < nct + qi + 1) { type = 2; tile = j - nct; } else { type = 3; tile = kt0 + (j - nct - qi - 1); }
}

__device__ __forceinline__ void attn_phase(LAS unsigned char* lds, const bf16_t* KVB, const bf16_t* KC, const bf16_t* VC, const bf16_t* YO, bf16_t* OUT, int ldo, const float* NG, const float* qn, const float* kn) {
    const int tid = tid_opq(), lane = tid & 63, w = __builtin_amdgcn_readfirstlane(tid >> 6), q = lane & 31, hi = lane >> 5, hh = q >> 3, tl = q & 7;
    LAS float* impw = (LAS float*)(lds + OFF_WS + w * WS_PER_WAVE);
    LAS float* rs = impw + 2048;
    LAS float* rs2 = rs + 32;
    const float gq = wave_max(fabsf(qn[lane]));
    const float nB0 = -8.5f * LOG2E * gq * wave_max(fabsf(kn[lane]));
    const float nB1 = -8.5f * LOG2E * gq * wave_max(fabsf(kn[64 + lane]));
    const float nB2 = -8.5f * LOG2E * gq * wave_max(fabsf(kn[128 + lane]));
    const int G = gd_opq(), bx = bx_opq();
    const int drow = 8 * w + (lane >> 3), dsl = lane & 7;
    const unsigned dkoff = (unsigned)(drow * 128 + ((dsl ^ ((drow >> 1) & 7)) * 16));
    const unsigned dvoff = (unsigned)(drow * 128 + ((dsl ^ (4 * ((drow >> 1) & 1))) * 16));
    const unsigned ldsw = (unsigned)w * 1024u;
    const int kfx = (q >> 1) & 7;
    const int qrow = (lane & 15) >> 2, pcol = lane & 3, cgp = (lane >> 4) & 1, fbit = (qrow >> 1) & 1;
    const int vbase = (4 * hi + qrow) * 128 + (2 * cgp + (pcol >> 1)) * 16 + 8 * (pcol & 1);
    const int vb0 = vbase + fbit * 64, vb1 = vbase + (fbit ^ 1) * 64;
#define ATT_WAIT_BAR(N) asm volatile("s_waitcnt vmcnt(" #N ") lgkmcnt(0)\n\ts_barrier" ::: "memory")
    for (int it = 0;; ++it) {
        int qi, bg;
        if (G == 256) { if (it >= 8) break; const int r = bx >> 5; qi = 8 * (7 - it) + ((it & 1) ? r : 7 - r); bg = bx & 31; }
        else { const int idx = it * G + bx; if (idx >= 2048) break; qi = 63 - (idx >> 5); bg = idx & 31; }
        const int b = bg >> 2, g = bg & 3;
        const int tt = w * 8 + tl, tq = qi * 64 + tt;
        const size_t row = (size_t)b * 4096 + tq;
        const int head = g * 4 + hh;
        bf16x8 qf[4];
#pragma unroll
        for (int d0 = 0; d0 < 4; ++d0) qf[d0] = *(const bf16x8*)(YO + row * 2048 + 1024 + head * 64 + 16 * d0 + 8 * hi);
        const int cmaxq = (tq - 31) >> 4;
        const int nct = (4 * qi + 2) / 64 + 1;
        const int nw = (qi < 8 ? qi : 8) + 1, kt0 = qi - (nw - 1);
        const int NJ = nct + (qi + 1) + nw;
        const char* kcb = (const char*)(KC + (size_t)bg * 256 * 64); const char* vcb = (const char*)(VC + (size_t)bg * 256 * 64);
        const char* ksb = (const char*)(KVB + 2 * KVBUF + (size_t)bg * 4096 * 64); const char* vsb = (const char*)(KVB + 3 * KVBUF + (size_t)bg * 4096 * 64);
        const char* kwb = (const char*)(KVB + 4 * KVBUF + (size_t)bg * 4096 * 64); const char* vwb = (const char*)(KVB + 5 * KVBUF + (size_t)bg * 4096 * 64);
#define ATT_ISSUE(j_, st_) do { int ty_, tile_; job_decode((j_) < NJ ? (j_) : NJ - 1, nct, qi, kt0, ty_, tile_); \
            const char* kp_ = (ty_ < 2 ? kcb : (ty_ == 2 ? ksb : kwb)) + (size_t)tile_ * 8192; const char* vp_ = (ty_ < 2 ? vcb : (ty_ == 2 ? vsb : vwb)) + (size_t)tile_ * 8192; \
            __builtin_amdgcn_global_load_lds((const unsigned*)(kp_ + dkoff), (LAS unsigned*)(lds + (st_) * STAGE + ldsw), 16, 0, 0); \
            __builtin_amdgcn_global_load_lds((const unsigned*)(vp_ + dvoff), (LAS unsigned*)(lds + (st_) * STAGE + 8192 + ldsw), 16, 0, 0); } while (0)
        ATT_ISSUE(0, 0); ATT_ISSUE(1, 1); ATT_ISSUE(2, 2);
        f32x16 ofin[2], ocur[2];
#pragma unroll
        for (int r = 0; r < 16; ++r) { ofin[0][r] = 0.f; ofin[1][r] = 0.f; ocur[0][r] = 0.f; ocur[1][r] = 0.f; }
        float lsum = 0.f, carry = 0.f;
        unsigned long long mymask = (2ull << qi) - 1ull, unionmask = mymask;
        int st_cur = 0, st_iss = 3;
        for (int jp = 0; jp < NJ; jp += 2) {
            ATT_WAIT_BAR(2);
            ATT_ISSUE(jp + 3, st_iss); st_iss = (st_iss == NST - 1) ? 0 : st_iss + 1;
            ATT_ISSUE(jp + 4, st_iss); st_iss = (st_iss == NST - 1) ? 0 : st_iss + 1;
          for (int half = 0; half < 2; ++half) {
            const int j = jp + half; if (j >= NJ) break;
            int type, tile; job_decode(j, nct, qi, kt0, type, tile);
            const LAS unsigned char* Kb = lds + st_cur * STAGE;
            const LAS unsigned char* Vb = Kb + 8192;
            st_cur = (st_cur == NST - 1) ? 0 : st_cur + 1;
            const bool skip = (type == 2) && (((unionmask >> tile) & 1ull) == 0ull);
            if (!skip) {
                const float nbT = type < 2 ? nB0 : (type == 2 ? nB1 : nB2);
                const unsigned long long msel = (type == 2) ? mymask : ~0ull;
                const float rowsel = (float)(unsigned)((msel >> tile) & 1ull);
                const float nB = fmaf(rowsel, nbT, fmaf(rowsel, 30000.f, -30000.f));
                f32x16 p0, p1, cin;
#pragma unroll
                for (int r = 0; r < 16; ++r) cin[r] = nB;
#define ATT_QK2() do { \
                p0 = __builtin_amdgcn_mfma_f32_32x32x16_bf16(*(const LAS bf16x8*)(Kb + q * 128 + (hi ^ kfx) * 16), qf[0], cin, 0, 0, 0); \
                _Pragma("unroll") for (int d0 = 1; d0 < 4; ++d0) p0 = __builtin_amdgcn_mfma_f32_32x32x16_bf16(*(const LAS bf16x8*)(Kb + q * 128 + ((2 * d0 + hi) ^ kfx) * 16), qf[d0], p0, 0, 0, 0); \
                p1 = __builtin_amdgcn_mfma_f32_32x32x16_bf16(*(const LAS bf16x8*)(Kb + (32 + q) * 128 + (hi ^ kfx) * 16), qf[0], cin, 0, 0, 0); \
                _Pragma("unroll") for (int d0 = 1; d0 < 4; ++d0) p1 = __builtin_amdgcn_mfma_f32_32x32x16_bf16(*(const LAS bf16x8*)(Kb + (32 + q) * 128 + ((2 * d0 + hi) ^ kfx) * 16), qf[d0], p1, 0, 0, 0); } while (0)
#define ATT_PV2() do { _Pragma("unroll") for (int s = 0; s < 4; ++s) { u32x4 pw; \
                    if (s < 2) { pw.x = pk_bf16(p0[8 * s], p0[8 * s + 1]); pw.y = pk_bf16(p0[8 * s + 2], p0[8 * s + 3]); pw.z = pk_bf16(p0[8 * s + 4], p0[8 * s + 5]); pw.w = pk_bf16(p0[8 * s + 6], p0[8 * s + 7]); } \
                    else { const int s2 = s - 2; pw.x = pk_bf16(p1[8 * s2], p1[8 * s2 + 1]); pw.y = pk_bf16(p1[8 * s2 + 2], p1[8 * s2 + 3]); pw.z = pk_bf16(p1[8 * s2 + 4], p1[8 * s2 + 5]); pw.w = pk_bf16(p1[8 * s2 + 6], p1[8 * s2 + 7]); } \
                    const bf16x8 pa = __builtin_bit_cast(bf16x8, pw); \
                    { const s16x4 vlo = vtr(Vb + s * 2048 + vb0), vhi = vtr(Vb + s * 2048 + 1024 + vb0); \
                      const bf16x8 vf = (bf16x8){vlo[0], vlo[1], vlo[2], vlo[3], vhi[0], vhi[1], vhi[2], vhi[3]}; ocur[0] = __builtin_amdgcn_mfma_f32_32x32x16_bf16(pa, vf, ocur[0], 0, 0, 0); } \
                    { const s16x4 vlo = vtr(Vb + s * 2048 + vb1), vhi = vtr(Vb + s * 2048 + 1024 + vb1); \
                      const bf16x8 vf = (bf16x8){vlo[0], vlo[1], vlo[2], vlo[3], vhi[0], vhi[1], vhi[2], vhi[3]}; ocur[1] = __builtin_amdgcn_mfma_f32_32x32x16_bf16(pa, vf, ocur[1], 0, 0, 0); } } } while (0)
                const bool interior = (type == 2 && tile < qi) || (type == 3 && tile > qi - 8 && tile < qi);
                if (interior) {
                    ATT_QK2();
                    float ps = 0.f, ps1 = 0.f;
#pragma unroll
                    for (int r = 0; r < 16; ++r) { p0[r] = ex2(p0[r]); ps += p0[r]; }
#pragma unroll
                    for (int r = 0; r < 16; ++r) { p1[r] = ex2(p1[r]); ps1 += p1[r]; }
                    lsum += ps + ps1;
                    ATT_PV2();
                } else {
                    ATT_QK2();
                    int lo = 0, hiq = 63;
                    if (type < 2) hiq = cmaxq - 64 * tile;
                    else if (type == 2) { if (tile == qi) hiq = tt; }
                    else { if (tile == qi - 8) lo = tt + 1; if (tile == qi) hiq = tt; }
                    float ps = 0.f;
#pragma unroll
                    for (int r = 0; r < 16; ++r) { const int k0i = crow(r, hi), k1i = k0i + 32;
                        p0[r] = (k0i >= lo && k0i <= hiq) ? ex2(p0[r]) : 0.f; p1[r] = (k1i >= lo && k1i <= hiq) ? ex2(p1[r]) : 0.f; ps += p0[r] + p1[r]; }
                    lsum += ps;
                    if (type == 1 && qi >= 16) {
                        float s4[8], b3[8], pb[8];
#pragma unroll
                        for (int a = 0; a < 4; ++a) { s4[a] = (p0[4 * a] + p0[4 * a + 1]) + (p0[4 * a + 2] + p0[4 * a + 3]); b3[a] = p0[4 * a + 3];
                            s4[4 + a] = (p1[4 * a] + p1[4 * a + 1]) + (p1[4 * a + 2] + p1[4 * a + 3]); b3[4 + a] = p1[4 * a + 3]; }
#pragma unroll
                        for (int x = 0; x < 8; ++x) pb[x] = __shfl_xor(b3[x], 32);
#pragma unroll
                        for (int x = 0; x < 8; ++x) { const float extra = hi ? pb[x] : (x == 0 ? carry : pb[x == 0 ? 0 : x - 1]);
                            const int n = 16 * tile + 2 * (x & 3) + hi + 8 * (x >> 2);
                            impw[q * 64 + n] = s4[x] + extra; }
                        carry = pb[7];
                    }
                    ATT_PV2();
                }
#undef ATT_QK2
#undef ATT_PV2
            }
            const bool end_c2 = (type == 1 && tile == nct - 1), end_s = (type == 2 && tile == qi), end_w = (type == 3 && tile == qi);
            if (end_c2 || end_s || end_w) {
                const float l = lsum + __shfl_xor(lsum, 32);
                const float gt_ = NG[row * 64 + (end_c2 ? 0 : (end_s ? 16 : 32)) + head];
                const float linv = l > 0.f ? 1.f / l : 0.f;
                const float sc = gt_ * linv;
                if (hi == 0) { rs[q] = sc; if (end_c2) rs2[q] = linv; }
#pragma unroll
                for (int r = 0; r < 16; ++r) { const float f = rs[crow(r, hi)]; ofin[0][r] += f * ocur[0][r]; ofin[1][r] += f * ocur[1][r]; ocur[0][r] = 0.f; ocur[1][r] = 0.f; }
                lsum = 0.f;
            }
            if (end_c2 && qi >= 16) {
                unionmask = 0ull; mymask = 0ull;
                for (int i = 0; i < 8; ++i) {
                    const int n = lane; const bool valid = n <= qi, forced = (n == 0) || (n == qi) || (n == qi - 1);
                    const float sc = forced ? 1e6f : (impw[i * 64 + n] * rs2[i] + impw[(8 + i) * 64 + n] * rs2[8 + i]) + (impw[(16 + i) * 64 + n] * rs2[16 + i] + impw[(24 + i) * 64 + n] * rs2[24 + i]);
                    const unsigned key = valid ? ((__float_as_uint(sc) & ~63u) | (unsigned)(63 - n)) : 0u;
                    unsigned T = 0u;
#pragma unroll
                    for (int bit = 30; bit >= 0; --bit) { const unsigned cand = T | (1u << bit); const unsigned long long bm = __ballot(key >= cand); if (__popcll(bm) >= 16) T = cand; }
                    const unsigned long long mk = __ballot(valid && key >= T);
                    unionmask |= mk; if (tl == i) mymask = mk;
                }
            }
          }
        }
#pragma unroll
        for (int r = 0; r < 16; ++r) { const int qq = crow(r, hi); const size_t orow = (size_t)b * 4096 + qi * 64 + w * 8 + (qq & 7);
            bf16_t* op = OUT + orow * ldo + (g * 4 + (qq >> 3)) * 64 + q;
            op[0] = (bf16_t)(pk_bf16(ofin[0][r], 0.f) & 0xffffu); op[32] = (bf16_t)(pk_bf16(ofin[1][r], 0.f) & 0xffffu); }
        ATT_WAIT_BAR(0);
#undef ATT_ISSUE
    }
#undef ATT_WAIT_BAR
}
}


#define XB_TMO      128
#define XB_XCNT(j)  (256  + 64 * (j))
#define XB_XSUB(j)  (1280 + 64 * (j))
#define XB_XGEN(j)  (2304 + 64 * (j))
#define XB_TOP      3328
#define XB_TOPGEN   3392
#define XCD_BAR_WORDS 3456
#define XB_SPIN_CAP (1u << 22)
__device__ __forceinline__ unsigned xb_ld(unsigned* p)              { return __hip_atomic_load(p, __ATOMIC_RELAXED, __HIP_MEMORY_SCOPE_AGENT); }
__device__ __forceinline__ unsigned xb_add(unsigned* p, unsigned v) { return __hip_atomic_fetch_add(p, v, __ATOMIC_RELAXED, __HIP_MEMORY_SCOPE_AGENT); }
__device__ __forceinline__ unsigned xb_xcc_id() { return (unsigned)__builtin_amdgcn_s_getreg((3 << 11) | 20) & 0xFu; }
#define XB_SPIN(cond, bar) do { unsigned _sp = 0; while (cond) { __builtin_amdgcn_s_sleep(1); \
    if ((++_sp & 255u) == 0u) { if (xb_ld(&(bar)[XB_TMO])) break; if (_sp > XB_SPIN_CAP) { atomicAdd(&(bar)[XB_TMO], 1u); break; } } } } while (0)
struct XcdBarrier { unsigned* bar; unsigned x; volatile LAS unsigned* st; };
__device__ __forceinline__ void xcd_barrier_complete(unsigned* bar, unsigned x, unsigned& nloc, unsigned& nx) {
    const unsigned G = gridDim.x * gridDim.y * gridDim.z;
    unsigned sum, cnt, mine, sp = 0u;
    for (;;) {
        sum = 0u; cnt = 0u; mine = 0u;
#pragma unroll
        for (unsigned j = 0; j < 16; ++j) { const unsigned c = xb_ld(&bar[XB_XCNT(j)]); sum += c; cnt += (c > 0u) ? 1u : 0u; mine = (j == x) ? c : mine; }
        if (sum == G) break;
        __builtin_amdgcn_s_sleep(1);
        if ((++sp & 255u) == 0u) { if (xb_ld(&bar[XB_TMO])) break; if (sp > XB_SPIN_CAP) { atomicAdd(&bar[XB_TMO], 1u); break; } }
    }
    nloc = mine > 0u ? mine : 1u; nx = cnt > 0u ? cnt : 1u;
}
__device__ __forceinline__ void xcd_barrier(unsigned* bar, volatile LAS unsigned* st) {
    asm volatile("s_waitcnt vmcnt(0)" ::: "memory");
    __syncthreads();
    if (threadIdx.x == 0) {
        const unsigned x = xb_xcc_id();
        __builtin_amdgcn_s_waitcnt(0);
        unsigned nloc = st[0], nx = st[1];
        if (nloc == 0u) { xcd_barrier_complete(bar, x, nloc, nx); st[0] = nloc; st[1] = nx; }
        const unsigned old = xb_add(&bar[XB_XSUB(x)], 1u);
        const unsigned gen = old / nloc;
        if (old + 1u == (gen + 1u) * nloc) {
            __builtin_amdgcn_fence(__ATOMIC_RELEASE, "agent");
            asm volatile("s_waitcnt vmcnt(0)" ::: "memory");
            const unsigned og = xb_add(&bar[XB_TOP], 1u);
            const unsigned tg = og / nx;
            if (og + 1u == (tg + 1u) * nx) xb_add(&bar[XB_TOPGEN], 1u);
            else XB_SPIN(xb_ld(&bar[XB_TOPGEN]) == tg, bar);
            __builtin_amdgcn_fence(__ATOMIC_ACQUIRE, "agent");
            xb_add(&bar[XB_XGEN(x)], 1u);
            asm volatile("s_waitcnt vmcnt(0)" ::: "memory");
        } else {
            XB_SPIN(xb_ld(&bar[XB_XGEN(x)]) == gen, bar);
            __builtin_amdgcn_fence(__ATOMIC_ACQUIRE, "agent");
            asm volatile("s_waitcnt vmcnt(0)" ::: "memory");
        }
    }
    __syncthreads();
}

constexpr int LDS_BYTES = 155648;
constexpr int NPH = 16;

__device__ __forceinline__ unsigned char* opq(unsigned char* p) { asm volatile("" : "+s"(p)); return p; }
#define WSP(off) ((bf16_t*)(opq(a.ws) + (off)))
#define WSF(off) ((float*)(opq(a.ws) + (off)))

__global__ void __launch_bounds__(512, 2) mega(Args a) {
    extern __shared__ __attribute__((aligned(16))) unsigned char lds_raw[];
    LAS unsigned char* lds = (LAS unsigned char*)lds_raw;
    cg::grid_group grid = cg::this_grid();
    const int lo = a.ph_lo, hi = a.ph_hi;
    volatile LAS unsigned* xst = (volatile LAS unsigned*)(lds + 155648 - 64);
    if (threadIdx.x == 0) { xst[0] = 0u; xst[1] = 0u; if (hi - lo > 1) (void)xb_add(&((unsigned*)(a.ws + WS_BAR))[XB_XCNT(xb_xcc_id())], 1u); }
    __syncthreads();
#define IDS const int tid = tid_opq(), lane = tid & 63, wave = __builtin_amdgcn_readfirstlane(tid >> 6); const int G = gd_opq(), bx = bx_opq(); \
    const int gw = bx * 8 + wave, ngw = G * 8, gt = bx * 512 + tid, ngt = G * 512; (void)lane; (void)gw; (void)ngw; (void)gt; (void)ngt;
#define IN(k) (lo <= (l * NPH + (k)) && (l * NPH + (k)) < hi)
#define SEAM(k) do { if (lo <= (l * NPH + (k)) && (l * NPH + (k)) + 1 < hi) { if (hi < 0) grid.sync(); xcd_barrier((unsigned*)(opq(a.ws) + WS_BAR), xst); if (PROBE_SYNC2) xcd_barrier((unsigned*)(opq(a.ws) + WS_BAR), xst); } } while (0)
    for (int l = 0; l < DEPTH; ++l) {
        for (int rep_ = 0; rep_ < ((PROBE_DUP >> 0) & 1) + 1; ++rep_) if (IN(0)) {
            IDS
            weights_phase(a, l, lds, gw, ngw, wave, lane);
            rms_phase((l == 0) ? a.in[0] : a.out, a.in[1] + l * 1024, WSP(WS_H), gw, ngw, lane);
        }
        SEAM(0);
        for (int rep_ = 0; rep_ < ((PROBE_DUP >> 1) & 1) + 1; ++rep_) if (IN(1)) {
            pg8::StaticOrder S; pg8::Gemm g{WSP(WS_H), WSP(WS_W + W_INA), MTOK, 2048, 1024, 1024, 0, 0}; S.init(MTOK, 2048, gd_opq(), bx_opq());
            EpiInA E{WSP(WS_RX), WSP(WS_YO)}; pg8::gemm_phase<EpiInA>(lds, g, S, E);
        }
        SEAM(1);
        for (int rep_ = 0; rep_ < ((PROBE_DUP >> 2) & 1) + 1; ++rep_) if (IN(2)) {
            IDS
            const bf16_t* RX = WSP(WS_RX); bf16_t* XR = WSP(WS_XR); const bf16_t* Wc1 = WSP(WS_W + W_C1); float* bias1 = WSF(WS_CTL);
            const float* cw = a.in[3] + l * 4 * 1024; const float* cb = a.in[4] + l * 1024;
            for (int it0 = gt; it0 < MTOK * 128; it0 += 2 * ngt) {
                u32x4 xw[2][4]; int rowv[2], chv[2]; bool ok[2];
#pragma unroll
                for (int e = 0; e < 2; ++e) { const int it = it0 + e * ngt; ok[e] = it < MTOK * 128; const int itc = ok[e] ? it : it0; rowv[e] = itc >> 7; chv[e] = (itc & 127) * 8; const int s = rowv[e] & 4095;
#pragma unroll
                    for (int kk = 0; kk < 4; ++kk) xw[e][kk] = (s - 3 + kk >= 0) ? *(const u32x4*)(RX + (size_t)(rowv[e] - 3 + kk) * 1024 + chv[e]) : (u32x4){0u, 0u, 0u, 0u}; }
#pragma unroll
                for (int e = 0; e < 2; ++e) { const int ch = chv[e];
                    float acc[8];
#pragma unroll
                    for (int i = 0; i < 8; ++i) acc[i] = cb[ch + i];
#pragma unroll
                    for (int kk = 0; kk < 4; ++kk) { const u32x4 w4 = xw[e][kk];
                        const f32x4 c0 = *(const f32x4*)(cw + kk * 1024 + ch), c1 = *(const f32x4*)(cw + kk * 1024 + ch + 4);
                        acc[0] += c0[0] * bf_lo(w4.x); acc[1] += c0[1] * bf_hi(w4.x); acc[2] += c0[2] * bf_lo(w4.y); acc[3] += c0[3] * bf_hi(w4.y);
                        acc[4] += c1[0] * bf_lo(w4.z); acc[5] += c1[1] * bf_hi(w4.z); acc[6] += c1[2] * bf_lo(w4.w); acc[7] += c1[3] * bf_hi(w4.w); }
                    u32x4 o; o.x = pk_bf16(acc[0], acc[1]); o.y = pk_bf16(acc[2], acc[3]); o.z = pk_bf16(acc[4], acc[5]); o.w = pk_bf16(acc[6], acc[7]);
                    if (ok[e]) *(u32x4*)(XR + (size_t)rowv[e] * 1024 + ch) = o; } }
            if (gt < 1024) { const float lm = a.in[9][l * 1024 + gt]; const float e = __expf(-fabsf(lm)); const float lp = e < 0.03f ? e * (1.f - e * (0.5f - e * (0.33333333f - 0.25f * e))) : __logf(1.f + e); bias1[1024 + gt] = -8.f * LOG2E * (fmaxf(-lm, 0.f) + lp); }
            for (int j = gw; j < 512; j += ngw) { const float* pos = (j >> 8 ? a.in[13] : a.in[12]) + l * 2048; const bf16_t* wr_ = Wc1 + (size_t)j * 2048;
                float s = 0.f;
                for (int kk = lane; kk < 2048; kk += 64) s += pos[kk] * __uint_as_float((unsigned)wr_[kk] << 16);
                s = wave_sum(s); if (lane == 0) bias1[j] = s; }
        }
        SEAM(2);
        for (int rep_ = 0; rep_ < ((PROBE_DUP >> 3) & 1) + 1; ++rep_) if (IN(3)) {
            pg8::StaticOrder S; pg8::Gemm g{WSP(WS_XR), WSP(WS_W + W_G), MTOK, 2048, 256, 1024, 2, 0}; S.init(MTOK, 2048, gd_opq(), bx_opq());
            EpiGate E{WSP(WS_XR), WSP(WS_LA), WSP(WS_U), a.in[6] + l * 1024, a.in[8] + l * 1024, WSF(WS_CTL) + 1024}; pg8::gemm_phase<EpiGate>(lds, g, S, E);
        }
        SEAM(3);
        for (int rep_ = 0; rep_ < ((PROBE_DUP >> 4) & 1) + 1; ++rep_) if (IN(4)) {
            IDS
            const bf16_t* LA = WSP(WS_LA); const bf16_t* U = WSP(WS_U); float* AGA = WSF(WS_AGG); float* AGH = AGA + 8 * 64 * 1024;
            for (int it = gt; it < 8 * 64 * 512; it += ngt) { const int cp = it & 511, bc = it >> 9; const int ch = 2 * cp; const size_t row0 = (size_t)bc * 64;
                float s0 = 0.f, s1 = 0.f, h0 = 0.f, h1 = 0.f;
#pragma unroll 8
                for (int t = 0; t < 64; ++t) { const unsigned wl = *(const unsigned*)(LA + (row0 + t) * 1024 + ch), wu = *(const unsigned*)(U + (row0 + t) * 1024 + ch);
                    const float l0 = bf_lo(wl), l1 = bf_hi(wl); s0 += l0; s1 += l1; h0 = ex2(l0) * h0 + bf_lo(wu); h1 = ex2(l1) * h1 + bf_hi(wu); }
                *(f32x2*)(AGA + (size_t)bc * 1024 + ch) = (f32x2){ex2(s0), ex2(s1)}; *(f32x2*)(AGH + (size_t)bc * 1024 + ch) = (f32x2){h0, h1}; }
        }
        SEAM(4);
        if (IN(5)) {
            IDS
            const bf16_t* LA = WSP(WS_LA); const bf16_t* U = WSP(WS_U); bf16_t* YO = WSP(WS_YO); const float* AGA = WSF(WS_AGG); const float* AGH = AGA + 8 * 64 * 1024;
            for (int it = gt; it < 8 * 64 * 512; it += ngt) { const int cp = it & 511, bc = it >> 9; const int ch = 2 * cp; const size_t row0 = (size_t)bc * 64; const int c = bc & 63, b0 = bc - c;
                float h0 = 0.f, h1 = 0.f;
                {   int cc = 0;
                    for (; cc + 8 <= c; cc += 8) { f32x2 A[8], Hh[8];
#pragma unroll
                        for (int k = 0; k < 8; ++k) { A[k] = *(const f32x2*)(AGA + (size_t)(b0 + cc + k) * 1024 + ch); Hh[k] = *(const f32x2*)(AGH + (size_t)(b0 + cc + k) * 1024 + ch); }
#pragma unroll
                        for (int k = 0; k < 8; ++k) { h0 = A[k][0] * h0 + Hh[k][0]; h1 = A[k][1] * h1 + Hh[k][1]; } }
                    for (; cc < c; ++cc) { const f32x2 A = *(const f32x2*)(AGA + (size_t)(b0 + cc) * 1024 + ch), Hh = *(const f32x2*)(AGH + (size_t)(b0 + cc) * 1024 + ch); h0 = A[0] * h0 + Hh[0]; h1 = A[1] * h1 + Hh[1]; } }
                for (int t0 = 0; t0 < 64; t0 += 8) { unsigned wl[8], wu[8], gy[8];
#pragma unroll
                    for (int k = 0; k < 8; ++k) { wl[k] = *(const unsigned*)(LA + (row0 + t0 + k) * 1024 + ch); wu[k] = *(const unsigned*)(U + (row0 + t0 + k) * 1024 + ch); gy[k] = *(const unsigned*)(YO + (row0 + t0 + k) * 2048 + ch); }
#pragma unroll
                    for (int k = 0; k < 8; ++k) { h0 = ex2(bf_lo(wl[k])) * h0 + bf_lo(wu[k]); h1 = ex2(bf_hi(wl[k])) * h1 + bf_hi(wu[k]); gy[k] = pk_bf16(h0 * bf_lo(gy[k]), h1 * bf_hi(gy[k])); }
#pragma unroll
                    for (int k = 0; k < 8; ++k) *(unsigned*)(YO + (row0 + t0 + k) * 2048 + ch) = gy[k]; }
            }
        }
        SEAM(5);
        for (int rep_ = 0; rep_ < ((PROBE_DUP >> 6) & 1) + 1; ++rep_) if (IN(6)) {
            pg8::StaticOrder S; pg8::Gemm g{WSP(WS_H), WSP(WS_W + W_INB), MTOK, 4864, 1024, 1024, 0, 0}; S.init(MTOK, 4864, gd_opq(), bx_opq());
            EpiInB E{WSP(WS_YO), WSP(WS_RX), WSP(WS_LA), WSF(WS_NG), a.in[10] + l * 64, a.in[11] + l * 192}; pg8::gemm_phase<EpiInB>(lds, g, S, E);
        }
        SEAM(6);
        for (int rep_ = 0; rep_ < ((PROBE_DUP >> 7) & 1) + 1; ++rep_) if (IN(7)) {
            pg8::StaticOrder S; pg8::Gemm g{WSP(WS_RX), WSP(WS_W + W_C1), 16384, 256, 2048, 1024, 0, 32}; S.init(16384, 256, gd_opq(), bx_opq());
            EpiCmp1 E{WSP(WS_HID), WSF(WS_CTL)}; pg8::gemm_phase<EpiCmp1>(lds, g, S, E);
        }
        SEAM(7);
        for (int rep_ = 0; rep_ < ((PROBE_DUP >> 8) & 1) + 1; ++rep_) if (IN(8)) {
            IDS
            const bf16_t* HID = WSP(WS_HID); bf16_t* KC = WSP(WS_KC); bf16_t* VC = WSP(WS_VC);
            const float* kn0 = a.in[11] + l * 192;
            LAS float* w2s = (LAS float*)lds;
            for (int i = tid; i < 2 * 4096; i += 512) { const f32x4 v = (i < 4096) ? ((const f32x4*)(a.in[15] + (size_t)l * 16384))[i] : ((const f32x4*)(a.in[17] + (size_t)l * 16384))[i - 4096]; *(LAS f32x4*)(w2s + 4 * i) = v; }
            __syncthreads();
            for (int r0 = gw * 4; r0 < 16384; r0 += ngw * 4) {
                const int which = r0 >> 13;
                const LAS float* wq = w2s + which * 16384 + lane;
                const unsigned* hp = (const unsigned*)(HID + (size_t)r0 * 256);
                float acc0 = 0.f, acc1 = 0.f, acc2 = 0.f, acc3 = 0.f;
#pragma unroll 4
                for (int h2 = 0; h2 < 128; ++h2) {
                    const float w0 = wq[(2 * h2) * 64], w1 = wq[(2 * h2 + 1) * 64];
                    const unsigned x0 = hp[h2], x1 = hp[128 + h2], x2 = hp[256 + h2], x3 = hp[384 + h2];
                    acc0 += bf_lo(x0) * w0 + bf_hi(x0) * w1; acc1 += bf_lo(x1) * w0 + bf_hi(x1) * w1;
                    acc2 += bf_lo(x2) * w0 + bf_hi(x2) * w1; acc3 += bf_lo(x3) * w0 + bf_hi(x3) * w1; }
                float accv[4] = {acc0, acc1, acc2, acc3};
#pragma unroll
                for (int e = 0; e < 4; ++e) { const int r = r0 + e, rr = r & 8191, c = rr & 255, bgi = rr >> 8;
                    bf16_t* dst = (which ? VC : KC) + ((size_t)bgi * 256 + c) * 64;
                    float v = accv[e];
                    if (!which) { const float ss = wave_sum(v * v); v *= rsqrtf(ss * (1.f / 64.f) + EPS) * kn0[lane]; }
                    if (c == 255) v = 0.f;
                    dst[lane] = (bf16_t)(pk_bf16(v, 0.f) & 0xffffu); }
            }
            __syncthreads();
        }
        SEAM(8);
        if (IN(9)) {
            if (PROBE_DUP & (1 << 9)) att::attn_phase(lds, WSP(WS_RX), WSP(WS_KC), WSP(WS_VC), WSP(WS_YO), WSP(WS_H), 1024, WSF(WS_NG), a.in[10] + l * 64, a.in[11] + l * 192);
            att::attn_phase(lds, WSP(WS_RX), WSP(WS_KC), WSP(WS_VC), WSP(WS_YO), WSP(WS_YO) + 1024, 2048, WSF(WS_NG), a.in[10] + l * 64, a.in[11] + l * 192);
        }
        SEAM(9);
        if (IN(10)) {
            pg8::StaticOrder S; pg8::Gemm g{WSP(WS_YO), WSP(WS_W + W_YA), MTOK, 1024, 2048, 2048, 0, 0}; S.init(MTOK, 1024, gd_opq(), bx_opq());
            EpiMixM E{WSP(WS_H), WSP(WS_LA)}; pg8::gemm_phase<EpiMixM>(lds, g, S, E);
        }
        SEAM(10);
        if (IN(12)) {
            pg8::StaticOrder S; pg8::Gemm g{WSP(WS_H), WSP(WS_W + W_O), MTOK, 1024, 1024, 1024, 0, 0}; S.init(MTOK, 1024, gd_opq(), bx_opq());
            EpiRes E{(l == 0) ? a.in[0] : a.out, a.out}; pg8::gemm_phase<EpiRes>(lds, g, S, E);
        }
        SEAM(12);
        for (int rep_ = 0; rep_ < ((PROBE_DUP >> 13) & 1) + 1; ++rep_) if (IN(13)) {
            IDS
            rms_phase(a.out, a.in[21] + l * 1024, WSP(WS_H), gw, ngw, lane);
        }
        SEAM(13);
        for (int rep_ = 0; rep_ < ((PROBE_DUP >> 14) & 1) + 1; ++rep_) if (IN(14)) {
            pg8::StaticOrder S; pg8::Gemm g{WSP(WS_H), WSP(WS_W + W_GU), MTOK, 5632, 1024, 1024, 0, 0}; S.init(MTOK, 5632, gd_opq(), bx_opq());
            EpiSwi E{WSP(WS_RX)}; pg8::gemm_phase<EpiSwi>(lds, g, S, E);
        }
        SEAM(14);
        if (IN(15)) {
            pg8::StaticOrder S; pg8::Gemm g{WSP(WS_RX), WSP(WS_W + W_D), MTOK, 1024, D_FF, D_FF, 0, 0}; S.init(MTOK, 1024, gd_opq(), bx_opq());
            EpiRes E{a.out, a.out}; pg8::gemm_phase<EpiRes>(lds, g, S, E);
        }
        SEAM(15);
    }
#undef IDS
#undef IN
#undef SEAM
}

extern "C" void kernel_launch(void* const* d_in, const int* in_sizes, int n_in, void* d_out, int out_size, void* d_ws, size_t ws_size, hipStream_t stream) {
    static int grid = 0;
    if (grid == 0) {
        if (n_in != 25 || out_size != MTOK * DM || ws_size < WS_END) { fprintf(stderr, "kernel_launch: unexpected problem (n_in %d, out %d, ws %zu)\n", n_in, out_size, ws_size); grid = -1; return; }
        int dev = 0, cus = 0, per_cu = 0;
        hipGetDevice(&dev); hipDeviceGetAttribute(&cus, hipDeviceAttributeMultiprocessorCount, dev);
        hipFuncSetAttribute((const void*)mega, hipFuncAttributeMaxDynamicSharedMemorySize, LDS_BYTES);
        if (hipOccupancyMaxActiveBlocksPerMultiprocessor(&per_cu, (const void*)mega, 512, LDS_BYTES) != hipSuccess || per_cu < 1) per_cu = 1;
        (void)hipGetLastError();
        grid = cus * per_cu;
        if (grid <= 0) grid = 256;
    }
    if (grid < 0) return;
    Args a{};
    for (int i = 0; i < 25; ++i) a.in[i] = (const float*)d_in[i];
    a.out = (float*)d_out; a.ws = (unsigned char*)d_ws;
#if MK_MULTI
    for (int p = 0; p < DEPTH * NPH; ++p) { a.ph_lo = p; a.ph_hi = p + 1; hipLaunchKernelGGL(mega, dim3(grid), dim3(512), LDS_BYTES, stream, a); }
#else
    a.ph_lo = 0; a.ph_hi = DEPTH * NPH;
    (void)hipMemsetAsync((char*)d_ws + WS_BAR, 0, 16384, stream);
    void* args[] = {&a};
    hipError_t e = hipLaunchCooperativeKernel((const void*)mega, dim3(grid), dim3(512), args, LDS_BYTES, stream);
    if (e != hipSuccess) fprintf(stderr, "cooperative launch failed: %s (grid %d)\n", hipGetErrorString(e), grid);
#endif
}
```

```cpp
#include <hip/hip_runtime.h>
#include <hip/hip_cooperative_groups.h>
#include <cstdio>
#include <cstdint>
namespace cg = cooperative_groups;

#ifndef PROBE_SYNC2
#define PROBE_SYNC2 0
#endif
#ifndef PROBE_DUP
#define PROBE_DUP 0
#endif
#ifndef MK_MULTI
#define MK_MULTI 0
#endif

#define LAS __attribute__((address_space(3)))
typedef unsigned short bf16_t;
typedef short bf16x8 __attribute__((ext_vector_type(8)));
typedef short s16x4 __attribute__((ext_vector_type(4)));
typedef float f32x2 __attribute__((ext_vector_type(2)));
typedef float f32x4 __attribute__((ext_vector_type(4)));
typedef float f32x16 __attribute__((ext_vector_type(16)));
typedef unsigned u32x2 __attribute__((ext_vector_type(2)));
typedef unsigned u32x4 __attribute__((ext_vector_type(4)));
typedef __bf16 bf16x2_t __attribute__((ext_vector_type(2)));

constexpr int DM = 1024, NB = 8, SEQ = 4096, MTOK = NB * SEQ, DEPTH = 2;
constexpr int D_IN = 6704, D_FF = 2816;
constexpr float EPS = 1e-6f;
constexpr float LOG2E = 1.4426950408889634f;
constexpr float QSCALE = 0.125f * LOG2E;

constexpr size_t MiB = 1u << 20;
constexpr size_t WS_CTL = 0;
constexpr size_t WS_BAR = 65536;
constexpr size_t WS_W = 1 * MiB;
constexpr size_t W_INA = 0, W_INB = 4 * MiB, W_G = 14 * MiB, W_C1 = 15 * MiB, W_YA = 17 * MiB, W_YB = 19 * MiB, W_O = 21 * MiB, W_GU = 23 * MiB, W_D = 34 * MiB;
constexpr size_t WS_H = 41 * MiB;
constexpr size_t WS_RX = 105 * MiB;
constexpr size_t WS_XR = 169 * MiB;
constexpr size_t WS_LA = 233 * MiB;
constexpr size_t WS_U = 297 * MiB;
constexpr size_t WS_YO = 361 * MiB;
constexpr size_t WS_NG = 489 * MiB;
constexpr size_t WS_HID = 497 * MiB;
constexpr size_t WS_KC = 505 * MiB;
constexpr size_t WS_VC = 506 * MiB;
constexpr size_t WS_AGG = 507 * MiB;
constexpr size_t WS_END = 511 * MiB;
constexpr size_t KVBUF = (size_t)32 * 4096 * 64;

__device__ __forceinline__ int bx_opq() { int t = blockIdx.x; asm volatile("" : "+s"(t)); return t; }
__device__ __forceinline__ int gd_opq() { int t = gridDim.x; asm volatile("" : "+s"(t)); return t; }
__device__ __forceinline__ int tid_opq() { int t = threadIdx.x; asm volatile("" : "+v"(t)); return t; }
__device__ __forceinline__ unsigned pk_bf16(float lo, float hi) { f32x2 v = {lo, hi}; bf16x2_t b = __builtin_convertvector(v, bf16x2_t); return __builtin_bit_cast(unsigned, b); }
__device__ __forceinline__ float bf_lo(unsigned w) { return __uint_as_float(w << 16); }
__device__ __forceinline__ float bf_hi(unsigned w) { return __uint_as_float(w & 0xffff0000u); }
__device__ __forceinline__ float ex2(float x) { return __builtin_amdgcn_exp2f(x); }
__device__ __forceinline__ float sigm(float x) { return __builtin_amdgcn_rcpf(1.f + ex2(-LOG2E * x)); }
__device__ __forceinline__ float gelu_t(float x) { const float y = 1.5957691216057308f * (x + 0.044715f * x * x * x); return x * sigm(y); }
__device__ __forceinline__ float wave_sum(float v) {
#pragma unroll
    for (int o = 1; o < 64; o <<= 1) v += __shfl_xor(v, o);
    return v;
}
__device__ __forceinline__ float wave_max(float v) {
#pragma unroll
    for (int o = 1; o < 64; o <<= 1) v = fmaxf(v, __shfl_xor(v, o));
    return v;
}
__device__ __forceinline__ u32x4 pack8(const f32x4 a, const f32x4 b) { u32x4 w; w.x = pk_bf16(a[0], a[1]); w.y = pk_bf16(a[2], a[3]); w.z = pk_bf16(b[0], b[1]); w.w = pk_bf16(b[2], b[3]); return w; }

namespace pg8 {
constexpr int BM = 256, BK = 64, HALF = 128, HTB = HALF * BK * 2, STAGE_BYTES = 8 * HTB, NXCD = 8, WGM = 8;
__host__ __device__ __forceinline__ int lds_byte(int r, int c) { const int st = (r >> 4) * 2 + (c >> 5), rr = r & 15, cc = c & 31, ob = rr * 64 + cc * 2; return st * 1024 + (ob ^ (((ob >> 9) & 1) << 5)); }
__host__ __device__ __forceinline__ void stage_rc(int b, int& R, int& C) { const int st = b / 1024, sb = b % 1024, swz = sb ^ (((sb >> 9) & 1) << 5); R = (st >> 1) * 16 + swz / 64; C = (st & 1) * 32 + (swz % 64) / 2; }
__host__ __device__ __forceinline__ int perm32(int rho) { const int n = rho >> 4, i = rho & 15; return 8 * (i >> 2) + 4 * n + (i & 3); }

struct Unit { int pm, pn; };
struct Gemm { const bf16_t* A; const bf16_t* Bt; int M, N, K, lda, a_div, b_div; };

struct StaticOrder {
    int nM, nN, nwg, G, c;
    __device__ void init(int M, int N, int G_, int c_) { nM = M / BM; nN = N / BM; nwg = nM * nN; G = G_; c = c_; }
    __device__ bool next(int i, Unit& u) const {
        const long L = (long)i * G + c; if (L >= nwg) return false;
        int wgid = (int)L; { const int q = nwg / NXCD, r = nwg % NXCD, xcd = wgid % NXCD, off = wgid / NXCD; wgid = (xcd < r ? xcd * (q + 1) : r * (q + 1) + (xcd - r) * q) + off; }
        const int nig = WGM * nN, gid = wgid / nig, fm = gid * WGM, gsz = (nM - fm) < WGM ? (nM - fm) : WGM;
        u.pm = fm + ((wgid % nig) % gsz); u.pn = (wgid % nig) / gsz; return true;
    }
};
__device__ __forceinline__ const char* unitA(const Gemm& g, const Unit& u, size_t tstepA) { return (const char*)g.A + (size_t)u.pm * tstepA + (g.a_div ? (size_t)(u.pn / g.a_div) * (size_t)g.K * 2 : (size_t)0); }
__device__ __forceinline__ const char* unitB(const Gemm& g, const Unit& u, size_t tstepB) { return (const char*)g.Bt + (size_t)(u.pn + (g.b_div ? (u.pm / g.b_div) * (g.N / BM) : 0)) * tstepB; }

template <class Epi>
__device__ __forceinline__ void gemm_phase(LAS unsigned char* lds, const Gemm g, const StaticOrder& S, const Epi& E) {
    const int tid = tid_opq(), wid = __builtin_amdgcn_readfirstlane(tid >> 6), lane = tid & 63, wr = wid >> 2, wc = wid & 3, fr = lane & 15, fq = lane >> 4;
    const int K = g.K, nt = K / BK;
    unsigned voffA[2], voffB[2];
#pragma unroll
    for (int i = 0; i < 2; ++i) { int R, C; stage_rc(tid * 16 + i * 8192, R, C); const int Rb = Epi::PERM ? ((R & ~31) + perm32(R & 31)) : R;
        voffA[i] = (unsigned)(R * g.lda + C) * 2u; voffB[i] = (unsigned)(Rb * K + C) * 2u; }
    const size_t kstep = (size_t)(BK * 2);
    const size_t hstepA = (size_t)HALF * g.lda * 2, hstepB = (size_t)HALF * K * 2;
    const size_t tstepA = 2 * hstepA, tstepB = 2 * hstepB;
    const unsigned ldsw = (unsigned)wid * 1024u;
    const int aoff = lds_byte(wr * 64 + fr, fq * 8), boff = lds_byte(wc * 32 + fr, fq * 8);
#define PG8_SA(b, h) (((b) * 2 + (h)) * HTB)
#define PG8_SB(b, h) ((4 + (b) * 2 + (h)) * HTB)
#define PG8_STAGE(bufoff, gbase, voff) do { _Pragma("unroll") for (int _i = 0; _i < 2; ++_i) \
        __builtin_amdgcn_global_load_lds((const unsigned*)((const char*)(gbase) + (voff)[_i]), (LAS unsigned*)(lds + (bufoff) + ldsw + _i * 8192), 16, 0, 0); } while (0)
#define PG8_LDA(dst, b, h) do { _Pragma("unroll") for (int m = 0; m < 4; ++m) _Pragma("unroll") for (int k = 0; k < 2; ++k) dst[m][k] = *(const LAS bf16x8*)(lds + PG8_SA(b, h) + aoff + m * 2048 + k * 1024); } while (0)
#define PG8_LDB(dst, b, h) do { _Pragma("unroll") for (int n = 0; n < 2; ++n) _Pragma("unroll") for (int k = 0; k < 2; ++k) dst[n][k] = *(const LAS bf16x8*)(lds + PG8_SB(b, h) + boff + n * 2048 + k * 1024); } while (0)
#define PG8_MMA(ai, bj, At, Bt) do { __builtin_amdgcn_s_setprio(1); _Pragma("unroll") for (int m = 0; m < 4; ++m) _Pragma("unroll") for (int n = 0; n < 2; ++n) _Pragma("unroll") for (int k = 0; k < 2; ++k) \
        acc[ai][bj][m][n] = __builtin_amdgcn_mfma_f32_16x16x32_bf16(Bt[n][k], At[m][k], acc[ai][bj][m][n], 0, 0, 0); __builtin_amdgcn_s_setprio(0); } while (0)
#define PG8_WAIT_V(n) asm volatile("s_waitcnt vmcnt(" #n ")" ::: "memory")
#define PG8_WAIT_L(n) asm volatile("s_waitcnt lgkmcnt(" #n ")" ::: "memory")
#define PG8_BAR __builtin_amdgcn_s_barrier()
#define PG8_SCHED __builtin_amdgcn_sched_barrier(0)
    Unit cur, nxt; int ui = 0;
    if (!S.next(0, cur)) return;
    f32x4 acc[2][2][4][2];
#pragma unroll
    for (int a = 0; a < 2; ++a)
#pragma unroll
        for (int b = 0; b < 2; ++b)
#pragma unroll
            for (int m = 0; m < 4; ++m)
#pragma unroll
                for (int n = 0; n < 2; ++n) acc[a][b][m][n] = (f32x4){0.f, 0.f, 0.f, 0.f};
    bf16x8 At[4][2], B0[2][2], B1[2][2];
    const char* cA = unitA(g, cur, tstepA); const char* cB = unitB(g, cur, tstepB);
    PG8_STAGE(PG8_SB(0, 0), cB, voffB); PG8_STAGE(PG8_SB(0, 1), cB + hstepB, voffB); PG8_STAGE(PG8_SA(0, 0), cA, voffA); PG8_STAGE(PG8_SA(0, 1), cA + hstepA, voffA);
    if (wr == 1) PG8_BAR;
    PG8_WAIT_V(2); PG8_BAR;
    PG8_STAGE(PG8_SB(1, 0), cB + kstep, voffB); PG8_STAGE(PG8_SA(1, 0), cA + kstep, voffA); PG8_STAGE(PG8_SB(1, 1), cB + hstepB + kstep, voffB);
    PG8_WAIT_V(6); PG8_BAR;
    for (;;) {
        const bool has_next = S.next(ui + 1, nxt);
        const char* nA = has_next ? unitA(g, nxt, tstepA) : cA; const char* nB = has_next ? unitB(g, nxt, tstepB) : cB;
#pragma unroll 1
        for (int t = 0; t < nt; t += 2) {
            const bool last = (t == nt - 2);
            const char* a1 = cA + (size_t)(t + 1) * kstep;
            const char* a2 = last ? nA : cA + (size_t)(t + 2) * kstep; const char* b2 = last ? nB : cB + (size_t)(t + 2) * kstep;
            const char* a3 = a2 + kstep; const char* b3 = b2 + kstep;
            if constexpr (Epi::MID) { if (t == nt / 2) E.mid(acc, cur, wr, wc, fr, fq); }
            PG8_LDB(B0, 0, 0); PG8_LDB(B1, 0, 1); PG8_SCHED; PG8_LDA(At, 0, 0); PG8_STAGE(PG8_SA(1, 1), a1 + hstepA, voffA);
            PG8_WAIT_V(8); PG8_WAIT_L(0); PG8_BAR; PG8_MMA(0, 0, At, B0); PG8_MMA(0, 1, At, B1); PG8_BAR; PG8_SCHED;
            PG8_LDA(At, 0, 1); PG8_STAGE(PG8_SB(0, 0), b2, voffB); PG8_STAGE(PG8_SB(0, 1), b2 + hstepB, voffB); PG8_STAGE(PG8_SA(0, 0), a2, voffA);
            PG8_WAIT_V(8); PG8_WAIT_L(0); PG8_BAR; PG8_MMA(1, 0, At, B0); PG8_MMA(1, 1, At, B1); PG8_BAR; PG8_SCHED;
            PG8_LDB(B0, 1, 0); PG8_LDB(B1, 1, 1); PG8_SCHED; PG8_LDA(At, 1, 0); PG8_STAGE(PG8_SA(0, 1), a2 + hstepA, voffA);
            PG8_WAIT_V(8); PG8_WAIT_L(0); PG8_BAR; PG8_MMA(0, 0, At, B0); PG8_MMA(0, 1, At, B1); PG8_BAR; PG8_SCHED;
            PG8_LDA(At, 1, 1); PG8_STAGE(PG8_SB(1, 0), b3, voffB); PG8_STAGE(PG8_SB(1, 1), b3 + hstepB, voffB); PG8_STAGE(PG8_SA(1, 0), a3, voffA);
            PG8_WAIT_V(8); PG8_WAIT_L(0); PG8_BAR; PG8_MMA(1, 0, At, B0); PG8_MMA(1, 1, At, B1); PG8_BAR; PG8_SCHED;
        }
        if (wr == 0) PG8_BAR;
        E(acc, cur, wr, wc, fr, fq);
        if (!has_next) break;
#pragma unroll
        for (int a = 0; a < 2; ++a)
#pragma unroll
            for (int b = 0; b < 2; ++b)
#pragma unroll
                for (int m = 0; m < 4; ++m)
#pragma unroll
                    for (int n = 0; n < 2; ++n) acc[a][b][m][n] = (f32x4){0.f, 0.f, 0.f, 0.f};
        cur = nxt; cA = nA; cB = nB; ++ui;
        if (wr == 1) PG8_BAR;
    }
    PG8_WAIT_V(0);
    PG8_BAR;
#undef PG8_SA
#undef PG8_SB
#undef PG8_STAGE
#undef PG8_LDA
#undef PG8_LDB
#undef PG8_MMA
#undef PG8_WAIT_V
#undef PG8_WAIT_L
#undef PG8_BAR
#undef PG8_SCHED
}
}
using pg8::Unit;
typedef const f32x4 (&AccRef)[2][2][4][2];

struct EpiInA {
    static constexpr bool PERM = true, MID = false;
    bf16_t* RX; bf16_t* YO;
    __device__ __forceinline__ void operator()(AccRef acc, const Unit& u, int wr, int wc, int fr, int fq) const {
        const bool isy = u.pn >= 4; bf16_t* base = isy ? YO : RX; const int ldc = isy ? 2048 : 1024;
        const int row0 = u.pm * 256 + wr * 64 + fr, col0 = (u.pn & 3) * 256 + wc * 32 + 8 * fq;
#pragma unroll
        for (int ai = 0; ai < 2; ++ai)
#pragma unroll
            for (int m = 0; m < 4; ++m) { bf16_t* rowp = base + (size_t)(row0 + ai * 128 + m * 16) * ldc + col0;
#pragma unroll
                for (int bj = 0; bj < 2; ++bj) { f32x4 v0 = acc[ai][bj][m][0], v1 = acc[ai][bj][m][1];
                    if (isy) {
#pragma unroll
                        for (int i = 0; i < 4; ++i) { v0[i] = gelu_t(v0[i]); v1[i] = gelu_t(v1[i]); } }
                    *(u32x4*)(rowp + bj * 128) = pack8(v0, v1); } }
    }
};
struct EpiInB {
    static constexpr bool PERM = true, MID = false;
    bf16_t* YO; bf16_t* KVB; bf16_t* MG; float* NG; const float* qn; const float* kn;
    __device__ __forceinline__ void operator()(AccRef acc, const Unit& u, int wr, int wc, int fr, int fq) const {
        const int t = u.pn; const int row0 = u.pm * 256 + wr * 64 + fr;
        if (t < 10) {
            const bool isq = t < 4; const bool nrm = isq || t == 6 || t == 8;
            const float* gw = isq ? qn : (kn + (t == 6 ? 64 : 128));
            const float osc = isq ? QSCALE : 1.f;
#pragma unroll
            for (int ai = 0; ai < 2; ++ai)
#pragma unroll
                for (int m = 0; m < 4; ++m) {
                    const int row = row0 + ai * 128 + m * 16;
                    float rinv = 1.f;
                    if (nrm) { float ss = 0.f;
#pragma unroll
                        for (int bj = 0; bj < 2; ++bj)
#pragma unroll
                            for (int n = 0; n < 2; ++n) { const f32x4 x = acc[ai][bj][m][n]; ss += (x[0] * x[0] + x[1] * x[1]) + (x[2] * x[2] + x[3] * x[3]); }
                        ss += __shfl_xor(ss, 16); ss += __shfl_xor(ss, 32);
                        rinv = rsqrtf(ss * (1.f / 64.f) + EPS) * osc; }
                    bf16_t* dst;
                    if (isq) dst = YO + (size_t)row * 2048 + 1024 + (t * 4 + wc) * 64 + 8 * fq;
                    else { const int b = row >> 12, s = row & 4095; dst = KVB + (size_t)(t - 4) * KVBUF + ((size_t)(b * 4 + wc) * 4096 + s) * 64 + 8 * fq; }
#pragma unroll
                    for (int bj = 0; bj < 2; ++bj) { const f32x4 g0 = nrm ? *(const f32x4*)(gw + 32 * bj + 8 * fq) : (f32x4){1.f, 1.f, 1.f, 1.f}, g1 = nrm ? *(const f32x4*)(gw + 32 * bj + 8 * fq + 4) : (f32x4){1.f, 1.f, 1.f, 1.f};
                        const f32x4 v0 = acc[ai][bj][m][0] * rinv * g0, v1 = acc[ai][bj][m][1] * rinv * g1;
                        *(u32x4*)(dst + 32 * bj) = pack8(v0, v1); }
                }
        } else if (t < 18) {
#pragma unroll
            for (int ai = 0; ai < 2; ++ai)
#pragma unroll
                for (int m = 0; m < 4; ++m) { bf16_t* dst = MG + (size_t)(row0 + ai * 128 + m * 16) * 2048 + (t - 10) * 256 + 64 * wc + 8 * fq;
#pragma unroll
                    for (int bj = 0; bj < 2; ++bj) { f32x4 v0 = acc[ai][bj][m][0], v1 = acc[ai][bj][m][1];
#pragma unroll
                        for (int i = 0; i < 4; ++i) { v0[i] = sigm(v0[i]); v1[i] = sigm(v1[i]); }
                        *(u32x4*)(dst + 32 * bj) = pack8(v0, v1); } }
        } else if (wc == 0) {
#pragma unroll
            for (int ai = 0; ai < 2; ++ai)
#pragma unroll
                for (int m = 0; m < 4; ++m) { float* dst = NG + (size_t)(row0 + ai * 128 + m * 16) * 64 + 8 * fq;
#pragma unroll
                    for (int bj = 0; bj < 2; ++bj)
#pragma unroll
                        for (int n = 0; n < 2; ++n) { f32x4 v = acc[ai][bj][m][n];
#pragma unroll
                            for (int i = 0; i < 4; ++i) v[i] = sigm(v[i]);
                            *(f32x4*)(dst + 32 * bj + 4 * n) = v; } }
        }
    }
};
struct EpiGate {
    static constexpr bool PERM = true, MID = false;
    const bf16_t* XR; bf16_t* LA; bf16_t* U; const float* ba; const float* bi; const float* lam;
    __device__ __forceinline__ void operator()(AccRef acc, const Unit& u, int wr, int wc, int fr, int fq) const {
        const int row0 = u.pm * 256 + wr * 64 + fr;
#pragma unroll
        for (int n = 0; n < 2; ++n) {
            const int ch0 = u.pn * 128 + wc * 32 + 8 * fq + 4 * n;
            const f32x4 bav = *(const f32x4*)(ba + ch0), biv = *(const f32x4*)(bi + ch0), spv = *(const f32x4*)(lam + ch0);
#pragma unroll
            for (int ai = 0; ai < 2; ++ai) {
                u32x2 xwv[4];
#pragma unroll
                for (int m = 0; m < 4; ++m) xwv[m] = *(const u32x2*)(XR + (size_t)(row0 + ai * 128 + m * 16) * 1024 + ch0);
#pragma unroll
                for (int m = 0; m < 4; ++m) { const int row = row0 + ai * 128 + m * 16; const bool first = (row & 4095) == 0;
                    const u32x2 xw = xwv[m];
                    const float xv[4] = {bf_lo(xw.x), bf_hi(xw.x), bf_lo(xw.y), bf_hi(xw.y)};
                    float la[4], uu[4];
#pragma unroll
                    for (int i = 0; i < 4; ++i) { const float rp = acc[ai][0][m][n][i] + bav[i], ip = acc[ai][1][m][n][i] + biv[i];
                        const float l2 = sigm(rp) * spv[i];
                        const float a2 = ex2(2.f * l2); float mult = __builtin_amdgcn_sqrtf(fmaxf(1.f - a2, 0.f)); if (first) mult = 1.f;
                        la[i] = l2; uu[i] = mult * sigm(ip) * xv[i]; }
                    u32x2 w0, w1; w0.x = pk_bf16(la[0], la[1]); w0.y = pk_bf16(la[2], la[3]); w1.x = pk_bf16(uu[0], uu[1]); w1.y = pk_bf16(uu[2], uu[3]);
                    *(u32x2*)(LA + (size_t)row * 1024 + ch0) = w0; *(u32x2*)(U + (size_t)row * 1024 + ch0) = w1; } }
        }
    }
};
struct EpiCmp1 {
    static constexpr bool PERM = true, MID = false;
    bf16_t* HID; const float* bias1;
    __device__ __forceinline__ void operator()(AccRef acc, const Unit& u, int wr, int wc, int fr, int fq) const {
        const int which = u.pm >> 5; const int row0 = u.pm * 256 + wr * 64 + fr;
#pragma unroll
        for (int ai = 0; ai < 2; ++ai)
#pragma unroll
            for (int m = 0; m < 4; ++m) { bf16_t* dst = HID + (size_t)(row0 + ai * 128 + m * 16) * 256 + wc * 32 + 8 * fq;
#pragma unroll
                for (int bj = 0; bj < 2; ++bj) { const float* bp = bias1 + which * 256 + bj * 128 + wc * 32 + 8 * fq;
                    f32x4 v0 = acc[ai][bj][m][0] + *(const f32x4*)bp, v1 = acc[ai][bj][m][1] + *(const f32x4*)(bp + 4);
#pragma unroll
                    for (int i = 0; i < 4; ++i) { v0[i] = gelu_t(v0[i]); v1[i] = gelu_t(v1[i]); }
                    *(u32x4*)(dst + bj * 128) = pack8(v0, v1); } }
    }
};
template <int ADD> struct EpiMix {
    static constexpr bool PERM = true, MID = false;
    bf16_t* MB; const bf16_t* MG; int sel;
    __device__ __forceinline__ void operator()(AccRef acc, const Unit& u, int wr, int wc, int fr, int fq) const {
        const int row0 = u.pm * 256 + wr * 64 + fr, col0 = u.pn * 256 + wc * 32 + 8 * fq;
#pragma unroll
        for (int ai = 0; ai < 2; ++ai)
#pragma unroll
            for (int mp = 0; mp < 2; ++mp) {
                u32x4 gwv[2][2], owv[2][2];
#pragma unroll
                for (int mm = 0; mm < 2; ++mm)
#pragma unroll
                    for (int bj = 0; bj < 2; ++bj) { const int row = row0 + ai * 128 + (2 * mp + mm) * 16, col = col0 + bj * 128;
                        gwv[mm][bj] = *(const u32x4*)(MG + (size_t)row * 2048 + sel * 1024 + col);
                        owv[mm][bj] = ADD ? *(const u32x4*)(MB + (size_t)row * 1024 + col) : (u32x4){0u, 0u, 0u, 0u}; }
#pragma unroll
                for (int mm = 0; mm < 2; ++mm)
#pragma unroll
                    for (int bj = 0; bj < 2; ++bj) { const int row = row0 + ai * 128 + (2 * mp + mm) * 16, col = col0 + bj * 128; const u32x4 gw = gwv[mm][bj], ow = owv[mm][bj];
                        f32x4 v0 = acc[ai][bj][2 * mp + mm][0], v1 = acc[ai][bj][2 * mp + mm][1];
                        v0[0] *= bf_lo(gw.x); v0[1] *= bf_hi(gw.x); v0[2] *= bf_lo(gw.y); v0[3] *= bf_hi(gw.y);
                        v1[0] *= bf_lo(gw.z); v1[1] *= bf_hi(gw.z); v1[2] *= bf_lo(gw.w); v1[3] *= bf_hi(gw.w);
                        if (ADD) { v0[0] += bf_lo(ow.x); v0[1] += bf_hi(ow.x); v0[2] += bf_lo(ow.y); v0[3] += bf_hi(ow.y);
                            v1[0] += bf_lo(ow.z); v1[1] += bf_hi(ow.z); v1[2] += bf_lo(ow.w); v1[3] += bf_hi(ow.w); }
                        *(u32x4*)(MB + (size_t)row * 1024 + col) = pack8(v0, v1); } }
    }
};
struct EpiMixM {
    static constexpr bool PERM = true, MID = true;
    bf16_t* MB; const bf16_t* MG;
    __device__ __forceinline__ void mid(f32x4 (&acc)[2][2][4][2], const Unit& u, int wr, int wc, int fr, int fq) const {
        int row0 = u.pm * 256 + wr * 64 + fr, col0 = u.pn * 256 + wc * 32 + 8 * fq; asm volatile("" : "+v"(row0), "+v"(col0));
#pragma unroll
        for (int ai = 0; ai < 2; ++ai)
#pragma unroll
            for (int m = 0; m < 4; ++m)
#pragma unroll
                for (int bj = 0; bj < 2; ++bj) { const bf16_t* gp = MG + (size_t)(row0 + ai * 128 + m * 16) * 2048 + col0 + bj * 128;
                    const u32x4 g0 = *(const u32x4*)gp, g1 = *(const u32x4*)(gp + 1024);
                    f32x4 r0, r1;
                    r0[0] = bf_lo(g0.x) * __builtin_amdgcn_rcpf(bf_lo(g1.x)); r0[1] = bf_hi(g0.x) * __builtin_amdgcn_rcpf(bf_hi(g1.x)); r0[2] = bf_lo(g0.y) * __builtin_amdgcn_rcpf(bf_lo(g1.y)); r0[3] = bf_hi(g0.y) * __builtin_amdgcn_rcpf(bf_hi(g1.y));
                    r1[0] = bf_lo(g0.z) * __builtin_amdgcn_rcpf(bf_lo(g1.z)); r1[1] = bf_hi(g0.z) * __builtin_amdgcn_rcpf(bf_hi(g1.z)); r1[2] = bf_lo(g0.w) * __builtin_amdgcn_rcpf(bf_lo(g1.w)); r1[3] = bf_hi(g0.w) * __builtin_amdgcn_rcpf(bf_hi(g1.w));
                    acc[ai][bj][m][0] *= r0; acc[ai][bj][m][1] *= r1; }
    }
    __device__ __forceinline__ void operator()(AccRef acc, const Unit& u, int wr, int wc, int fr, int fq) const {
        const int row0 = u.pm * 256 + wr * 64 + fr, col0 = u.pn * 256 + wc * 32 + 8 * fq;
#pragma unroll
        for (int ai = 0; ai < 2; ++ai)
#pragma unroll
            for (int m = 0; m < 4; ++m)
#pragma unroll
                for (int bj = 0; bj < 2; ++bj) { const int row = row0 + ai * 128 + m * 16, col = col0 + bj * 128;
                    const u32x4 gw = *(const u32x4*)(MG + (size_t)row * 2048 + 1024 + col);
                    f32x4 v0 = acc[ai][bj][m][0], v1 = acc[ai][bj][m][1];
                    v0[0] *= bf_lo(gw.x); v0[1] *= bf_hi(gw.x); v0[2] *= bf_lo(gw.y); v0[3] *= bf_hi(gw.y);
                    v1[0] *= bf_lo(gw.z); v1[1] *= bf_hi(gw.z); v1[2] *= bf_lo(gw.w); v1[3] *= bf_hi(gw.w);
                    *(u32x4*)(MB + (size_t)row * 1024 + col) = pack8(v0, v1); }
    }
};
struct EpiRes {
    static constexpr bool PERM = false, MID = false;
    const float* base; float* out;
    __device__ __forceinline__ void operator()(AccRef acc, const Unit& u, int wr, int wc, int fr, int fq) const {
        const int row0 = u.pm * 256 + wr * 64 + fr, col0 = u.pn * 256 + wc * 32 + 4 * fq;
#pragma unroll
        for (int ai = 0; ai < 2; ++ai)
#pragma unroll
            for (int mp = 0; mp < 2; ++mp) {
                f32x4 bs[2][2][2];
#pragma unroll
                for (int mm = 0; mm < 2; ++mm) { const size_t off = (size_t)(row0 + ai * 128 + (2 * mp + mm) * 16) * 1024 + col0;
#pragma unroll
                    for (int bj = 0; bj < 2; ++bj)
#pragma unroll
                        for (int n = 0; n < 2; ++n) bs[mm][bj][n] = *(const f32x4*)(base + off + bj * 128 + n * 16); }
#pragma unroll
                for (int mm = 0; mm < 2; ++mm) { const size_t off = (size_t)(row0 + ai * 128 + (2 * mp + mm) * 16) * 1024 + col0;
#pragma unroll
                    for (int bj = 0; bj < 2; ++bj)
#pragma unroll
                        for (int n = 0; n < 2; ++n) *(f32x4*)(out + off + bj * 128 + n * 16) = bs[mm][bj][n] + acc[ai][bj][2 * mp + mm][n]; } }
    }
};
struct EpiSwi {
    static constexpr bool PERM = true, MID = false;
    bf16_t* ACT;
    __device__ __forceinline__ void operator()(AccRef acc, const Unit& u, int wr, int wc, int fr, int fq) const {
        const int row0 = u.pm * 256 + wr * 64 + fr, ch0 = u.pn * 128 + wc * 32 + 8 * fq;
#pragma unroll
        for (int ai = 0; ai < 2; ++ai)
#pragma unroll
            for (int m = 0; m < 4; ++m) { f32x4 v0, v1;
#pragma unroll
                for (int i = 0; i < 4; ++i) { const float g0 = acc[ai][0][m][0][i], g1 = acc[ai][0][m][1][i];
                    v0[i] = g0 * sigm(g0) * acc[ai][1][m][0][i]; v1[i] = g1 * sigm(g1) * acc[ai][1][m][1][i]; }
                *(u32x4*)(ACT + (size_t)(row0 + ai * 128 + m * 16) * D_FF + ch0) = pack8(v0, v1); }
    }
};

__device__ __forceinline__ void xpose_item(const float* W, int Ns, int col0, int valid, bf16_t* dst, int K, int k0, LAS float* scr, int lane) {
#pragma unroll
    for (int i = 0; i < 32; ++i) { const int kk = 2 * i + (lane >> 5), n = lane & 31; scr[kk * 33 + n] = (n < valid) ? W[(size_t)(k0 + kk) * Ns + col0 + n] : 0.f; }
    asm volatile("s_waitcnt lgkmcnt(0)" ::: "memory");
    const int c = lane & 7;
#pragma unroll
    for (int j = 0; j < 4; ++j) { const int n = (lane >> 3) + 8 * j; const LAS float* s = scr + (8 * c) * 33 + n;
        u32x4 o; o.x = pk_bf16(s[0 * 33], s[1 * 33]); o.y = pk_bf16(s[2 * 33], s[3 * 33]); o.z = pk_bf16(s[4 * 33], s[5 * 33]); o.w = pk_bf16(s[6 * 33], s[7 * 33]);
        *(u32x4*)(dst + (size_t)n * K + k0 + 8 * c) = o; }
    asm volatile("s_waitcnt lgkmcnt(0)" ::: "memory");
}

struct Args { const float* in[25]; float* out; unsigned char* ws; int ph_lo, ph_hi; };
__device__ __forceinline__ unsigned char* opq(unsigned char* p);

__device__ __forceinline__ void weights_phase(const Args& a, int l, LAS unsigned char* lds, int gw, int ngw, int wave, int lane) {
    LAS float* scr = (LAS float*)(lds + wave * 16384);
    bf16_t* Wb = (bf16_t*)(opq(a.ws) + WS_W);
    const float* w_in = a.in[2] + (size_t)l * 1024 * D_IN;
    constexpr int I1 = 16 * 64, I2 = 16 * 152, I3 = 4 * 64, I4 = 32 * 16, I5 = 16 * 32, I6 = 16 * 176, I7 = 44 * 32;
    constexpr int NIT = I1 + I2 + I3 + I4 + 3 * I5 + I6 + I7;
    for (int it = gw; it < NIT; it += ngw) {
        int r = it;
        if (r < I1) { const int kb = r / 64, gi = r % 64; xpose_item(w_in, D_IN, 32 * gi, 32, Wb + W_INA / 2 + (size_t)(32 * gi) * 1024, 1024, 64 * kb, scr, lane); continue; } r -= I1;
        if (r < I2) { const int kb = r / 152, gi = r % 152; const int t = gi >> 3, gl = gi & 7, ca = 64 * (gl & 3) + 32 * (gl >> 2);
            int col0, valid = 32;
            if (t < 10) col0 = 2048 + 256 * t + ca; else if (t < 18) col0 = 4656 + 256 * (t - 10) + ca; else { col0 = 4608 + ca; valid = 48 - ca; valid = valid < 0 ? 0 : (valid > 32 ? 32 : valid); }
            xpose_item(w_in, D_IN, col0, valid, Wb + W_INB / 2 + (size_t)(32 * gi) * 1024, 1024, 64 * kb, scr, lane); continue; } r -= I2;
        if (r < I3) { const int kb = r / 64, gi = r % 64; const int pn = gi >> 3, gl = gi & 7, bj = gl >> 2, ch = 128 * pn + 32 * (gl & 3);
            const float* W = (bj ? a.in[7] : a.in[5]) + (size_t)l * 4 * 65536 + (size_t)(ch >> 8) * 65536;
            xpose_item(W, 256, ch & 255, 32, Wb + W_G / 2 + (size_t)(32 * gi) * 256, 256, 64 * kb, scr, lane); continue; } r -= I3;
        if (r < I4) { const int kb = r / 16, gi = r % 16; const float* W = ((gi >> 3) ? a.in[16] : a.in[14]) + (size_t)l * 2048 * 256;
            xpose_item(W, 256, 32 * (gi & 7), 32, Wb + W_C1 / 2 + (size_t)(32 * gi) * 2048, 2048, 64 * kb, scr, lane); continue; } r -= I4;
        if (r < 3 * I5) { const int which = r / I5; r -= which * I5; const int kb = r / 32, gi = r % 32;
            const float* W = a.in[18 + which] + (size_t)l * 1024 * 1024;
            if (which < 2) xpose_item(W, 1024, 32 * gi, 32, Wb + W_YA / 2 + (size_t)(32 * gi) * 2048 + which * 1024, 2048, 64 * kb, scr, lane);
            else xpose_item(W, 1024, 32 * gi, 32, Wb + W_O / 2 + (size_t)(32 * gi) * 1024, 1024, 64 * kb, scr, lane);
            continue; } r -= 3 * I5;
        if (r < I6) { const int kb = r / 176, gi = r % 176; const int pn = gi >> 3, gl = gi & 7, bj = gl >> 2;
            const float* W = (bj ? a.in[23] : a.in[22]) + (size_t)l * 1024 * D_FF;
            xpose_item(W, D_FF, 128 * pn + 32 * (gl & 3), 32, Wb + W_GU / 2 + (size_t)(32 * gi) * 1024, 1024, 64 * kb, scr, lane); continue; } r -= I6;
        { const int kb = r / 32, gi = r % 32; const float* W = a.in[24] + (size_t)l * D_FF * 1024;
            xpose_item(W, 1024, 32 * gi, 32, Wb + W_D / 2 + (size_t)(32 * gi) * D_FF, D_FF, 64 * kb, scr, lane); }
    }
}

__device__ __forceinline__ void rms_phase(const float* x, const float* g, bf16_t* out, int gw, int ngw, int lane) {
    f32x4 gv[4];
#pragma unroll
    for (int j = 0; j < 4; ++j) gv[j] = ((const f32x4*)g)[lane + 64 * j];
    for (int m0 = gw; m0 < MTOK; m0 += 4 * ngw) {
        f32x4 v[4][4];
#pragma unroll
        for (int e = 0; e < 4; ++e) { const int m = m0 + e * ngw; const f32x4* xr = (const f32x4*)(x + (size_t)(m < MTOK ? m : m0) * 1024) + lane;
#pragma unroll
            for (int j = 0; j < 4; ++j) v[e][j] = xr[64 * j]; }
#pragma unroll
        for (int e = 0; e < 4; ++e) { const int m = m0 + e * ngw; float s = 0.f;
#pragma unroll
            for (int j = 0; j < 4; ++j) s += (v[e][j][0] * v[e][j][0] + v[e][j][1] * v[e][j][1]) + (v[e][j][2] * v[e][j][2] + v[e][j][3] * v[e][j][3]);
            const float rinv = rsqrtf(wave_sum(s) * (1.f / 1024.f) + EPS);
            if (m < MTOK) { u32x2* o8 = (u32x2*)(out + (size_t)m * 1024) + lane;
#pragma unroll
                for (int j = 0; j < 4; ++j) { u32x2 w; w.x = pk_bf16(v[e][j][0] * rinv * gv[j][0], v[e][j][1] * rinv * gv[j][1]); w.y = pk_bf16(v[e][j][2] * rinv * gv[j][2], v[e][j][3] * rinv * gv[j][3]); o8[64 * j] = w; } } }
    }
}

namespace att {
constexpr int NST = 5, DEPTH_INFLIGHT = 4;
constexpr int STAGE = 16384;
constexpr int OFF_WS = NST * STAGE, WS_PER_WAVE = 8192 + 256;
__device__ __forceinline__ int crow(int r, int hi) { return (r & 3) + 8 * (r >> 2) + 4 * hi; }
__device__ __forceinline__ s16x4 vtr(const LAS unsigned char* p) { typedef short v4i16_t __attribute__((ext_vector_type(4))); return __builtin_bit_cast(s16x4, __builtin_amdgcn_ds_read_tr16_b64_v4i16((LAS v4i16_t*)p)); }

__device__ __forceinline__ void job_decode(int j, int nct, int qi, int kt0, int& type, int& tile) {
    if (j < nct) { type = 1; tile = j; } else if (j < nct + qi + 1) { type = 2; tile = j - nct; } else { type = 3; tile = kt0 + (j - nct - qi - 1); }
}

__device__ __forceinline__ void attn_phase(LAS unsigned char* lds, const bf16_t* KVB, const bf16_t* KC, const bf16_t* VC, const bf16_t* YO, bf16_t* OUT, int ldo, const float* NG, const float* qn, const float* kn) {
    const int tid = tid_opq(), lane = tid & 63, w = __builtin_amdgcn_readfirstlane(tid >> 6), q = lane & 31, hi = lane >> 5, hh = q >> 3, tl = q & 7;
    LAS float* impw = (LAS float*)(lds + OFF_WS + w * WS_PER_WAVE);
    LAS float* rs = impw + 2048;
    LAS float* rs2 = rs + 32;
    const float gq = wave_max(fabsf(qn[lane]));
    const float nB0 = -8.5f * LOG2E * gq * wave_max(fabsf(kn[lane]));
    const float nB1 = -8.5f * LOG2E * gq * wave_max(fabsf(kn[64 + lane]));
    const float nB2 = -8.5f * LOG2E * gq * wave_max(fabsf(kn[128 + lane]));
    const int G = gd_opq(), bx = bx_opq();
    const int drow = 8 * w + (lane >> 3), dsl = lane & 7;
    const unsigned dkoff = (unsigned)(drow * 128 + ((dsl ^ ((drow >> 1) & 7)) * 16));
    const unsigned dvoff = (unsigned)(drow * 128 + ((dsl ^ (4 * ((drow >> 1) & 1))) * 16));
    const unsigned ldsw = (unsigned)w * 1024u;
    const int kfx = (q >> 1) & 7;
    const int qrow = (lane & 15) >> 2, pcol = lane & 3, cgp = (lane >> 4) & 1, fbit = (qrow >> 1) & 1;
    const int vbase = (4 * hi + qrow) * 128 + (2 * cgp + (pcol >> 1)) * 16 + 8 * (pcol & 1);
    const int vb0 = vbase + fbit * 64, vb1 = vbase + (fbit ^ 1) * 64;
#define ATT_WAIT_BAR(N) asm volatile("s_waitcnt vmcnt(" #N ") lgkmcnt(0)\n\ts_barrier" ::: "memory")
    for (int it = 0;; ++it) {
        int qi, bg;
        if (G == 256) { if (it >= 8) break; const int r = bx >> 5; qi = 8 * (7 - it) + ((it & 1) ? r : 7 - r); bg = bx & 31; }
        else { const int idx = it * G + bx; if (idx >= 2048) break; qi = 63 - (idx >> 5); bg = idx & 31; }
        const int b = bg >> 2, g = bg & 3;
        const int tt = w * 8 + tl, tq = qi * 64 + tt;
        const size_t row = (size_t)b * 4096 + tq;
        const int head = g * 4 + hh;
        bf16x8 qf[4];
#pragma unroll
        for (int d0 = 0; d0 < 4; ++d0) qf[d0] = *(const bf16x8*)(YO + row * 2048 + 1024 + head * 64 + 16 * d0 + 8 * hi);
        const int cmaxq = (tq - 31) >> 4;
        const int nct = (4 * qi + 2) / 64 + 1;
        const int nw = (qi < 8 ? qi : 8) + 1, kt0 = qi - (nw - 1);
        const int NJ = nct + (qi + 1) + nw;
        const char* kcb = (const char*)(KC + (size_t)bg * 256 * 64); const char* vcb = (const char*)(VC + (size_t)bg * 256 * 64);
        const char* ksb = (const char*)(KVB + 2 * KVBUF + (size_t)bg * 4096 * 64); const char* vsb = (const char*)(KVB + 3 * KVBUF + (size_t)bg * 4096 * 64);
        const char* kwb = (const char*)(KVB + 4 * KVBUF + (size_t)bg * 4096 * 64); const char* vwb = (const char*)(KVB + 5 * KVBUF + (size_t)bg * 4096 * 64);
#define ATT_ISSUE(j_, st_) do { int ty_, tile_; job_decode((j_) < NJ ? (j_) : NJ - 1, nct, qi, kt0, ty_, tile_); \
            const char* kp_ = (ty_ < 2 ? kcb : (ty_ == 2 ? ksb : kwb)) + (size_t)tile_ * 8192; const char* vp_ = (ty_ < 2 ? vcb : (ty_ == 2 ? vsb : vwb)) + (size_t)tile_ * 8192; \
            __builtin_amdgcn_global_load_lds((const unsigned*)(kp_ + dkoff), (LAS unsigned*)(lds + (st_) * STAGE + ldsw), 16, 0, 0); \
            __builtin_amdgcn_global_load_lds((const unsigned*)(vp_ + dvoff), (LAS unsigned*)(lds + (st_) * STAGE + 8192 + ldsw), 16, 0, 0); } while (0)
        ATT_ISSUE(0, 0); ATT_ISSUE(1, 1); ATT_ISSUE(2, 2);
        f32x16 ofin[2], ocur[2];
#pragma unroll
        for (int r = 0; r < 16; ++r) { ofin[0][r] = 0.f; ofin[1][r] = 0.f; ocur[0][r] = 0.f; ocur[1][r] = 0.f; }
        float lsum = 0.f, carry = 0.f;
        unsigned long long mymask = (2ull << qi) - 1ull, unionmask = mymask;
        int st_cur = 0, st_iss = 3;
        for (int jp = 0; jp < NJ; jp += 2) {
            ATT_WAIT_BAR(2);
            ATT_ISSUE(jp + 3, st_iss); st_iss = (st_iss == NST - 1) ? 0 : st_iss + 1;
            ATT_ISSUE(jp + 4, st_iss); st_iss = (st_iss == NST - 1) ? 0 : st_iss + 1;
          for (int half = 0; half < 2; ++half) {
            const int j = jp + half; if (j >= NJ) break;
            int type, tile; job_decode(j, nct, qi, kt0, type, tile);
            const LAS unsigned char* Kb = lds + st_cur * STAGE;
            const LAS unsigned char* Vb = Kb + 8192;
            st_cur = (st_cur == NST - 1) ? 0 : st_cur + 1;
            const bool skip = (type == 2) && (((unionmask >> tile) & 1ull) == 0ull);
            if (!skip) {
                const bool rowok = (type != 2) || (((mymask >> tile) & 1ull) != 0ull);
                const float nB = !rowok ? -30000.f : (type < 2 ? nB0 : (type == 2 ? nB1 : nB2));
                f32x16 p0, p1, cin;
#pragma unroll
                for (int r = 0; r < 16; ++r) cin[r] = nB;
#define ATT_QK2() do { \
                p0 = __builtin_amdgcn_mfma_f32_32x32x16_bf16(*(const LAS bf16x8*)(Kb + q * 128 + (hi ^ kfx) * 16), qf[0], cin, 0, 0, 0); \
                _Pragma("unroll") for (int d0 = 1; d0 < 4; ++d0) p0 = __builtin_amdgcn_mfma_f32_32x32x16_bf16(*(const LAS bf16x8*)(Kb + q * 128 + ((2 * d0 + hi) ^ kfx) * 16), qf[d0], p0, 0, 0, 0); \
                p1 = __builtin_amdgcn_mfma_f32_32x32x16_bf16(*(const LAS bf16x8*)(Kb + (32 + q) * 128 + (hi ^ kfx) * 16), qf[0], cin, 0, 0, 0); \
                _Pragma("unroll") for (int d0 = 1; d0 < 4; ++d0) p1 = __builtin_amdgcn_mfma_f32_32x32x16_bf16(*(const LAS bf16x8*)(Kb + (32 + q) * 128 + ((2 * d0 + hi) ^ kfx) * 16), qf[d0], p1, 0, 0, 0); } while (0)
#define ATT_PV2() do { _Pragma("unroll") for (int s = 0; s < 4; ++s) { u32x4 pw; \
                    if (s < 2) { pw.x = pk_bf16(p0[8 * s], p0[8 * s + 1]); pw.y = pk_bf16(p0[8 * s + 2], p0[8 * s + 3]); pw.z = pk_bf16(p0[8 * s + 4], p0[8 * s + 5]); pw.w = pk_bf16(p0[8 * s + 6], p0[8 * s + 7]); } \
                    else { const int s2 = s - 2; pw.x = pk_bf16(p1[8 * s2], p1[8 * s2 + 1]); pw.y = pk_bf16(p1[8 * s2 + 2], p1[8 * s2 + 3]); pw.z = pk_bf16(p1[8 * s2 + 4], p1[8 * s2 + 5]); pw.w = pk_bf16(p1[8 * s2 + 6], p1[8 * s2 + 7]); } \
                    const bf16x8 pa = __builtin_bit_cast(bf16x8, pw); \
                    { const s16x4 vlo = vtr(Vb + s * 2048 + vb0), vhi = vtr(Vb + s * 2048 + 1024 + vb0); \
                      const bf16x8 vf = (bf16x8){vlo[0], vlo[1], vlo[2], vlo[3], vhi[0], vhi[1], vhi[2], vhi[3]}; ocur[0] = __builtin_amdgcn_mfma_f32_32x32x16_bf16(pa, vf, ocur[0], 0, 0, 0); } \
                    { const s16x4 vlo = vtr(Vb + s * 2048 + vb1), vhi = vtr(Vb + s * 2048 + 1024 + vb1); \
                      const bf16x8 vf = (bf16x8){vlo[0], vlo[1], vlo[2], vlo[3], vhi[0], vhi[1], vhi[2], vhi[3]}; ocur[1] = __builtin_amdgcn_mfma_f32_32x32x16_bf16(pa, vf, ocur[1], 0, 0, 0); } } } while (0)
                const bool interior = (type == 2 && tile < qi) || (type == 3 && tile > qi - 8 && tile < qi);
                if (interior) {
                    ATT_QK2();
                    float ps = 0.f, ps1 = 0.f;
#pragma unroll
                    for (int r = 0; r < 16; ++r) { p0[r] = ex2(p0[r]); ps += p0[r]; }
#pragma unroll
                    for (int r = 0; r < 16; ++r) { p1[r] = ex2(p1[r]); ps1 += p1[r]; }
                    lsum += ps + ps1;
                    ATT_PV2();
                } else {
                    ATT_QK2();
                    int lo = 0, hiq = 63;
                    if (type < 2) hiq = cmaxq - 64 * tile;
                    else if (type == 2) { if (tile == qi) hiq = tt; }
                    else { if (tile == qi - 8) lo = tt + 1; if (tile == qi) hiq = tt; }
                    float ps = 0.f;
#pragma unroll
                    for (int r = 0; r < 16; ++r) { const int k0i = crow(r, hi), k1i = k0i + 32;
                        p0[r] = (k0i >= lo && k0i <= hiq) ? ex2(p0[r]) : 0.f; p1[r] = (k1i >= lo && k1i <= hiq) ? ex2(p1[r]) : 0.f; ps += p0[r] + p1[r]; }
                    lsum += ps;
                    if (type == 1 && qi >= 16) {
                        float s4[8], b3[8], pb[8];
#pragma unroll
                        for (int a = 0; a < 4; ++a) { s4[a] = (p0[4 * a] + p0[4 * a + 1]) + (p0[4 * a + 2] + p0[4 * a + 3]); b3[a] = p0[4 * a + 3];
                            s4[4 + a] = (p1[4 * a] + p1[4 * a + 1]) + (p1[4 * a + 2] + p1[4 * a + 3]); b3[4 + a] = p1[4 * a + 3]; }
#pragma unroll
                        for (int x = 0; x < 8; ++x) pb[x] = __shfl_xor(b3[x], 32);
#pragma unroll
                        for (int x = 0; x < 8; ++x) { const float extra = hi ? pb[x] : (x == 0 ? carry : pb[x == 0 ? 0 : x - 1]);
                            const int n = 16 * tile + 2 * (x & 3) + hi + 8 * (x >> 2);
                            impw[q * 64 + n] = s4[x] + extra; }
                        carry = pb[7];
                    }
                    ATT_PV2();
                }
#undef ATT_QK2
#undef ATT_PV2
            }
            const bool end_c2 = (type == 1 && tile == nct - 1), end_s = (type == 2 && tile == qi), end_w = (type == 3 && tile == qi);
            if (end_c2 || end_s || end_w) {
                const float l = lsum + __shfl_xor(lsum, 32);
                const float gt_ = NG[row * 64 + (end_c2 ? 0 : (end_s ? 16 : 32)) + head];
                const float linv = l > 0.f ? 1.f / l : 0.f;
                const float sc = gt_ * linv;
                if (hi == 0) { rs[q] = sc; if (end_c2) rs2[q] = linv; }
#pragma unroll
                for (int r = 0; r < 16; ++r) { const float f = rs[crow(r, hi)]; ofin[0][r] += f * ocur[0][r]; ofin[1][r] += f * ocur[1][r]; ocur[0][r] = 0.f; ocur[1][r] = 0.f; }
                lsum = 0.f;
            }
            if (end_c2 && qi >= 16) {
                unionmask = 0ull; mymask = 0ull;
                for (int i = 0; i < 8; ++i) {
                    const int n = lane; const bool valid = n <= qi, forced = (n == 0) || (n == qi) || (n == qi - 1);
                    const float sc = forced ? 1e6f : (impw[i * 64 + n] * rs2[i] + impw[(8 + i) * 64 + n] * rs2[8 + i]) + (impw[(16 + i) * 64 + n] * rs2[16 + i] + impw[(24 + i) * 64 + n] * rs2[24 + i]);
                    const unsigned key = valid ? ((__float_as_uint(sc) & ~63u) | (unsigned)(63 - n)) : 0u;
                    unsigned T = 0u;
#pragma unroll
                    for (int bit = 30; bit >= 0; --bit) { const unsigned cand = T | (1u << bit); const unsigned long long bm = __ballot(key >= cand); if (__popcll(bm) >= 16) T = cand; }
                    const unsigned long long mk = __ballot(valid && key >= T);
                    unionmask |= mk; if (tl == i) mymask = mk;
                }
            }
          }
        }
#pragma unroll
        for (int r = 0; r < 16; ++r) { const int qq = crow(r, hi); const size_t orow = (size_t)b * 4096 + qi * 64 + w * 8 + (qq & 7);
            bf16_t* op = OUT + orow * ldo + (g * 4 + (qq >> 3)) * 64 + q;
            op[0] = (bf16_t)(pk_bf16(ofin[0][r], 0.f) & 0xffffu); op[32] = (bf16_t)(pk_bf16(ofin[1][r], 0.f) & 0xffffu); }
        ATT_WAIT_BAR(0);
#undef ATT_ISSUE
    }
#undef ATT_WAIT_BAR
}
}


#define XB_TMO      128
#define XB_XCNT(j)  (256  + 64 * (j))
#define XB_XSUB(j)  (1280 + 64 * (j))
#define XB_XGEN(j)  (2304 + 64 * (j))
#define XB_TOP      3328
#define XB_TOPGEN   3392
#define XCD_BAR_WORDS 3456
#define XB_SPIN_CAP (1u << 22)
__device__ __forceinline__ unsigned xb_ld(unsigned* p)              { return __hip_atomic_load(p, __ATOMIC_RELAXED, __HIP_MEMORY_SCOPE_AGENT); }
__device__ __forceinline__ unsigned xb_add(unsigned* p, unsigned v) { return __hip_atomic_fetch_add(p, v, __ATOMIC_RELAXED, __HIP_MEMORY_SCOPE_AGENT); }
__device__ __forceinline__ unsigned xb_xcc_id() { return (unsigned)__builtin_amdgcn_s_getreg((3 << 11) | 20) & 0xFu; }
#define XB_SPIN(cond, bar) do { unsigned _sp = 0; while (cond) { __builtin_amdgcn_s_sleep(1); \
    if ((++_sp & 255u) == 0u) { if (xb_ld(&(bar)[XB_TMO])) break; if (_sp > XB_SPIN_CAP) { atomicAdd(&(bar)[XB_TMO], 1u); break; } } } } while (0)
struct XcdBarrier { unsigned* bar; unsigned x; volatile LAS unsigned* st; };
__device__ __forceinline__ void xcd_barrier_complete(unsigned* bar, unsigned x, unsigned& nloc, unsigned& nx) {
    const unsigned G = gridDim.x * gridDim.y * gridDim.z;
    unsigned sum, cnt, mine, sp = 0u;
    for (;;) {
        sum = 0u; cnt = 0u; mine = 0u;
#pragma unroll
        for (unsigned j = 0; j < 16; ++j) { const unsigned c = xb_ld(&bar[XB_XCNT(j)]); sum += c; cnt += (c > 0u) ? 1u : 0u; mine = (j == x) ? c : mine; }
        if (sum == G) break;
        __builtin_amdgcn_s_sleep(1);
        if ((++sp & 255u) == 0u) { if (xb_ld(&bar[XB_TMO])) break; if (sp > XB_SPIN_CAP) { atomicAdd(&bar[XB_TMO], 1u); break; } }
    }
    nloc = mine > 0u ? mine : 1u; nx = cnt > 0u ? cnt : 1u;
}
__device__ __forceinline__ void xcd_barrier(unsigned* bar, volatile LAS unsigned* st) {
    asm volatile("s_waitcnt vmcnt(0)" ::: "memory");
    __syncthreads();
    if (threadIdx.x == 0) {
        const unsigned x = xb_xcc_id();
        __builtin_amdgcn_s_waitcnt(0);
        unsigned nloc = st[0], nx = st[1];
        if (nloc == 0u) { xcd_barrier_complete(bar, x, nloc, nx); st[0] = nloc; st[1] = nx; }
        const unsigned old = xb_add(&bar[XB_XSUB(x)], 1u);
        const unsigned gen = old / nloc;
        if (old + 1u == (gen + 1u) * nloc) {
            __builtin_amdgcn_fence(__ATOMIC_RELEASE, "agent");
            asm volatile("s_waitcnt vmcnt(0)" ::: "memory");
            const unsigned og = xb_add(&bar[XB_TOP], 1u);
            const unsigned tg = og / nx;
            if (og + 1u == (tg + 1u) * nx) xb_add(&bar[XB_TOPGEN], 1u);
            else XB_SPIN(xb_ld(&bar[XB_TOPGEN]) == tg, bar);
            __builtin_amdgcn_fence(__ATOMIC_ACQUIRE, "agent");
            xb_add(&bar[XB_XGEN(x)], 1u);
            asm volatile("s_waitcnt vmcnt(0)" ::: "memory");
        } else {
            XB_SPIN(xb_ld(&bar[XB_XGEN(x)]) == gen, bar);
            __builtin_amdgcn_fence(__ATOMIC_ACQUIRE, "agent");
            asm volatile("s_waitcnt vmcnt(0)" ::: "memory");
        }
    }
    __syncthreads();
}

constexpr int LDS_BYTES = 155648;
constexpr int NPH = 16;

__device__ __forceinline__ unsigned char* opq(unsigned char* p) { asm volatile("" : "+s"(p)); return p; }
#define WSP(off) ((bf16_t*)(opq(a.ws) + (off)))
#define WSF(off) ((float*)(opq(a.ws) + (off)))

__global__ void __launch_bounds__(512, 2) mega(Args a) {
    extern __shared__ __attribute__((aligned(16))) unsigned char lds_raw[];
    LAS unsigned char* lds = (LAS unsigned char*)lds_raw;
    cg::grid_group grid = cg::this_grid();
    const int lo = a.ph_lo, hi = a.ph_hi;
    volatile LAS unsigned* xst = (volatile LAS unsigned*)(lds + 155648 - 64);
    if (threadIdx.x == 0) { xst[0] = 0u; xst[1] = 0u; if (hi - lo > 1) (void)xb_add(&((unsigned*)(a.ws + WS_BAR))[XB_XCNT(xb_xcc_id())], 1u); }
    __syncthreads();
#define IDS const int tid = tid_opq(), lane = tid & 63, wave = __builtin_amdgcn_readfirstlane(tid >> 6); const int G = gd_opq(), bx = bx_opq(); \
    const int gw = bx * 8 + wave, ngw = G * 8, gt = bx * 512 + tid, ngt = G * 512; (void)lane; (void)gw; (void)ngw; (void)gt; (void)ngt;
#define IN(k) (lo <= (l * NPH + (k)) && (l * NPH + (k)) < hi)
#define SEAM(k) do { if (lo <= (l * NPH + (k)) && (l * NPH + (k)) + 1 < hi) { if (hi < 0) grid.sync(); xcd_barrier((unsigned*)(opq(a.ws) + WS_BAR), xst); if (PROBE_SYNC2) xcd_barrier((unsigned*)(opq(a.ws) + WS_BAR), xst); } } while (0)
    for (int l = 0; l < DEPTH; ++l) {
        for (int rep_ = 0; rep_ < ((PROBE_DUP >> 0) & 1) + 1; ++rep_) if (IN(0)) {
            IDS
            weights_phase(a, l, lds, gw, ngw, wave, lane);
            rms_phase((l == 0) ? a.in[0] : a.out, a.in[1] + l * 1024, WSP(WS_H), gw, ngw, lane);
        }
        SEAM(0);
        for (int rep_ = 0; rep_ < ((PROBE_DUP >> 1) & 1) + 1; ++rep_) if (IN(1)) {
            pg8::StaticOrder S; pg8::Gemm g{WSP(WS_H), WSP(WS_W + W_INA), MTOK, 2048, 1024, 1024, 0, 0}; S.init(MTOK, 2048, gd_opq(), bx_opq());
            EpiInA E{WSP(WS_RX), WSP(WS_YO)}; pg8::gemm_phase<EpiInA>(lds, g, S, E);
        }
        SEAM(1);
        for (int rep_ = 0; rep_ < ((PROBE_DUP >> 2) & 1) + 1; ++rep_) if (IN(2)) {
            IDS
            const bf16_t* RX = WSP(WS_RX); bf16_t* XR = WSP(WS_XR); const bf16_t* Wc1 = WSP(WS_W + W_C1); float* bias1 = WSF(WS_CTL);
            const float* cw = a.in[3] + l * 4 * 1024; const float* cb = a.in[4] + l * 1024;
            for (int it0 = gt; it0 < MTOK * 128; it0 += 2 * ngt) {
                u32x4 xw[2][4]; int rowv[2], chv[2]; bool ok[2];
#pragma unroll
                for (int e = 0; e < 2; ++e) { const int it = it0 + e * ngt; ok[e] = it < MTOK * 128; const int itc = ok[e] ? it : it0; rowv[e] = itc >> 7; chv[e] = (itc & 127) * 8; const int s = rowv[e] & 4095;
#pragma unroll
                    for (int kk = 0; kk < 4; ++kk) xw[e][kk] = (s - 3 + kk >= 0) ? *(const u32x4*)(RX + (size_t)(rowv[e] - 3 + kk) * 1024 + chv[e]) : (u32x4){0u, 0u, 0u, 0u}; }
#pragma unroll
                for (int e = 0; e < 2; ++e) { const int ch = chv[e];
                    float acc[8];
#pragma unroll
                    for (int i = 0; i < 8; ++i) acc[i] = cb[ch + i];
#pragma unroll
                    for (int kk = 0; kk < 4; ++kk) { const u32x4 w4 = xw[e][kk];
                        const f32x4 c0 = *(const f32x4*)(cw + kk * 1024 + ch), c1 = *(const f32x4*)(cw + kk * 1024 + ch + 4);
                        acc[0] += c0[0] * bf_lo(w4.x); acc[1] += c0[1] * bf_hi(w4.x); acc[2] += c0[2] * bf_lo(w4.y); acc[3] += c0[3] * bf_hi(w4.y);
                        acc[4] += c1[0] * bf_lo(w4.z); acc[5] += c1[1] * bf_hi(w4.z); acc[6] += c1[2] * bf_lo(w4.w); acc[7] += c1[3] * bf_hi(w4.w); }
                    u32x4 o; o.x = pk_bf16(acc[0], acc[1]); o.y = pk_bf16(acc[2], acc[3]); o.z = pk_bf16(acc[4], acc[5]); o.w = pk_bf16(acc[6], acc[7]);
                    if (ok[e]) *(u32x4*)(XR + (size_t)rowv[e] * 1024 + ch) = o; } }
            if (gt < 1024) { const float lm = a.in[9][l * 1024 + gt]; const float e = __expf(-fabsf(lm)); const float lp = e < 0.03f ? e * (1.f - e * (0.5f - e * (0.33333333f - 0.25f * e))) : __logf(1.f + e); bias1[1024 + gt] = -8.f * LOG2E * (fmaxf(-lm, 0.f) + lp); }
            for (int j = gw; j < 512; j += ngw) { const float* pos = (j >> 8 ? a.in[13] : a.in[12]) + l * 2048; const bf16_t* wr_ = Wc1 + (size_t)j * 2048;
                float s = 0.f;
                for (int kk = lane; kk < 2048; kk += 64) s += pos[kk] * __uint_as_float((unsigned)wr_[kk] << 16);
                s = wave_sum(s); if (lane == 0) bias1[j] = s; }
        }
        SEAM(2);
        for (int rep_ = 0; rep_ < ((PROBE_DUP >> 3) & 1) + 1; ++rep_) if (IN(3)) {
            pg8::StaticOrder S; pg8::Gemm g{WSP(WS_XR), WSP(WS_W + W_G), MTOK, 2048, 256, 1024, 2, 0}; S.init(MTOK, 2048, gd_opq(), bx_opq());
            EpiGate E{WSP(WS_XR), WSP(WS_LA), WSP(WS_U), a.in[6] + l * 1024, a.in[8] + l * 1024, WSF(WS_CTL) + 1024}; pg8::gemm_phase<EpiGate>(lds, g, S, E);
        }
        SEAM(3);
        for (int rep_ = 0; rep_ < ((PROBE_DUP >> 4) & 1) + 1; ++rep_) if (IN(4)) {
            IDS
            const bf16_t* LA = WSP(WS_LA); const bf16_t* U = WSP(WS_U); float* AGA = WSF(WS_AGG); float* AGH = AGA + 8 * 64 * 1024;
            for (int it = gt; it < 8 * 64 * 256; it += ngt) { const int cq = it & 255, bc = it >> 8; const int ch = 4 * cq; const size_t row0 = (size_t)bc * 64;
                float s[4] = {0.f, 0.f, 0.f, 0.f}, h[4] = {0.f, 0.f, 0.f, 0.f};
#pragma unroll 8
                for (int t = 0; t < 64; ++t) { const u32x2 wl = *(const u32x2*)(LA + (row0 + t) * 1024 + ch), wu = *(const u32x2*)(U + (row0 + t) * 1024 + ch);
                    const float l0 = bf_lo(wl.x), l1 = bf_hi(wl.x), l2 = bf_lo(wl.y), l3 = bf_hi(wl.y); s[0] += l0; s[1] += l1; s[2] += l2; s[3] += l3;
                    h[0] = ex2(l0) * h[0] + bf_lo(wu.x); h[1] = ex2(l1) * h[1] + bf_hi(wu.x); h[2] = ex2(l2) * h[2] + bf_lo(wu.y); h[3] = ex2(l3) * h[3] + bf_hi(wu.y); }
                *(f32x4*)(AGA + (size_t)bc * 1024 + ch) = (f32x4){ex2(s[0]), ex2(s[1]), ex2(s[2]), ex2(s[3])}; *(f32x4*)(AGH + (size_t)bc * 1024 + ch) = (f32x4){h[0], h[1], h[2], h[3]}; }
        }
        SEAM(4);
        if (IN(5)) {
            IDS
            const bf16_t* LA = WSP(WS_LA); const bf16_t* U = WSP(WS_U); bf16_t* YO = WSP(WS_YO); const float* AGA = WSF(WS_AGG); const float* AGH = AGA + 8 * 64 * 1024;
            for (int it = gt; it < 8 * 64 * 256; it += ngt) { const int cq = it & 255, bc = it >> 8; const int ch = 4 * cq; const size_t row0 = (size_t)bc * 64; const int c = bc & 63, b0 = bc - c;
                f32x4 h = (f32x4){0.f, 0.f, 0.f, 0.f};
                {   int cc = 0;
                    for (; cc + 8 <= c; cc += 8) { f32x4 A[8], Hh[8];
#pragma unroll
                        for (int k = 0; k < 8; ++k) { A[k] = *(const f32x4*)(AGA + (size_t)(b0 + cc + k) * 1024 + ch); Hh[k] = *(const f32x4*)(AGH + (size_t)(b0 + cc + k) * 1024 + ch); }
#pragma unroll
                        for (int k = 0; k < 8; ++k) h = A[k] * h + Hh[k]; }
                    for (; cc < c; ++cc) { const f32x4 A = *(const f32x4*)(AGA + (size_t)(b0 + cc) * 1024 + ch), Hh = *(const f32x4*)(AGH + (size_t)(b0 + cc) * 1024 + ch); h = A * h + Hh; } }
                for (int t0 = 0; t0 < 64; t0 += 8) { u32x2 wl[8], wu[8], gy[8];
#pragma unroll
                    for (int k = 0; k < 8; ++k) { wl[k] = *(const u32x2*)(LA + (row0 + t0 + k) * 1024 + ch); wu[k] = *(const u32x2*)(U + (row0 + t0 + k) * 1024 + ch); gy[k] = *(const u32x2*)(YO + (row0 + t0 + k) * 2048 + ch); }
#pragma unroll
                    for (int k = 0; k < 8; ++k) { h[0] = ex2(bf_lo(wl[k].x)) * h[0] + bf_lo(wu[k].x); h[1] = ex2(bf_hi(wl[k].x)) * h[1] + bf_hi(wu[k].x); h[2] = ex2(bf_lo(wl[k].y)) * h[2] + bf_lo(wu[k].y); h[3] = ex2(bf_hi(wl[k].y)) * h[3] + bf_hi(wu[k].y);
                        u32x2 o; o.x = pk_bf16(h[0] * bf_lo(gy[k].x), h[1] * bf_hi(gy[k].x)); o.y = pk_bf16(h[2] * bf_lo(gy[k].y), h[3] * bf_hi(gy[k].y)); gy[k] = o; }
#pragma unroll
                    for (int k = 0; k < 8; ++k) *(u32x2*)(YO + (row0 + t0 + k) * 2048 + ch) = gy[k]; }
            }
        }
        SEAM(5);
        for (int rep_ = 0; rep_ < ((PROBE_DUP >> 6) & 1) + 1; ++rep_) if (IN(6)) {
            pg8::StaticOrder S; pg8::Gemm g{WSP(WS_H), WSP(WS_W + W_INB), MTOK, 4864, 1024, 1024, 0, 0}; S.init(MTOK, 4864, gd_opq(), bx_opq());
            EpiInB E{WSP(WS_YO), WSP(WS_RX), WSP(WS_LA), WSF(WS_NG), a.in[10] + l * 64, a.in[11] + l * 192}; pg8::gemm_phase<EpiInB>(lds, g, S, E);
        }
        SEAM(6);
        for (int rep_ = 0; rep_ < ((PROBE_DUP >> 7) & 1) + 1; ++rep_) if (IN(7)) {
            pg8::StaticOrder S; pg8::Gemm g{WSP(WS_RX), WSP(WS_W + W_C1), 16384, 256, 2048, 1024, 0, 32}; S.init(16384, 256, gd_opq(), bx_opq());
            EpiCmp1 E{WSP(WS_HID), WSF(WS_CTL)}; pg8::gemm_phase<EpiCmp1>(lds, g, S, E);
        }
        SEAM(7);
        for (int rep_ = 0; rep_ < ((PROBE_DUP >> 8) & 1) + 1; ++rep_) if (IN(8)) {
            IDS
            const bf16_t* HID = WSP(WS_HID); bf16_t* KC = WSP(WS_KC); bf16_t* VC = WSP(WS_VC);
            const float* kn0 = a.in[11] + l * 192;
            LAS float* w2s = (LAS float*)lds;
            for (int i = tid; i < 2 * 4096; i += 512) { const f32x4 v = (i < 4096) ? ((const f32x4*)(a.in[15] + (size_t)l * 16384))[i] : ((const f32x4*)(a.in[17] + (size_t)l * 16384))[i - 4096]; *(LAS f32x4*)(w2s + 4 * i) = v; }
            __syncthreads();
            for (int r0 = gw * 4; r0 < 16384; r0 += ngw * 4) {
                const int which = r0 >> 13;
                const LAS float* wq = w2s + which * 16384 + lane;
                const unsigned* hp = (const unsigned*)(HID + (size_t)r0 * 256);
                float acc0 = 0.f, acc1 = 0.f, acc2 = 0.f, acc3 = 0.f;
#pragma unroll 4
                for (int h2 = 0; h2 < 128; ++h2) {
                    const float w0 = wq[(2 * h2) * 64], w1 = wq[(2 * h2 + 1) * 64];
                    const unsigned x0 = hp[h2], x1 = hp[128 + h2], x2 = hp[256 + h2], x3 = hp[384 + h2];
                    acc0 += bf_lo(x0) * w0 + bf_hi(x0) * w1; acc1 += bf_lo(x1) * w0 + bf_hi(x1) * w1;
                    acc2 += bf_lo(x2) * w0 + bf_hi(x2) * w1; acc3 += bf_lo(x3) * w0 + bf_hi(x3) * w1; }
                float accv[4] = {acc0, acc1, acc2, acc3};
#pragma unroll
                for (int e = 0; e < 4; ++e) { const int r = r0 + e, rr = r & 8191, c = rr & 255, bgi = rr >> 8;
                    bf16_t* dst = (which ? VC : KC) + ((size_t)bgi * 256 + c) * 64;
                    float v = accv[e];
                    if (!which) { const float ss = wave_sum(v * v); v *= rsqrtf(ss * (1.f / 64.f) + EPS) * kn0[lane]; }
                    if (c == 255) v = 0.f;
                    dst[lane] = (bf16_t)(pk_bf16(v, 0.f) & 0xffffu); }
            }
            __syncthreads();
        }
        SEAM(8);
        if (IN(9)) {
            if (PROBE_DUP & (1 << 9)) att::attn_phase(lds, WSP(WS_RX), WSP(WS_KC), WSP(WS_VC), WSP(WS_YO), WSP(WS_H), 1024, WSF(WS_NG), a.in[10] + l * 64, a.in[11] + l * 192);
            att::attn_phase(lds, WSP(WS_RX), WSP(WS_KC), WSP(WS_VC), WSP(WS_YO), WSP(WS_YO) + 1024, 2048, WSF(WS_NG), a.in[10] + l * 64, a.in[11] + l * 192);
        }
        SEAM(9);
        if (IN(10)) {
            pg8::StaticOrder S; pg8::Gemm g{WSP(WS_YO), WSP(WS_W + W_YA), MTOK, 1024, 2048, 2048, 0, 0}; S.init(MTOK, 1024, gd_opq(), bx_opq());
            EpiMixM E{WSP(WS_H), WSP(WS_LA)}; pg8::gemm_phase<EpiMixM>(lds, g, S, E);
        }
        SEAM(10);
        if (IN(12)) {
            pg8::StaticOrder S; pg8::Gemm g{WSP(WS_H), WSP(WS_W + W_O), MTOK, 1024, 1024, 1024, 0, 0}; S.init(MTOK, 1024, gd_opq(), bx_opq());
            EpiRes E{(l == 0) ? a.in[0] : a.out, a.out}; pg8::gemm_phase<EpiRes>(lds, g, S, E);
        }
        SEAM(12);
        for (int rep_ = 0; rep_ < ((PROBE_DUP >> 13) & 1) + 1; ++rep_) if (IN(13)) {
            IDS
            rms_phase(a.out, a.in[21] + l * 1024, WSP(WS_H), gw, ngw, lane);
        }
        SEAM(13);
        for (int rep_ = 0; rep_ < ((PROBE_DUP >> 14) & 1) + 1; ++rep_) if (IN(14)) {
            pg8::StaticOrder S; pg8::Gemm g{WSP(WS_H), WSP(WS_W + W_GU), MTOK, 5632, 1024, 1024, 0, 0}; S.init(MTOK, 5632, gd_opq(), bx_opq());
            EpiSwi E{WSP(WS_RX)}; pg8::gemm_phase<EpiSwi>(lds, g, S, E);
        }
        SEAM(14);
        if (IN(15)) {
            pg8::StaticOrder S; pg8::Gemm g{WSP(WS_RX), WSP(WS_W + W_D), MTOK, 1024, D_FF, D_FF, 0, 0}; S.init(MTOK, 1024, gd_opq(), bx_opq());
            EpiRes E{a.out, a.out}; pg8::gemm_phase<EpiRes>(lds, g, S, E);
        }
        SEAM(15);
    }
#undef IDS
#undef IN
#undef SEAM
}

extern "C" void kernel_launch(void* const* d_in, const int* in_sizes, int n_in, void* d_out, int out_size, void* d_ws, size_t ws_size, hipStream_t stream) {
    static int grid = 0;
    if (grid == 0) {
        if (n_in != 25 || out_size != MTOK * DM || ws_size < WS_END) { fprintf(stderr, "kernel_launch: unexpected problem (n_in %d, out %d, ws %zu)\n", n_in, out_size, ws_size); grid = -1; return; }
        int dev = 0, cus = 0, per_cu = 0;
        hipGetDevice(&dev); hipDeviceGetAttribute(&cus, hipDeviceAttributeMultiprocessorCount, dev);
        hipFuncSetAttribute((const void*)mega, hipFuncAttributeMaxDynamicSharedMemorySize, LDS_BYTES);
        if (hipOccupancyMaxActiveBlocksPerMultiprocessor(&per_cu, (const void*)mega, 512, LDS_BYTES) != hipSuccess || per_cu < 1) per_cu = 1;
        (void)hipGetLastError();
        grid = cus * per_cu;
        if (grid <= 0) grid = 256;
    }
    if (grid < 0) return;
    Args a{};
    for (int i = 0; i < 25; ++i) a.in[i] = (const float*)d_in[i];
    a.out = (float*)d_out; a.ws = (unsigned char*)d_ws;
#if MK_MULTI
    for (int p = 0; p < DEPTH * NPH; ++p) { a.ph_lo = p; a.ph_hi = p + 1; hipLaunchKernelGGL(mega, dim3(grid), dim3(512), LDS_BYTES, stream, a); }
#else
    a.ph_lo = 0; a.ph_hi = DEPTH * NPH;
    (void)hipMemsetAsync((char*)d_ws + WS_BAR, 0, 16384, stream);
    void* args[] = {&a};
    hipError_t e = hipLaunchCooperativeKernel((const void*)mega, dim3(grid), dim3(512), args, LDS_BYTES, stream);
    if (e != hipSuccess) fprintf(stderr, "cooperative launch failed: %s (grid %d)\n", hipGetErrorString(e), grid);
#endif
}
```

```cpp
#include <hip/hip_runtime.h>
#include <hip/hip_cooperative_groups.h>
#include <cstdio>
#include <cstdint>
namespace cg = cooperative_groups;

#ifndef PROBE_SYNC2
#define PROBE_SYNC2 0
#endif
#ifndef PROBE_DUP
#define PROBE_DUP 0
#endif
#ifndef MK_MULTI
#define MK_MULTI 0
#endif

#define LAS __attribute__((address_space(3)))
typedef unsigned short bf16_t;
typedef short bf16x8 __attribute__((ext_vector_type(8)));
typedef short s16x4 __attribute__((ext_vector_type(4)));
typedef float f32x2 __attribute__((ext_vector_type(2)));
typedef float f32x4 __attribute__((ext_vector_type(4)));
typedef float f32x16 __attribute__((ext_vector_type(16)));
typedef unsigned u32x2 __attribute__((ext_vector_type(2)));
typedef unsigned u32x4 __attribute__((ext_vector_type(4)));
typedef __bf16 bf16x2_t __attribute__((ext_vector_type(2)));

constexpr int DM = 1024, NB = 8, SEQ = 4096, MTOK = NB * SEQ, DEPTH = 2;
constexpr int D_IN = 6704, D_FF = 2816;
constexpr float EPS = 1e-6f;
constexpr float LOG2E = 1.4426950408889634f;
constexpr float QSCALE = 0.125f * LOG2E;

constexpr size_t MiB = 1u << 20;
constexpr size_t WS_CTL = 0;
constexpr size_t WS_BAR = 65536;
constexpr size_t WS_W = 1 * MiB;
constexpr size_t W_INA = 0, W_INB = 4 * MiB, W_G = 14 * MiB, W_C1 = 15 * MiB, W_YA = 17 * MiB, W_YB = 19 * MiB, W_O = 21 * MiB, W_GU = 23 * MiB, W_D = 34 * MiB;
constexpr size_t WS_H = 41 * MiB;
constexpr size_t WS_RX = 105 * MiB;
constexpr size_t WS_XR = 169 * MiB;
constexpr size_t WS_LA = 233 * MiB;
constexpr size_t WS_U = 297 * MiB;
constexpr size_t WS_YO = 361 * MiB;
constexpr size_t WS_NG = 489 * MiB;
constexpr size_t WS_HID = 497 * MiB;
constexpr size_t WS_KC = 505 * MiB;
constexpr size_t WS_VC = 506 * MiB;
constexpr size_t WS_AGG = 507 * MiB;
constexpr size_t WS_END = 511 * MiB;
constexpr size_t KVBUF = (size_t)32 * 4096 * 64;

__device__ __forceinline__ int bx_opq() { int t = blockIdx.x; asm volatile("" : "+s"(t)); return t; }
__device__ __forceinline__ int gd_opq() { int t = gridDim.x; asm volatile("" : "+s"(t)); return t; }
__device__ __forceinline__ int tid_opq() { int t = threadIdx.x; asm volatile("" : "+v"(t)); return t; }
__device__ __forceinline__ unsigned pk_bf16(float lo, float hi) { f32x2 v = {lo, hi}; bf16x2_t b = __builtin_convertvector(v, bf16x2_t); return __builtin_bit_cast(unsigned, b); }
__device__ __forceinline__ float bf_lo(unsigned w) { return __uint_as_float(w << 16); }
__device__ __forceinline__ float bf_hi(unsigned w) { return __uint_as_float(w & 0xffff0000u); }
__device__ __forceinline__ float ex2(float x) { return __builtin_amdgcn_exp2f(x); }
__device__ __forceinline__ float sigm(float x) { return __builtin_amdgcn_rcpf(1.f + ex2(-LOG2E * x)); }
__device__ __forceinline__ float gelu_t(float x) { const float y = 1.5957691216057308f * (x + 0.044715f * x * x * x); return x * sigm(y); }
__device__ __forceinline__ float wave_sum(float v) {
#pragma unroll
    for (int o = 1; o < 64; o <<= 1) v += __shfl_xor(v, o);
    return v;
}
__device__ __forceinline__ float wave_max(float v) {
#pragma unroll
    for (int o = 1; o < 64; o <<= 1) v = fmaxf(v, __shfl_xor(v, o));
    return v;
}
__device__ __forceinline__ u32x4 pack8(const f32x4 a, const f32x4 b) { u32x4 w; w.x = pk_bf16(a[0], a[1]); w.y = pk_bf16(a[2], a[3]); w.z = pk_bf16(b[0], b[1]); w.w = pk_bf16(b[2], b[3]); return w; }

namespace pg8 {
constexpr int BM = 256, BK = 64, HALF = 128, HTB = HALF * BK * 2, STAGE_BYTES = 8 * HTB, NXCD = 8, WGM = 8;
__host__ __device__ __forceinline__ int lds_byte(int r, int c) { const int st = (r >> 4) * 2 + (c >> 5), rr = r & 15, cc = c & 31, ob = rr * 64 + cc * 2; return st * 1024 + (ob ^ (((ob >> 9) & 1) << 5)); }
__host__ __device__ __forceinline__ void stage_rc(int b, int& R, int& C) { const int st = b / 1024, sb = b % 1024, swz = sb ^ (((sb >> 9) & 1) << 5); R = (st >> 1) * 16 + swz / 64; C = (st & 1) * 32 + (swz % 64) / 2; }
__host__ __device__ __forceinline__ int perm32(int rho) { const int n = rho >> 4, i = rho & 15; return 8 * (i >> 2) + 4 * n + (i & 3); }

struct Unit { int pm, pn; };
struct Gemm { const bf16_t* A; const bf16_t* Bt; int M, N, K, lda, a_div, b_div; };

struct StaticOrder {
    int nM, nN, nwg, G, c;
    __device__ void init(int M, int N, int G_, int c_) { nM = M / BM; nN = N / BM; nwg = nM * nN; G = G_; c = c_; }
    __device__ bool next(int i, Unit& u) const {
        const long L = (long)i * G + c; if (L >= nwg) return false;
        int wgid = (int)L; { const int q = nwg / NXCD, r = nwg % NXCD, xcd = wgid % NXCD, off = wgid / NXCD; wgid = (xcd < r ? xcd * (q + 1) : r * (q + 1) + (xcd - r) * q) + off; }
        const int nig = WGM * nN, gid = wgid / nig, fm = gid * WGM, gsz = (nM - fm) < WGM ? (nM - fm) : WGM;
        u.pm = fm + ((wgid % nig) % gsz); u.pn = (wgid % nig) / gsz; return true;
    }
};
__device__ __forceinline__ const char* unitA(const Gemm& g, const Unit& u, size_t tstepA) { return (const char*)g.A + (size_t)u.pm * tstepA + (g.a_div ? (size_t)(u.pn / g.a_div) * (size_t)g.K * 2 : (size_t)0); }
__device__ __forceinline__ const char* unitB(const Gemm& g, const Unit& u, size_t tstepB) { return (const char*)g.Bt + (size_t)(u.pn + (g.b_div ? (u.pm / g.b_div) * (g.N / BM) : 0)) * tstepB; }

template <class Epi>
__device__ __forceinline__ void gemm_phase(LAS unsigned char* lds, const Gemm g, const StaticOrder& S, const Epi& E) {
    const int tid = tid_opq(), wid = __builtin_amdgcn_readfirstlane(tid >> 6), lane = tid & 63, wr = wid >> 2, wc = wid & 3, fr = lane & 15, fq = lane >> 4;
    const int K = g.K, nt = K / BK;
    unsigned voffA[2], voffB[2];
#pragma unroll
    for (int i = 0; i < 2; ++i) { int R, C; stage_rc(tid * 16 + i * 8192, R, C); const int Rb = Epi::PERM ? ((R & ~31) + perm32(R & 31)) : R;
        voffA[i] = (unsigned)(R * g.lda + C) * 2u; voffB[i] = (unsigned)(Rb * K + C) * 2u; }
    const size_t kstep = (size_t)(BK * 2);
    const size_t hstepA = (size_t)HALF * g.lda * 2, hstepB = (size_t)HALF * K * 2;
    const size_t tstepA = 2 * hstepA, tstepB = 2 * hstepB;
    const unsigned ldsw = (unsigned)wid * 1024u;
    const int aoff = lds_byte(wr * 64 + fr, fq * 8), boff = lds_byte(wc * 32 + fr, fq * 8);
#define PG8_SA(b, h) (((b) * 2 + (h)) * HTB)
#define PG8_SB(b, h) ((4 + (b) * 2 + (h)) * HTB)
#define PG8_STAGE(bufoff, gbase, voff) do { _Pragma("unroll") for (int _i = 0; _i < 2; ++_i) \
        __builtin_amdgcn_global_load_lds((const unsigned*)((const char*)(gbase) + (voff)[_i]), (LAS unsigned*)(lds + (bufoff) + ldsw + _i * 8192), 16, 0, 0); } while (0)
#define PG8_LDA(dst, b, h) do { _Pragma("unroll") for (int m = 0; m < 4; ++m) _Pragma("unroll") for (int k = 0; k < 2; ++k) dst[m][k] = *(const LAS bf16x8*)(lds + PG8_SA(b, h) + aoff + m * 2048 + k * 1024); } while (0)
#define PG8_LDB(dst, b, h) do { _Pragma("unroll") for (int n = 0; n < 2; ++n) _Pragma("unroll") for (int k = 0; k < 2; ++k) dst[n][k] = *(const LAS bf16x8*)(lds + PG8_SB(b, h) + boff + n * 2048 + k * 1024); } while (0)
#define PG8_MMA(ai, bj, At, Bt) do { __builtin_amdgcn_s_setprio(1); _Pragma("unroll") for (int m = 0; m < 4; ++m) _Pragma("unroll") for (int n = 0; n < 2; ++n) _Pragma("unroll") for (int k = 0; k < 2; ++k) \
        acc[ai][bj][m][n] = __builtin_amdgcn_mfma_f32_16x16x32_bf16(Bt[n][k], At[m][k], acc[ai][bj][m][n], 0, 0, 0); __builtin_amdgcn_s_setprio(0); } while (0)
#define PG8_WAIT_V(n) asm volatile("s_waitcnt vmcnt(" #n ")" ::: "memory")
#define PG8_WAIT_L(n) asm volatile("s_waitcnt lgkmcnt(" #n ")" ::: "memory")
#define PG8_BAR __builtin_amdgcn_s_barrier()
#define PG8_SCHED __builtin_amdgcn_sched_barrier(0)
    Unit cur, nxt; int ui = 0;
    if (!S.next(0, cur)) return;
    f32x4 acc[2][2][4][2];
#pragma unroll
    for (int a = 0; a < 2; ++a)
#pragma unroll
        for (int b = 0; b < 2; ++b)
#pragma unroll
            for (int m = 0; m < 4; ++m)
#pragma unroll
                for (int n = 0; n < 2; ++n) acc[a][b][m][n] = (f32x4){0.f, 0.f, 0.f, 0.f};
    bf16x8 At[4][2], B0[2][2], B1[2][2];
    const char* cA = unitA(g, cur, tstepA); const char* cB = unitB(g, cur, tstepB);
    PG8_STAGE(PG8_SB(0, 0), cB, voffB); PG8_STAGE(PG8_SB(0, 1), cB + hstepB, voffB); PG8_STAGE(PG8_SA(0, 0), cA, voffA); PG8_STAGE(PG8_SA(0, 1), cA + hstepA, voffA);
    if (wr == 1) PG8_BAR;
    PG8_WAIT_V(2); PG8_BAR;
    PG8_STAGE(PG8_SB(1, 0), cB + kstep, voffB); PG8_STAGE(PG8_SA(1, 0), cA + kstep, voffA); PG8_STAGE(PG8_SB(1, 1), cB + hstepB + kstep, voffB);
    PG8_WAIT_V(6); PG8_BAR;
    for (;;) {
        const bool has_next = S.next(ui + 1, nxt);
        const char* nA = has_next ? unitA(g, nxt, tstepA) : cA; const char* nB = has_next ? unitB(g, nxt, tstepB) : cB;
#pragma unroll 1
        for (int t = 0; t < nt; t += 2) {
            const bool last = (t == nt - 2);
            const char* a1 = cA + (size_t)(t + 1) * kstep;
            const char* a2 = last ? nA : cA + (size_t)(t + 2) * kstep; const char* b2 = last ? nB : cB + (size_t)(t + 2) * kstep;
            const char* a3 = a2 + kstep; const char* b3 = b2 + kstep;
            if constexpr (Epi::MID) { if (t == nt / 2) E.mid(acc, cur, wr, wc, fr, fq); }
            PG8_LDB(B0, 0, 0); PG8_LDB(B1, 0, 1); PG8_SCHED; PG8_LDA(At, 0, 0); PG8_STAGE(PG8_SA(1, 1), a1 + hstepA, voffA);
            PG8_WAIT_V(8); PG8_WAIT_L(0); PG8_BAR; PG8_MMA(0, 0, At, B0); PG8_MMA(0, 1, At, B1); PG8_BAR; PG8_SCHED;
            PG8_LDA(At, 0, 1); PG8_STAGE(PG8_SB(0, 0), b2, voffB); PG8_STAGE(PG8_SB(0, 1), b2 + hstepB, voffB); PG8_STAGE(PG8_SA(0, 0), a2, voffA);
            PG8_WAIT_V(8); PG8_WAIT_L(0); PG8_BAR; PG8_MMA(1, 0, At, B0); PG8_MMA(1, 1, At, B1); PG8_BAR; PG8_SCHED;
            PG8_LDB(B0, 1, 0); PG8_LDB(B1, 1, 1); PG8_SCHED; PG8_LDA(At, 1, 0); PG8_STAGE(PG8_SA(0, 1), a2 + hstepA, voffA);
            PG8_WAIT_V(8); PG8_WAIT_L(0); PG8_BAR; PG8_MMA(0, 0, At, B0); PG8_MMA(0, 1, At, B1); PG8_BAR; PG8_SCHED;
            PG8_LDA(At, 1, 1); PG8_STAGE(PG8_SB(1, 0), b3, voffB); PG8_STAGE(PG8_SB(1, 1), b3 + hstepB, voffB); PG8_STAGE(PG8_SA(1, 0), a3, voffA);
            PG8_WAIT_V(8); PG8_WAIT_L(0); PG8_BAR; PG8_MMA(1, 0, At, B0); PG8_MMA(1, 1, At, B1); PG8_BAR; PG8_SCHED;
        }
        if (wr == 0) PG8_BAR;
        E(acc, cur, wr, wc, fr, fq);
        if (!has_next) break;
#pragma unroll
        for (int a = 0; a < 2; ++a)
#pragma unroll
            for (int b = 0; b < 2; ++b)
#pragma unroll
                for (int m = 0; m < 4; ++m)
#pragma unroll
                    for (int n = 0; n < 2; ++n) acc[a][b][m][n] = (f32x4){0.f, 0.f, 0.f, 0.f};
        cur = nxt; cA = nA; cB = nB; ++ui;
        if (wr == 1) PG8_BAR;
    }
    PG8_WAIT_V(0);
    PG8_BAR;
#undef PG8_SA
#undef PG8_SB
#undef PG8_STAGE
#undef PG8_LDA
#undef PG8_LDB
#undef PG8_MMA
#undef PG8_WAIT_V
#undef PG8_WAIT_L
#undef PG8_BAR
#undef PG8_SCHED
}
}
using pg8::Unit;
typedef const f32x4 (&AccRef)[2][2][4][2];

struct EpiInA {
    static constexpr bool PERM = true, MID = false;
    bf16_t* RX; bf16_t* YO;
    __device__ __forceinline__ void operator()(AccRef acc, const Unit& u, int wr, int wc, int fr, int fq) const {
        const bool isy = u.pn >= 4; bf16_t* base = isy ? YO : RX; const int ldc = isy ? 2048 : 1024;
        const int row0 = u.pm * 256 + wr * 64 + fr, col0 = (u.pn & 3) * 256 + wc * 32 + 8 * fq;
#pragma unroll
        for (int ai = 0; ai < 2; ++ai)
#pragma unroll
            for (int m = 0; m < 4; ++m) { bf16_t* rowp = base + (size_t)(row0 + ai * 128 + m * 16) * ldc + col0;
#pragma unroll
                for (int bj = 0; bj < 2; ++bj) { f32x4 v0 = acc[ai][bj][m][0], v1 = acc[ai][bj][m][1];
                    if (isy) {
#pragma unroll
                        for (int i = 0; i < 4; ++i) { v0[i] = gelu_t(v0[i]); v1[i] = gelu_t(v1[i]); } }
                    *(u32x4*)(rowp + bj * 128) = pack8(v0, v1); } }
    }
};
struct EpiInB {
    static constexpr bool PERM = true, MID = false;
    bf16_t* YO; bf16_t* KVB; bf16_t* MG; float* NG; const float* qn; const float* kn;
    __device__ __forceinline__ void operator()(AccRef acc, const Unit& u, int wr, int wc, int fr, int fq) const {
        const int t = u.pn; const int row0 = u.pm * 256 + wr * 64 + fr;
        if (t < 10) {
            const bool isq = t < 4; const bool nrm = isq || t == 6 || t == 8;
            const float* gw = isq ? qn : (kn + (t == 6 ? 64 : 128));
            const float osc = isq ? QSCALE : 1.f;
            f32x4 gvv[2][2];
#pragma unroll
            for (int bj = 0; bj < 2; ++bj)
#pragma unroll
                for (int n = 0; n < 2; ++n) gvv[bj][n] = nrm ? *(const f32x4*)(gw + 32 * bj + 8 * fq + 4 * n) : (f32x4){1.f, 1.f, 1.f, 1.f};
#pragma unroll
            for (int ai = 0; ai < 2; ++ai)
#pragma unroll
                for (int m = 0; m < 4; ++m) {
                    const int row = row0 + ai * 128 + m * 16;
                    float rinv = 1.f;
                    if (nrm) { float ss = 0.f;
#pragma unroll
                        for (int bj = 0; bj < 2; ++bj)
#pragma unroll
                            for (int n = 0; n < 2; ++n) { const f32x4 x = acc[ai][bj][m][n]; ss += (x[0] * x[0] + x[1] * x[1]) + (x[2] * x[2] + x[3] * x[3]); }
                        ss += __shfl_xor(ss, 16); ss += __shfl_xor(ss, 32);
                        rinv = rsqrtf(ss * (1.f / 64.f) + EPS) * osc; }
                    bf16_t* dst;
                    if (isq) dst = YO + (size_t)row * 2048 + 1024 + (t * 4 + wc) * 64 + 8 * fq;
                    else { const int b = row >> 12, s = row & 4095; dst = KVB + (size_t)(t - 4) * KVBUF + ((size_t)(b * 4 + wc) * 4096 + s) * 64 + 8 * fq; }
#pragma unroll
                    for (int bj = 0; bj < 2; ++bj) { const f32x4 g0 = gvv[bj][0], g1 = gvv[bj][1];
                        const f32x4 v0 = acc[ai][bj][m][0] * rinv * g0, v1 = acc[ai][bj][m][1] * rinv * g1;
                        *(u32x4*)(dst + 32 * bj) = pack8(v0, v1); }
                }
        } else if (t < 18) {
#pragma unroll
            for (int ai = 0; ai < 2; ++ai)
#pragma unroll
                for (int m = 0; m < 4; ++m) { bf16_t* dst = MG + (size_t)(row0 + ai * 128 + m * 16) * 2048 + (t - 10) * 256 + 64 * wc + 8 * fq;
#pragma unroll
                    for (int bj = 0; bj < 2; ++bj) { f32x4 v0 = acc[ai][bj][m][0], v1 = acc[ai][bj][m][1];
#pragma unroll
                        for (int i = 0; i < 4; ++i) { v0[i] = sigm(v0[i]); v1[i] = sigm(v1[i]); }
                        *(u32x4*)(dst + 32 * bj) = pack8(v0, v1); } }
        } else if (wc == 0) {
#pragma unroll
            for (int ai = 0; ai < 2; ++ai)
#pragma unroll
                for (int m = 0; m < 4; ++m) { float* dst = NG + (size_t)(row0 + ai * 128 + m * 16) * 64 + 8 * fq;
#pragma unroll
                    for (int bj = 0; bj < 2; ++bj)
#pragma unroll
                        for (int n = 0; n < 2; ++n) { f32x4 v = acc[ai][bj][m][n];
#pragma unroll
                            for (int i = 0; i < 4; ++i) v[i] = sigm(v[i]);
                            *(f32x4*)(dst + 32 * bj + 4 * n) = v; } }
        }
    }
};
struct EpiGate {
    static constexpr bool PERM = true, MID = false;
    const bf16_t* XR; bf16_t* LA; bf16_t* U; const float* ba; const float* bi; const float* lam;
    __device__ __forceinline__ void operator()(AccRef acc, const Unit& u, int wr, int wc, int fr, int fq) const {
        const int row0 = u.pm * 256 + wr * 64 + fr;
#pragma unroll
        for (int n = 0; n < 2; ++n) {
            const int ch0 = u.pn * 128 + wc * 32 + 8 * fq + 4 * n;
            const f32x4 bav = *(const f32x4*)(ba + ch0), biv = *(const f32x4*)(bi + ch0), spv = *(const f32x4*)(lam + ch0);
#pragma unroll
            for (int ai = 0; ai < 2; ++ai) {
                u32x2 xwv[4];
#pragma unroll
                for (int m = 0; m < 4; ++m) xwv[m] = *(const u32x2*)(XR + (size_t)(row0 + ai * 128 + m * 16) * 1024 + ch0);
#pragma unroll
                for (int m = 0; m < 4; ++m) { const int row = row0 + ai * 128 + m * 16; const bool first = (row & 4095) == 0;
                    const u32x2 xw = xwv[m];
                    const float xv[4] = {bf_lo(xw.x), bf_hi(xw.x), bf_lo(xw.y), bf_hi(xw.y)};
                    float la[4], uu[4];
#pragma unroll
                    for (int i = 0; i < 4; ++i) { const float rp = acc[ai][0][m][n][i] + bav[i], ip = acc[ai][1][m][n][i] + biv[i];
                        const float l2 = sigm(rp) * spv[i];
                        const float a2 = ex2(2.f * l2); float mult = __builtin_amdgcn_sqrtf(fmaxf(1.f - a2, 0.f)); if (first) mult = 1.f;
                        la[i] = l2; uu[i] = mult * sigm(ip) * xv[i]; }
                    u32x2 w0, w1; w0.x = pk_bf16(la[0], la[1]); w0.y = pk_bf16(la[2], la[3]); w1.x = pk_bf16(uu[0], uu[1]); w1.y = pk_bf16(uu[2], uu[3]);
                    *(u32x2*)(LA + (size_t)row * 1024 + ch0) = w0; *(u32x2*)(U + (size_t)row * 1024 + ch0) = w1; } }
        }
    }
};
struct EpiCmp1 {
    static constexpr bool PERM = true, MID = false;
    bf16_t* HID; const float* bias1;
    __device__ __forceinline__ void operator()(AccRef acc, const Unit& u, int wr, int wc, int fr, int fq) const {
        const int which = u.pm >> 5; const int row0 = u.pm * 256 + wr * 64 + fr;
#pragma unroll
        for (int ai = 0; ai < 2; ++ai)
#pragma unroll
            for (int m = 0; m < 4; ++m) { bf16_t* dst = HID + (size_t)(row0 + ai * 128 + m * 16) * 256 + wc * 32 + 8 * fq;
#pragma unroll
                for (int bj = 0; bj < 2; ++bj) { const float* bp = bias1 + which * 256 + bj * 128 + wc * 32 + 8 * fq;
                    f32x4 v0 = acc[ai][bj][m][0] + *(const f32x4*)bp, v1 = acc[ai][bj][m][1] + *(const f32x4*)(bp + 4);
#pragma unroll
                    for (int i = 0; i < 4; ++i) { v0[i] = gelu_t(v0[i]); v1[i] = gelu_t(v1[i]); }
                    *(u32x4*)(dst + bj * 128) = pack8(v0, v1); } }
    }
};
template <int ADD> struct EpiMix {
    static constexpr bool PERM = true, MID = false;
    bf16_t* MB; const bf16_t* MG; int sel;
    __device__ __forceinline__ void operator()(AccRef acc, const Unit& u, int wr, int wc, int fr, int fq) const {
        const int row0 = u.pm * 256 + wr * 64 + fr, col0 = u.pn * 256 + wc * 32 + 8 * fq;
#pragma unroll
        for (int ai = 0; ai < 2; ++ai)
#pragma unroll
            for (int mp = 0; mp < 2; ++mp) {
                u32x4 gwv[2][2], owv[2][2];
#pragma unroll
                for (int mm = 0; mm < 2; ++mm)
#pragma unroll
                    for (int bj = 0; bj < 2; ++bj) { const int row = row0 + ai * 128 + (2 * mp + mm) * 16, col = col0 + bj * 128;
                        gwv[mm][bj] = *(const u32x4*)(MG + (size_t)row * 2048 + sel * 1024 + col);
                        owv[mm][bj] = ADD ? *(const u32x4*)(MB + (size_t)row * 1024 + col) : (u32x4){0u, 0u, 0u, 0u}; }
#pragma unroll
                for (int mm = 0; mm < 2; ++mm)
#pragma unroll
                    for (int bj = 0; bj < 2; ++bj) { const int row = row0 + ai * 128 + (2 * mp + mm) * 16, col = col0 + bj * 128; const u32x4 gw = gwv[mm][bj], ow = owv[mm][bj];
                        f32x4 v0 = acc[ai][bj][2 * mp + mm][0], v1 = acc[ai][bj][2 * mp + mm][1];
                        v0[0] *= bf_lo(gw.x); v0[1] *= bf_hi(gw.x); v0[2] *= bf_lo(gw.y); v0[3] *= bf_hi(gw.y);
                        v1[0] *= bf_lo(gw.z); v1[1] *= bf_hi(gw.z); v1[2] *= bf_lo(gw.w); v1[3] *= bf_hi(gw.w);
                        if (ADD) { v0[0] += bf_lo(ow.x); v0[1] += bf_hi(ow.x); v0[2] += bf_lo(ow.y); v0[3] += bf_hi(ow.y);
                            v1[0] += bf_lo(ow.z); v1[1] += bf_hi(ow.z); v1[2] += bf_lo(ow.w); v1[3] += bf_hi(ow.w); }
                        *(u32x4*)(MB + (size_t)row * 1024 + col) = pack8(v0, v1); } }
    }
};
struct EpiMixM {
    static constexpr bool PERM = true, MID = true;
    bf16_t* MB; const bf16_t* MG;
    __device__ __forceinline__ void mid(f32x4 (&acc)[2][2][4][2], const Unit& u, int wr, int wc, int fr, int fq) const {
        int row0 = u.pm * 256 + wr * 64 + fr, col0 = u.pn * 256 + wc * 32 + 8 * fq; asm volatile("" : "+v"(row0), "+v"(col0));
#pragma unroll
        for (int ai = 0; ai < 2; ++ai)
#pragma unroll
            for (int m = 0; m < 4; ++m)
#pragma unroll
                for (int bj = 0; bj < 2; ++bj) { const bf16_t* gp = MG + (size_t)(row0 + ai * 128 + m * 16) * 2048 + col0 + bj * 128;
                    const u32x4 g0 = *(const u32x4*)gp, g1 = *(const u32x4*)(gp + 1024);
                    f32x4 r0, r1;
                    r0[0] = bf_lo(g0.x) * __builtin_amdgcn_rcpf(bf_lo(g1.x)); r0[1] = bf_hi(g0.x) * __builtin_amdgcn_rcpf(bf_hi(g1.x)); r0[2] = bf_lo(g0.y) * __builtin_amdgcn_rcpf(bf_lo(g1.y)); r0[3] = bf_hi(g0.y) * __builtin_amdgcn_rcpf(bf_hi(g1.y));
                    r1[0] = bf_lo(g0.z) * __builtin_amdgcn_rcpf(bf_lo(g1.z)); r1[1] = bf_hi(g0.z) * __builtin_amdgcn_rcpf(bf_hi(g1.z)); r1[2] = bf_lo(g0.w) * __builtin_amdgcn_rcpf(bf_lo(g1.w)); r1[3] = bf_hi(g0.w) * __builtin_amdgcn_rcpf(bf_hi(g1.w));
                    acc[ai][bj][m][0] *= r0; acc[ai][bj][m][1] *= r1; }
    }
    __device__ __forceinline__ void operator()(AccRef acc, const Unit& u, int wr, int wc, int fr, int fq) const {
        const int row0 = u.pm * 256 + wr * 64 + fr, col0 = u.pn * 256 + wc * 32 + 8 * fq;
#pragma unroll
        for (int ai = 0; ai < 2; ++ai) {
            u32x4 gwv[4][2];
#pragma unroll
            for (int m = 0; m < 4; ++m)
#pragma unroll
                for (int bj = 0; bj < 2; ++bj) gwv[m][bj] = *(const u32x4*)(MG + (size_t)(row0 + ai * 128 + m * 16) * 2048 + 1024 + col0 + bj * 128);
#pragma unroll
            for (int m = 0; m < 4; ++m)
#pragma unroll
                for (int bj = 0; bj < 2; ++bj) { const int row = row0 + ai * 128 + m * 16, col = col0 + bj * 128; const u32x4 gw = gwv[m][bj];
                    f32x4 v0 = acc[ai][bj][m][0], v1 = acc[ai][bj][m][1];
                    v0[0] *= bf_lo(gw.x); v0[1] *= bf_hi(gw.x); v0[2] *= bf_lo(gw.y); v0[3] *= bf_hi(gw.y);
                    v1[0] *= bf_lo(gw.z); v1[1] *= bf_hi(gw.z); v1[2] *= bf_lo(gw.w); v1[3] *= bf_hi(gw.w);
                    *(u32x4*)(MB + (size_t)row * 1024 + col) = pack8(v0, v1); } }
    }
};
struct EpiRes {
    static constexpr bool PERM = false, MID = false;
    const float* base; float* out;
    __device__ __forceinline__ void operator()(AccRef acc, const Unit& u, int wr, int wc, int fr, int fq) const {
        const int row0 = u.pm * 256 + wr * 64 + fr, col0 = u.pn * 256 + wc * 32 + 4 * fq;
#pragma unroll
        for (int ai = 0; ai < 2; ++ai)
#pragma unroll
            for (int mp = 0; mp < 2; ++mp) {
                f32x4 bs[2][2][2];
#pragma unroll
                for (int mm = 0; mm < 2; ++mm) { const size_t off = (size_t)(row0 + ai * 128 + (2 * mp + mm) * 16) * 1024 + col0;
#pragma unroll
                    for (int bj = 0; bj < 2; ++bj)
#pragma unroll
                        for (int n = 0; n < 2; ++n) bs[mm][bj][n] = *(const f32x4*)(base + off + bj * 128 + n * 16); }
#pragma unroll
                for (int mm = 0; mm < 2; ++mm) { const size_t off = (size_t)(row0 + ai * 128 + (2 * mp + mm) * 16) * 1024 + col0;
#pragma unroll
                    for (int bj = 0; bj < 2; ++bj)
#pragma unroll
                        for (int n = 0; n < 2; ++n) *(f32x4*)(out + off + bj * 128 + n * 16) = bs[mm][bj][n] + acc[ai][bj][2 * mp + mm][n]; } }
    }
};
struct EpiSwi {
    static constexpr bool PERM = true, MID = false;
    bf16_t* ACT;
    __device__ __forceinline__ void operator()(AccRef acc, const Unit& u, int wr, int wc, int fr, int fq) const {
        const int row0 = u.pm * 256 + wr * 64 + fr, ch0 = u.pn * 128 + wc * 32 + 8 * fq;
#pragma unroll
        for (int ai = 0; ai < 2; ++ai)
#pragma unroll
            for (int m = 0; m < 4; ++m) { f32x4 v0, v1;
#pragma unroll
                for (int i = 0; i < 4; ++i) { const float g0 = acc[ai][0][m][0][i], g1 = acc[ai][0][m][1][i];
                    v0[i] = g0 * sigm(g0) * acc[ai][1][m][0][i]; v1[i] = g1 * sigm(g1) * acc[ai][1][m][1][i]; }
                *(u32x4*)(ACT + (size_t)(row0 + ai * 128 + m * 16) * D_FF + ch0) = pack8(v0, v1); }
    }
};

__device__ __forceinline__ void xpose_item(const float* W, int Ns, int col0, int valid, bf16_t* dst, int K, int k0, LAS float* scr, int lane) {
#pragma unroll
    for (int i = 0; i < 32; ++i) { const int kk = 2 * i + (lane >> 5), n = lane & 31; scr[kk * 33 + n] = (n < valid) ? W[(size_t)(k0 + kk) * Ns + col0 + n] : 0.f; }
    asm volatile("s_waitcnt lgkmcnt(0)" ::: "memory");
    const int c = lane & 7;
#pragma unroll
    for (int j = 0; j < 4; ++j) { const int n = (lane >> 3) + 8 * j; const LAS float* s = scr + (8 * c) * 33 + n;
        u32x4 o; o.x = pk_bf16(s[0 * 33], s[1 * 33]); o.y = pk_bf16(s[2 * 33], s[3 * 33]); o.z = pk_bf16(s[4 * 33], s[5 * 33]); o.w = pk_bf16(s[6 * 33], s[7 * 33]);
        *(u32x4*)(dst + (size_t)n * K + k0 + 8 * c) = o; }
    asm volatile("s_waitcnt lgkmcnt(0)" ::: "memory");
}

struct Args { const float* in[25]; float* out; unsigned char* ws; int ph_lo, ph_hi; };
__device__ __forceinline__ unsigned char* opq(unsigned char* p);

__device__ __forceinline__ void weights_phase(const Args& a, int l, LAS unsigned char* lds, int gw, int ngw, int wave, int lane) {
    LAS float* scr = (LAS float*)(lds + wave * 16384);
    bf16_t* Wb = (bf16_t*)(opq(a.ws) + WS_W);
    const float* w_in = a.in[2] + (size_t)l * 1024 * D_IN;
    constexpr int I1 = 16 * 64, I2 = 16 * 152, I3 = 4 * 64, I4 = 32 * 16, I5 = 16 * 32, I6 = 16 * 176, I7 = 44 * 32;
    constexpr int NIT = I1 + I2 + I3 + I4 + 3 * I5 + I6 + I7;
    for (int it = gw; it < NIT; it += ngw) {
        int r = it;
        if (r < I1) { const int kb = r / 64, gi = r % 64; xpose_item(w_in, D_IN, 32 * gi, 32, Wb + W_INA / 2 + (size_t)(32 * gi) * 1024, 1024, 64 * kb, scr, lane); continue; } r -= I1;
        if (r < I2) { const int kb = r / 152, gi = r % 152; const int t = gi >> 3, gl = gi & 7, ca = 64 * (gl & 3) + 32 * (gl >> 2);
            int col0, valid = 32;
            if (t < 10) col0 = 2048 + 256 * t + ca; else if (t < 18) col0 = 4656 + 256 * (t - 10) + ca; else { col0 = 4608 + ca; valid = 48 - ca; valid = valid < 0 ? 0 : (valid > 32 ? 32 : valid); }
            xpose_item(w_in, D_IN, col0, valid, Wb + W_INB / 2 + (size_t)(32 * gi) * 1024, 1024, 64 * kb, scr, lane); continue; } r -= I2;
        if (r < I3) { const int kb = r / 64, gi = r % 64; const int pn = gi >> 3, gl = gi & 7, bj = gl >> 2, ch = 128 * pn + 32 * (gl & 3);
            const float* W = (bj ? a.in[7] : a.in[5]) + (size_t)l * 4 * 65536 + (size_t)(ch >> 8) * 65536;
            xpose_item(W, 256, ch & 255, 32, Wb + W_G / 2 + (size_t)(32 * gi) * 256, 256, 64 * kb, scr, lane); continue; } r -= I3;
        if (r < I4) { const int kb = r / 16, gi = r % 16; const float* W = ((gi >> 3) ? a.in[16] : a.in[14]) + (size_t)l * 2048 * 256;
            xpose_item(W, 256, 32 * (gi & 7), 32, Wb + W_C1 / 2 + (size_t)(32 * gi) * 2048, 2048, 64 * kb, scr, lane); continue; } r -= I4;
        if (r < 3 * I5) { const int which = r / I5; r -= which * I5; const int kb = r / 32, gi = r % 32;
            const float* W = a.in[18 + which] + (size_t)l * 1024 * 1024;
            if (which < 2) xpose_item(W, 1024, 32 * gi, 32, Wb + W_YA / 2 + (size_t)(32 * gi) * 2048 + which * 1024, 2048, 64 * kb, scr, lane);
            else xpose_item(W, 1024, 32 * gi, 32, Wb + W_O / 2 + (size_t)(32 * gi) * 1024, 1024, 64 * kb, scr, lane);
            continue; } r -= 3 * I5;
        if (r < I6) { const int kb = r / 176, gi = r % 176; const int pn = gi >> 3, gl = gi & 7, bj = gl >> 2;
            const float* W = (bj ? a.in[23] : a.in[22]) + (size_t)l * 1024 * D_FF;
            xpose_item(W, D_FF, 128 * pn + 32 * (gl & 3), 32, Wb + W_GU / 2 + (size_t)(32 * gi) * 1024, 1024, 64 * kb, scr, lane); continue; } r -= I6;
        { const int kb = r / 32, gi = r % 32; const float* W = a.in[24] + (size_t)l * D_FF * 1024;
            xpose_item(W, 1024, 32 * gi, 32, Wb + W_D / 2 + (size_t)(32 * gi) * D_FF, D_FF, 64 * kb, scr, lane); }
    }
}

__device__ __forceinline__ void rms_phase(const float* x, const float* g, bf16_t* out, int gw, int ngw, int lane) {
    f32x4 gv[4];
#pragma unroll
    for (int j = 0; j < 4; ++j) gv[j] = ((const f32x4*)g)[lane + 64 * j];
    for (int m0 = gw; m0 < MTOK; m0 += 4 * ngw) {
        f32x4 v[4][4];
#pragma unroll
        for (int e = 0; e < 4; ++e) { const int m = m0 + e * ngw; const f32x4* xr = (const f32x4*)(x + (size_t)(m < MTOK ? m : m0) * 1024) + lane;
#pragma unroll
            for (int j = 0; j < 4; ++j) v[e][j] = xr[64 * j]; }
#pragma unroll
        for (int e = 0; e < 4; ++e) { const int m = m0 + e * ngw; float s = 0.f;
#pragma unroll
            for (int j = 0; j < 4; ++j) s += (v[e][j][0] * v[e][j][0] + v[e][j][1] * v[e][j][1]) + (v[e][j][2] * v[e][j][2] + v[e][j][3] * v[e][j][3]);
            const float rinv = rsqrtf(wave_sum(s) * (1.f / 1024.f) + EPS);
            if (m < MTOK) { u32x2* o8 = (u32x2*)(out + (size_t)m * 1024) + lane;
#pragma unroll
                for (int j = 0; j < 4; ++j) { u32x2 w; w.x = pk_bf16(v[e][j][0] * rinv * gv[j][0], v[e][j][1] * rinv * gv[j][1]); w.y = pk_bf16(v[e][j][2] * rinv * gv[j][2], v[e][j][3] * rinv * gv[j][3]); o8[64 * j] = w; } } }
    }
}

namespace att {
constexpr int NST = 5, DEPTH_INFLIGHT = 4;
constexpr int STAGE = 16384;
constexpr int OFF_WS = NST * STAGE, WS_PER_WAVE = 8192 + 256;
__device__ __forceinline__ int crow(int r, int hi) { return (r & 3) + 8 * (r >> 2) + 4 * hi; }
__device__ __forceinline__ s16x4 vtr(const LAS unsigned char* p) { typedef short v4i16_t __attribute__((ext_vector_type(4))); return __builtin_bit_cast(s16x4, __builtin_amdgcn_ds_read_tr16_b64_v4i16((LAS v4i16_t*)p)); }

__device__ __forceinline__ void job_decode(int j, int nct, int qi, int kt0, int& type, int& tile) {
    if (j < nct) { type = 1; tile = j; } else if (j < nct + qi + 1) { type = 2; tile = j - nct; } else { type = 3; tile = kt0 + (j - nct - qi - 1); }
}

__device__ __forceinline__ void attn_phase(LAS unsigned char* lds, const bf16_t* KVB, const bf16_t* KC, const bf16_t* VC, const bf16_t* YO, bf16_t* OUT, int ldo, const float* NG, const float* qn, const float* kn) {
    const int tid = tid_opq(), lane = tid & 63, w = __builtin_amdgcn_readfirstlane(tid >> 6), q = lane & 31, hi = lane >> 5, hh = q >> 3, tl = q & 7;
    LAS float* impw = (LAS float*)(lds + OFF_WS + w * WS_PER_WAVE);
    LAS float* rs = impw + 2048;
    LAS float* rs2 = rs + 32;
    const float gq = wave_max(fabsf(qn[lane]));
    const float nB0 = -8.5f * LOG2E * gq * wave_max(fabsf(kn[lane]));
    const float nB1 = -8.5f * LOG2E * gq * wave_max(fabsf(kn[64 + lane]));
    const float nB2 = -8.5f * LOG2E * gq * wave_max(fabsf(kn[128 + lane]));
    const int G = gd_opq(), bx = bx_opq();
    const int drow = 8 * w + (lane >> 3), dsl = lane & 7;
    const unsigned dkoff = (unsigned)(drow * 128 + ((dsl ^ ((drow >> 1) & 7)) * 16));
    const unsigned dvoff = (unsigned)(drow * 128 + ((dsl ^ (4 * ((drow >> 1) & 1))) * 16));
    const unsigned ldsw = (unsigned)w * 1024u;
    const int kfx = (q >> 1) & 7;
    const int qrow = (lane & 15) >> 2, pcol = lane & 3, cgp = (lane >> 4) & 1, fbit = (qrow >> 1) & 1;
    const int vbase = (4 * hi + qrow) * 128 + (2 * cgp + (pcol >> 1)) * 16 + 8 * (pcol & 1);
    const int vb0 = vbase + fbit * 64, vb1 = vbase + (fbit ^ 1) * 64;
#define ATT_WAIT_BAR(N) asm volatile("s_waitcnt vmcnt(" #N ") lgkmcnt(0)\n\ts_barrier" ::: "memory")
    for (int it = 0;; ++it) {
        int qi, bg;
        if (G == 256) { if (it >= 8) break; const int r = bx >> 5; qi = 8 * (7 - it) + ((it & 1) ? r : 7 - r); bg = bx & 31; }
        else { const int idx = it * G + bx; if (idx >= 2048) break; qi = 63 - (idx >> 5); bg = idx & 31; }
        const int b = bg >> 2, g = bg & 3;
        const int tt = w * 8 + tl, tq = qi * 64 + tt;
        const size_t row = (size_t)b * 4096 + tq;
        const int head = g * 4 + hh;
        bf16x8 qf[4];
#pragma unroll
        for (int d0 = 0; d0 < 4; ++d0) qf[d0] = *(const bf16x8*)(YO + row * 2048 + 1024 + head * 64 + 16 * d0 + 8 * hi);
        const int cmaxq = (tq - 31) >> 4;
        const int nct = (4 * qi + 2) / 64 + 1;
        const int nw = (qi < 8 ? qi : 8) + 1, kt0 = qi - (nw - 1);
        const int NJ = nct + (qi + 1) + nw;
        const char* kcb = (const char*)(KC + (size_t)bg * 256 * 64); const char* vcb = (const char*)(VC + (size_t)bg * 256 * 64);
        const char* ksb = (const char*)(KVB + 2 * KVBUF + (size_t)bg * 4096 * 64); const char* vsb = (const char*)(KVB + 3 * KVBUF + (size_t)bg * 4096 * 64);
        const char* kwb = (const char*)(KVB + 4 * KVBUF + (size_t)bg * 4096 * 64); const char* vwb = (const char*)(KVB + 5 * KVBUF + (size_t)bg * 4096 * 64);
#define ATT_ISSUE(j_, st_) do { int ty_, tile_; job_decode((j_) < NJ ? (j_) : NJ - 1, nct, qi, kt0, ty_, tile_); \
            const char* kp_ = (ty_ < 2 ? kcb : (ty_ == 2 ? ksb : kwb)) + (size_t)tile_ * 8192; const char* vp_ = (ty_ < 2 ? vcb : (ty_ == 2 ? vsb : vwb)) + (size_t)tile_ * 8192; \
            __builtin_amdgcn_global_load_lds((const unsigned*)(kp_ + dkoff), (LAS unsigned*)(lds + (st_) * STAGE + ldsw), 16, 0, 0); \
            __builtin_amdgcn_global_load_lds((const unsigned*)(vp_ + dvoff), (LAS unsigned*)(lds + (st_) * STAGE + 8192 + ldsw), 16, 0, 0); } while (0)
        ATT_ISSUE(0, 0); ATT_ISSUE(1, 1); ATT_ISSUE(2, 2);
        f32x16 ofin[2], ocur[2];
#pragma unroll
        for (int r = 0; r < 16; ++r) { ofin[0][r] = 0.f; ofin[1][r] = 0.f; ocur[0][r] = 0.f; ocur[1][r] = 0.f; }
        float lsum = 0.f, carry = 0.f;
        unsigned long long mymask = (2ull << qi) - 1ull, unionmask = mymask;
        int st_cur = 0, st_iss = 3;
        for (int jp = 0; jp < NJ; jp += 2) {
            ATT_WAIT_BAR(2);
            ATT_ISSUE(jp + 3, st_iss); st_iss = (st_iss == NST - 1) ? 0 : st_iss + 1;
            ATT_ISSUE(jp + 4, st_iss); st_iss = (st_iss == NST - 1) ? 0 : st_iss + 1;
          for (int half = 0; half < 2; ++half) {
            const int j = jp + half; if (j >= NJ) break;
            int type, tile; job_decode(j, nct, qi, kt0, type, tile);
            const LAS unsigned char* Kb = lds + st_cur * STAGE;
            const LAS unsigned char* Vb = Kb + 8192;
            st_cur = (st_cur == NST - 1) ? 0 : st_cur + 1;
            const bool skip = (type == 2) && (((unionmask >> tile) & 1ull) == 0ull);
            if (!skip) {
                const float nbT = type < 2 ? nB0 : (type == 2 ? nB1 : nB2);
                const unsigned long long msel = (type == 2) ? mymask : ~0ull;
                const float rowsel = (float)(unsigned)((msel >> tile) & 1ull);
                const float nB = fmaf(rowsel, nbT, fmaf(rowsel, 30000.f, -30000.f));
                f32x16 p0, p1, cin;
#pragma unroll
                for (int r = 0; r < 16; ++r) cin[r] = nB;
#define ATT_QK2() do { \
                p0 = __builtin_amdgcn_mfma_f32_32x32x16_bf16(*(const LAS bf16x8*)(Kb + q * 128 + (hi ^ kfx) * 16), qf[0], cin, 0, 0, 0); \
                _Pragma("unroll") for (int d0 = 1; d0 < 4; ++d0) p0 = __builtin_amdgcn_mfma_f32_32x32x16_bf16(*(const LAS bf16x8*)(Kb + q * 128 + ((2 * d0 + hi) ^ kfx) * 16), qf[d0], p0, 0, 0, 0); \
                p1 = __builtin_amdgcn_mfma_f32_32x32x16_bf16(*(const LAS bf16x8*)(Kb + (32 + q) * 128 + (hi ^ kfx) * 16), qf[0], cin, 0, 0, 0); \
                _Pragma("unroll") for (int d0 = 1; d0 < 4; ++d0) p1 = __builtin_amdgcn_mfma_f32_32x32x16_bf16(*(const LAS bf16x8*)(Kb + (32 + q) * 128 + ((2 * d0 + hi) ^ kfx) * 16), qf[d0], p1, 0, 0, 0); } while (0)
#define ATT_PV2() do { _Pragma("unroll") for (int s = 0; s < 4; ++s) { u32x4 pw; \
                    if (s < 2) { pw.x = pk_bf16(p0[8 * s], p0[8 * s + 1]); pw.y = pk_bf16(p0[8 * s + 2], p0[8 * s + 3]); pw.z = pk_bf16(p0[8 * s + 4], p0[8 * s + 5]); pw.w = pk_bf16(p0[8 * s + 6], p0[8 * s + 7]); } \
                    else { const int s2 = s - 2; pw.x = pk_bf16(p1[8 * s2], p1[8 * s2 + 1]); pw.y = pk_bf16(p1[8 * s2 + 2], p1[8 * s2 + 3]); pw.z = pk_bf16(p1[8 * s2 + 4], p1[8 * s2 + 5]); pw.w = pk_bf16(p1[8 * s2 + 6], p1[8 * s2 + 7]); } \
                    const bf16x8 pa = __builtin_bit_cast(bf16x8, pw); \
                    { const s16x4 vlo = vtr(Vb + s * 2048 + vb0), vhi = vtr(Vb + s * 2048 + 1024 + vb0); \
                      const bf16x8 vf = (bf16x8){vlo[0], vlo[1], vlo[2], vlo[3], vhi[0], vhi[1], vhi[2], vhi[3]}; ocur[0] = __builtin_amdgcn_mfma_f32_32x32x16_bf16(pa, vf, ocur[0], 0, 0, 0); } \
                    { const s16x4 vlo = vtr(Vb + s * 2048 + vb1), vhi = vtr(Vb + s * 2048 + 1024 + vb1); \
                      const bf16x8 vf = (bf16x8){vlo[0], vlo[1], vlo[2], vlo[3], vhi[0], vhi[1], vhi[2], vhi[3]}; ocur[1] = __builtin_amdgcn_mfma_f32_32x32x16_bf16(pa, vf, ocur[1], 0, 0, 0); } } } while (0)
                const bool interior = (type == 2 && tile < qi) || (type == 3 && tile > qi - 8 && tile < qi);
                if (interior) {
                    ATT_QK2();
                    float ps = 0.f, ps1 = 0.f;
#pragma unroll
                    for (int r = 0; r < 16; ++r) { p0[r] = ex2(p0[r]); ps += p0[r]; }
#pragma unroll
                    for (int r = 0; r < 16; ++r) { p1[r] = ex2(p1[r]); ps1 += p1[r]; }
                    lsum += ps + ps1;
                    ATT_PV2();
                } else {
                    ATT_QK2();
                    int lo = 0, hiq = 63;
                    if (type < 2) hiq = cmaxq - 64 * tile;
                    else if (type == 2) { if (tile == qi) hiq = tt; }
                    else { if (tile == qi - 8) lo = tt + 1; if (tile == qi) hiq = tt; }
                    float ps = 0.f;
#pragma unroll
                    for (int r = 0; r < 16; ++r) { const int k0i = crow(r, hi), k1i = k0i + 32;
                        p0[r] = (k0i >= lo && k0i <= hiq) ? ex2(p0[r]) : 0.f; p1[r] = (k1i >= lo && k1i <= hiq) ? ex2(p1[r]) : 0.f; ps += p0[r] + p1[r]; }
                    lsum += ps;
                    if (type == 1 && qi >= 16) {
                        float s4[8], b3[8], pb[8];
#pragma unroll
                        for (int a = 0; a < 4; ++a) { s4[a] = (p0[4 * a] + p0[4 * a + 1]) + (p0[4 * a + 2] + p0[4 * a + 3]); b3[a] = p0[4 * a + 3];
                            s4[4 + a] = (p1[4 * a] + p1[4 * a + 1]) + (p1[4 * a + 2] + p1[4 * a + 3]); b3[4 + a] = p1[4 * a + 3]; }
#pragma unroll
                        for (int x = 0; x < 8; ++x) pb[x] = __shfl_xor(b3[x], 32);
#pragma unroll
                        for (int x = 0; x < 8; ++x) { const float extra = hi ? pb[x] : (x == 0 ? carry : pb[x == 0 ? 0 : x - 1]);
                            const int n = 16 * tile + 2 * (x & 3) + hi + 8 * (x >> 2);
                            impw[q * 64 + n] = s4[x] + extra; }
                        carry = pb[7];
                    }
                    ATT_PV2();
                }
#undef ATT_QK2
#undef ATT_PV2
            }
            const bool end_c2 = (type == 1 && tile == nct - 1), end_s = (type == 2 && tile == qi), end_w = (type == 3 && tile == qi);
            if (end_c2 || end_s || end_w) {
                const float l = lsum + __shfl_xor(lsum, 32);
                const float gt_ = NG[row * 64 + (end_c2 ? 0 : (end_s ? 16 : 32)) + head];
                const float linv = l > 0.f ? 1.f / l : 0.f;
                const float sc = gt_ * linv;
                if (hi == 0) { rs[q] = sc; if (end_c2) rs2[q] = linv; }
#pragma unroll
                for (int r = 0; r < 16; ++r) { const float f = rs[crow(r, hi)]; ofin[0][r] += f * ocur[0][r]; ofin[1][r] += f * ocur[1][r]; ocur[0][r] = 0.f; ocur[1][r] = 0.f; }
                lsum = 0.f;
            }
            if (end_c2 && qi >= 16) {
                unionmask = 0ull; mymask = 0ull;
                for (int i = 0; i < 8; ++i) {
                    const int n = lane; const bool valid = n <= qi, forced = (n == 0) || (n == qi) || (n == qi - 1);
                    const float sc = forced ? 1e6f : (impw[i * 64 + n] * rs2[i] + impw[(8 + i) * 64 + n] * rs2[8 + i]) + (impw[(16 + i) * 64 + n] * rs2[16 + i] + impw[(24 + i) * 64 + n] * rs2[24 + i]);
                    const unsigned key = valid ? ((__float_as_uint(sc) & ~63u) | (unsigned)(63 - n)) : 0u;
                    unsigned T = 0u;
#pragma unroll
                    for (int bit = 30; bit >= 0; --bit) { const unsigned cand = T | (1u << bit); const unsigned long long bm = __ballot(key >= cand); if (__popcll(bm) >= 16) T = cand; }
                    const unsigned long long mk = __ballot(valid && key >= T);
                    unionmask |= mk; if (tl == i) mymask = mk;
                }
            }
          }
        }
#pragma unroll
        for (int r = 0; r < 16; ++r) { const int qq = crow(r, hi); const size_t orow = (size_t)b * 4096 + qi * 64 + w * 8 + (qq & 7);
            bf16_t* op = OUT + orow * ldo + (g * 4 + (qq >> 3)) * 64 + q;
            op[0] = (bf16_t)(pk_bf16(ofin[0][r], 0.f) & 0xffffu); op[32] = (bf16_t)(pk_bf16(ofin[1][r], 0.f) & 0xffffu); }
        ATT_WAIT_BAR(0);
#undef ATT_ISSUE
    }
#undef ATT_WAIT_BAR
}
}


#define XB_TMO      128
#define XB_XCNT(j)  (256  + 64 * (j))
#define XB_XSUB(j)  (1280 + 64 * (j))
#define XB_XGEN(j)  (2304 + 64 * (j))
#define XB_TOP      3328
#define XB_TOPGEN   3392
#define XCD_BAR_WORDS 3456
#define XB_SPIN_CAP (1u << 22)
__device__ __forceinline__ unsigned xb_ld(unsigned* p)              { return __hip_atomic_load(p, __ATOMIC_RELAXED, __HIP_MEMORY_SCOPE_AGENT); }
__device__ __forceinline__ unsigned xb_add(unsigned* p, unsigned v) { return __hip_atomic_fetch_add(p, v, __ATOMIC_RELAXED, __HIP_MEMORY_SCOPE_AGENT); }
__device__ __forceinline__ unsigned xb_xcc_id() { return (unsigned)__builtin_amdgcn_s_getreg((3 << 11) | 20) & 0xFu; }
#define XB_SPIN(cond, bar) do { unsigned _sp = 0; while (cond) { __builtin_amdgcn_s_sleep(1); \
    if ((++_sp & 255u) == 0u) { if (xb_ld(&(bar)[XB_TMO])) break; if (_sp > XB_SPIN_CAP) { atomicAdd(&(bar)[XB_TMO], 1u); break; } } } } while (0)
struct XcdBarrier { unsigned* bar; unsigned x; volatile LAS unsigned* st; };
__device__ __forceinline__ void xcd_barrier_complete(unsigned* bar, unsigned x, unsigned& nloc, unsigned& nx) {
    const unsigned G = gridDim.x * gridDim.y * gridDim.z;
    unsigned sum, cnt, mine, sp = 0u;
    for (;;) {
        sum = 0u; cnt = 0u; mine = 0u;
#pragma unroll
        for (unsigned j = 0; j < 16; ++j) { const unsigned c = xb_ld(&bar[XB_XCNT(j)]); sum += c; cnt += (c > 0u) ? 1u : 0u; mine = (j == x) ? c : mine; }
        if (sum == G) break;
        __builtin_amdgcn_s_sleep(1);
        if ((++sp & 255u) == 0u) { if (xb_ld(&bar[XB_TMO])) break; if (sp > XB_SPIN_CAP) { atomicAdd(&bar[XB_TMO], 1u); break; } }
    }
    nloc = mine > 0u ? mine : 1u; nx = cnt > 0u ? cnt : 1u;
}
__device__ __forceinline__ void xcd_barrier(unsigned* bar, volatile LAS unsigned* st) {
    asm volatile("s_waitcnt vmcnt(0)" ::: "memory");
    __syncthreads();
    if (threadIdx.x == 0) {
        const unsigned x = xb_xcc_id();
        __builtin_amdgcn_s_waitcnt(0);
        unsigned nloc = st[0], nx = st[1];
        if (nloc == 0u) { xcd_barrier_complete(bar, x, nloc, nx); st[0] = nloc; st[1] = nx; }
        const unsigned old = xb_add(&bar[XB_XSUB(x)], 1u);
        const unsigned gen = old / nloc;
        if (old + 1u == (gen + 1u) * nloc) {
            __builtin_amdgcn_fence(__ATOMIC_RELEASE, "agent");
            asm volatile("s_waitcnt vmcnt(0)" ::: "memory");
            const unsigned og = xb_add(&bar[XB_TOP], 1u);
            const unsigned tg = og / nx;
            if (og + 1u == (tg + 1u) * nx) xb_add(&bar[XB_TOPGEN], 1u);
            else XB_SPIN(xb_ld(&bar[XB_TOPGEN]) == tg, bar);
            __builtin_amdgcn_fence(__ATOMIC_ACQUIRE, "agent");
            xb_add(&bar[XB_XGEN(x)], 1u);
            asm volatile("s_waitcnt vmcnt(0)" ::: "memory");
        } else {
            XB_SPIN(xb_ld(&bar[XB_XGEN(x)]) == gen, bar);
            __builtin_amdgcn_fence(__ATOMIC_ACQUIRE, "agent");
            asm volatile("s_waitcnt vmcnt(0)" ::: "memory");
        }
    }
    __syncthreads();
}

constexpr int LDS_BYTES = 155648;
constexpr int NPH = 16;

__device__ __forceinline__ unsigned char* opq(unsigned char* p) { asm volatile("" : "+s"(p)); return p; }
#define WSP(off) ((bf16_t*)(opq(a.ws) + (off)))
#define WSF(off) ((float*)(opq(a.ws) + (off)))

__global__ void __launch_bounds__(512, 2) mega(Args a) {
    extern __shared__ __attribute__((aligned(16))) unsigned char lds_raw[];
    LAS unsigned char* lds = (LAS unsigned char*)lds_raw;
    cg::grid_group grid = cg::this_grid();
    const int lo = a.ph_lo, hi = a.ph_hi;
    volatile LAS unsigned* xst = (volatile LAS unsigned*)(lds + 155648 - 64);
    if (threadIdx.x == 0) { xst[0] = 0u; xst[1] = 0u; if (hi - lo > 1) (void)xb_add(&((unsigned*)(a.ws + WS_BAR))[XB_XCNT(xb_xcc_id())], 1u); }
    __syncthreads();
#define IDS const int tid = tid_opq(), lane = tid & 63, wave = __builtin_amdgcn_readfirstlane(tid >> 6); const int G = gd_opq(), bx = bx_opq(); \
    const int gw = bx * 8 + wave, ngw = G * 8, gt = bx * 512 + tid, ngt = G * 512; (void)lane; (void)gw; (void)ngw; (void)gt; (void)ngt;
#define IN(k) (lo <= (l * NPH + (k)) && (l * NPH + (k)) < hi)
#define SEAM(k) do { if (lo <= (l * NPH + (k)) && (l * NPH + (k)) + 1 < hi) { if (hi < 0) grid.sync(); xcd_barrier((unsigned*)(opq(a.ws) + WS_BAR), xst); if (PROBE_SYNC2) xcd_barrier((unsigned*)(opq(a.ws) + WS_BAR), xst); } } while (0)
    for (int l = 0; l < DEPTH; ++l) {
        for (int rep_ = 0; rep_ < ((PROBE_DUP >> 0) & 1) + 1; ++rep_) if (IN(0)) {
            IDS
            weights_phase(a, l, lds, gw, ngw, wave, lane);
            rms_phase((l == 0) ? a.in[0] : a.out, a.in[1] + l * 1024, WSP(WS_H), gw, ngw, lane);
        }
        SEAM(0);
        for (int rep_ = 0; rep_ < ((PROBE_DUP >> 1) & 1) + 1; ++rep_) if (IN(1)) {
            pg8::StaticOrder S; pg8::Gemm g{WSP(WS_H), WSP(WS_W + W_INA), MTOK, 2048, 1024, 1024, 0, 0}; S.init(MTOK, 2048, gd_opq(), bx_opq());
            EpiInA E{WSP(WS_RX), WSP(WS_YO)}; pg8::gemm_phase<EpiInA>(lds, g, S, E);
        }
        SEAM(1);
        for (int rep_ = 0; rep_ < ((PROBE_DUP >> 2) & 1) + 1; ++rep_) if (IN(2)) {
            IDS
            const bf16_t* RX = WSP(WS_RX); bf16_t* XR = WSP(WS_XR); const bf16_t* Wc1 = WSP(WS_W + W_C1); float* bias1 = WSF(WS_CTL);
            const float* cw = a.in[3] + l * 4 * 1024; const float* cb = a.in[4] + l * 1024;
            for (int it0 = gt; it0 < MTOK * 128; it0 += 2 * ngt) {
                u32x4 xw[2][4]; int rowv[2], chv[2]; bool ok[2];
#pragma unroll
                for (int e = 0; e < 2; ++e) { const int it = it0 + e * ngt; ok[e] = it < MTOK * 128; const int itc = ok[e] ? it : it0; rowv[e] = itc >> 7; chv[e] = (itc & 127) * 8; const int s = rowv[e] & 4095;
#pragma unroll
                    for (int kk = 0; kk < 4; ++kk) xw[e][kk] = (s - 3 + kk >= 0) ? *(const u32x4*)(RX + (size_t)(rowv[e] - 3 + kk) * 1024 + chv[e]) : (u32x4){0u, 0u, 0u, 0u}; }
#pragma unroll
                for (int e = 0; e < 2; ++e) { const int ch = chv[e];
                    float acc[8];
#pragma unroll
                    for (int i = 0; i < 8; ++i) acc[i] = cb[ch + i];
#pragma unroll
                    for (int kk = 0; kk < 4; ++kk) { const u32x4 w4 = xw[e][kk];
                        const f32x4 c0 = *(const f32x4*)(cw + kk * 1024 + ch), c1 = *(const f32x4*)(cw + kk * 1024 + ch + 4);
                        acc[0] += c0[0] * bf_lo(w4.x); acc[1] += c0[1] * bf_hi(w4.x); acc[2] += c0[2] * bf_lo(w4.y); acc[3] += c0[3] * bf_hi(w4.y);
                        acc[4] += c1[0] * bf_lo(w4.z); acc[5] += c1[1] * bf_hi(w4.z); acc[6] += c1[2] * bf_lo(w4.w); acc[7] += c1[3] * bf_hi(w4.w); }
                    u32x4 o; o.x = pk_bf16(acc[0], acc[1]); o.y = pk_bf16(acc[2], acc[3]); o.z = pk_bf16(acc[4], acc[5]); o.w = pk_bf16(acc[6], acc[7]);
                    if (ok[e]) *(u32x4*)(XR + (size_t)rowv[e] * 1024 + ch) = o; } }
            if (gt < 1024) { const float lm = a.in[9][l * 1024 + gt]; const float e = __expf(-fabsf(lm)); const float lp = e < 0.03f ? e * (1.f - e * (0.5f - e * (0.33333333f - 0.25f * e))) : __logf(1.f + e); bias1[1024 + gt] = -8.f * LOG2E * (fmaxf(-lm, 0.f) + lp); }
            for (int j = gw; j < 512; j += ngw) { const float* pos = (j >> 8 ? a.in[13] : a.in[12]) + l * 2048; const bf16_t* wr_ = Wc1 + (size_t)j * 2048;
                float s = 0.f;
                for (int kk = lane; kk < 2048; kk += 64) s += pos[kk] * __uint_as_float((unsigned)wr_[kk] << 16);
                s = wave_sum(s); if (lane == 0) bias1[j] = s; }
        }
        SEAM(2);
        for (int rep_ = 0; rep_ < ((PROBE_DUP >> 3) & 1) + 1; ++rep_) if (IN(3)) {
            pg8::StaticOrder S; pg8::Gemm g{WSP(WS_XR), WSP(WS_W + W_G), MTOK, 2048, 256, 1024, 2, 0}; S.init(MTOK, 2048, gd_opq(), bx_opq());
            EpiGate E{WSP(WS_XR), WSP(WS_LA), WSP(WS_U), a.in[6] + l * 1024, a.in[8] + l * 1024, WSF(WS_CTL) + 1024}; pg8::gemm_phase<EpiGate>(lds, g, S, E);
        }
        SEAM(3);
        for (int rep_ = 0; rep_ < ((PROBE_DUP >> 4) & 1) + 1; ++rep_) if (IN(4)) {
            IDS
            const bf16_t* LA = WSP(WS_LA); const bf16_t* U = WSP(WS_U); float* AGA = WSF(WS_AGG); float* AGH = AGA + 8 * 64 * 1024;
            for (int it = gt; it < 8 * 64 * 256; it += ngt) { const int cq = it & 255, bc = it >> 8; const int ch = 4 * cq; const size_t row0 = (size_t)bc * 64;
                float s[4] = {0.f, 0.f, 0.f, 0.f}, h[4] = {0.f, 0.f, 0.f, 0.f};
#pragma unroll 8
                for (int t = 0; t < 64; ++t) { const u32x2 wl = *(const u32x2*)(LA + (row0 + t) * 1024 + ch), wu = *(const u32x2*)(U + (row0 + t) * 1024 + ch);
                    const float l0 = bf_lo(wl.x), l1 = bf_hi(wl.x), l2 = bf_lo(wl.y), l3 = bf_hi(wl.y); s[0] += l0; s[1] += l1; s[2] += l2; s[3] += l3;
                    h[0] = ex2(l0) * h[0] + bf_lo(wu.x); h[1] = ex2(l1) * h[1] + bf_hi(wu.x); h[2] = ex2(l2) * h[2] + bf_lo(wu.y); h[3] = ex2(l3) * h[3] + bf_hi(wu.y); }
                *(f32x4*)(AGA + (size_t)bc * 1024 + ch) = (f32x4){ex2(s[0]), ex2(s[1]), ex2(s[2]), ex2(s[3])}; *(f32x4*)(AGH + (size_t)bc * 1024 + ch) = (f32x4){h[0], h[1], h[2], h[3]}; }
        }
        SEAM(4);
        if (IN(5)) {
            IDS
            const bf16_t* LA = WSP(WS_LA); const bf16_t* U = WSP(WS_U); bf16_t* YO = WSP(WS_YO); const float* AGA = WSF(WS_AGG); const float* AGH = AGA + 8 * 64 * 1024;
            for (int it = gt; it < 8 * 64 * 256; it += ngt) { const int cq = it & 255, bc = it >> 8; const int ch = 4 * cq; const size_t row0 = (size_t)bc * 64; const int c = bc & 63, b0 = bc - c;
                f32x4 h = (f32x4){0.f, 0.f, 0.f, 0.f};
                {   int cc = 0;
                    for (; cc + 8 <= c; cc += 8) { f32x4 A[8], Hh[8];
#pragma unroll
                        for (int k = 0; k < 8; ++k) { A[k] = *(const f32x4*)(AGA + (size_t)(b0 + cc + k) * 1024 + ch); Hh[k] = *(const f32x4*)(AGH + (size_t)(b0 + cc + k) * 1024 + ch); }
#pragma unroll
                        for (int k = 0; k < 8; ++k) h = A[k] * h + Hh[k]; }
                    for (; cc < c; ++cc) { const f32x4 A = *(const f32x4*)(AGA + (size_t)(b0 + cc) * 1024 + ch), Hh = *(const f32x4*)(AGH + (size_t)(b0 + cc) * 1024 + ch); h = A * h + Hh; } }
                for (int t0 = 0; t0 < 64; t0 += 8) { u32x2 wl[8], wu[8], gy[8];
#pragma unroll
                    for (int k = 0; k < 8; ++k) { wl[k] = *(const u32x2*)(LA + (row0 + t0 + k) * 1024 + ch); wu[k] = *(const u32x2*)(U + (row0 + t0 + k) * 1024 + ch); gy[k] = *(const u32x2*)(YO + (row0 + t0 + k) * 2048 + ch); }
#pragma unroll
                    for (int k = 0; k < 8; ++k) { h[0] = ex2(bf_lo(wl[k].x)) * h[0] + bf_lo(wu[k].x); h[1] = ex2(bf_hi(wl[k].x)) * h[1] + bf_hi(wu[k].x); h[2] = ex2(bf_lo(wl[k].y)) * h[2] + bf_lo(wu[k].y); h[3] = ex2(bf_hi(wl[k].y)) * h[3] + bf_hi(wu[k].y);
                        u32x2 o; o.x = pk_bf16(h[0] * bf_lo(gy[k].x), h[1] * bf_hi(gy[k].x)); o.y = pk_bf16(h[2] * bf_lo(gy[k].y), h[3] * bf_hi(gy[k].y)); gy[k] = o; }
#pragma unroll
                    for (int k = 0; k < 8; ++k) *(u32x2*)(YO + (row0 + t0 + k) * 2048 + ch) = gy[k]; }
            }
        }
        SEAM(5);
        for (int rep_ = 0; rep_ < ((PROBE_DUP >> 6) & 1) + 1; ++rep_) if (IN(6)) {
            pg8::StaticOrder S; pg8::Gemm g{WSP(WS_H), WSP(WS_W + W_INB), MTOK, 4864, 1024, 1024, 0, 0}; S.init(MTOK, 4864, gd_opq(), bx_opq());
            EpiInB E{WSP(WS_YO), WSP(WS_RX), WSP(WS_LA), WSF(WS_NG), a.in[10] + l * 64, a.in[11] + l * 192}; pg8::gemm_phase<EpiInB>(lds, g, S, E);
        }
        SEAM(6);
        for (int rep_ = 0; rep_ < ((PROBE_DUP >> 7) & 1) + 1; ++rep_) if (IN(7)) {
            pg8::StaticOrder S; pg8::Gemm g{WSP(WS_RX), WSP(WS_W + W_C1), 16384, 256, 2048, 1024, 0, 32}; S.init(16384, 256, gd_opq(), bx_opq());
            EpiCmp1 E{WSP(WS_HID), WSF(WS_CTL)}; pg8::gemm_phase<EpiCmp1>(lds, g, S, E);
        }
        SEAM(7);
        for (int rep_ = 0; rep_ < ((PROBE_DUP >> 8) & 1) + 1; ++rep_) if (IN(8)) {
            IDS
            const bf16_t* HID = WSP(WS_HID); bf16_t* KC = WSP(WS_KC); bf16_t* VC = WSP(WS_VC);
            const float* kn0 = a.in[11] + l * 192;
            LAS float* w2s = (LAS float*)lds;
            for (int i = tid; i < 2 * 4096; i += 512) { const f32x4 v = (i < 4096) ? ((const f32x4*)(a.in[15] + (size_t)l * 16384))[i] : ((const f32x4*)(a.in[17] + (size_t)l * 16384))[i - 4096]; *(LAS f32x4*)(w2s + 4 * i) = v; }
            __syncthreads();
            for (int r0 = gw * 4; r0 < 16384; r0 += ngw * 4) {
                const int which = r0 >> 13;
                const LAS float* wq = w2s + which * 16384 + lane;
                const unsigned* hp = (const unsigned*)(HID + (size_t)r0 * 256);
                float acc0 = 0.f, acc1 = 0.f, acc2 = 0.f, acc3 = 0.f;
#pragma unroll 4
                for (int h2 = 0; h2 < 128; ++h2) {
                    const float w0 = wq[(2 * h2) * 64], w1 = wq[(2 * h2 + 1) * 64];
                    const unsigned x0 = hp[h2], x1 = hp[128 + h2], x2 = hp[256 + h2], x3 = hp[384 + h2];
                    acc0 += bf_lo(x0) * w0 + bf_hi(x0) * w1; acc1 += bf_lo(x1) * w0 + bf_hi(x1) * w1;
                    acc2 += bf_lo(x2) * w0 + bf_hi(x2) * w1; acc3 += bf_lo(x3) * w0 + bf_hi(x3) * w1; }
                float accv[4] = {acc0, acc1, acc2, acc3};
#pragma unroll
                for (int e = 0; e < 4; ++e) { const int r = r0 + e, rr = r & 8191, c = rr & 255, bgi = rr >> 8;
                    bf16_t* dst = (which ? VC : KC) + ((size_t)bgi * 256 + c) * 64;
                    float v = accv[e];
                    if (!which) { const float ss = wave_sum(v * v); v *= rsqrtf(ss * (1.f / 64.f) + EPS) * kn0[lane]; }
                    if (c == 255) v = 0.f;
                    dst[lane] = (bf16_t)(pk_bf16(v, 0.f) & 0xffffu); }
            }
            __syncthreads();
        }
        SEAM(8);
        if (IN(9)) {
            if (PROBE_DUP & (1 << 9)) att::attn_phase(lds, WSP(WS_RX), WSP(WS_KC), WSP(WS_VC), WSP(WS_YO), WSP(WS_H), 1024, WSF(WS_NG), a.in[10] + l * 64, a.in[11] + l * 192);
            att::attn_phase(lds, WSP(WS_RX), WSP(WS_KC), WSP(WS_VC), WSP(WS_YO), WSP(WS_YO) + 1024, 2048, WSF(WS_NG), a.in[10] + l * 64, a.in[11] + l * 192);
        }
        SEAM(9);
        if (IN(10)) {
            pg8::StaticOrder S; pg8::Gemm g{WSP(WS_YO), WSP(WS_W + W_YA), MTOK, 1024, 2048, 2048, 0, 0}; S.init(MTOK, 1024, gd_opq(), bx_opq());
            EpiMixM E{WSP(WS_H), WSP(WS_LA)}; pg8::gemm_phase<EpiMixM>(lds, g, S, E);
        }
        SEAM(10);
        if (IN(12)) {
            pg8::StaticOrder S; pg8::Gemm g{WSP(WS_H), WSP(WS_W + W_O), MTOK, 1024, 1024, 1024, 0, 0}; S.init(MTOK, 1024, gd_opq(), bx_opq());
            EpiRes E{(l == 0) ? a.in[0] : a.out, a.out}; pg8::gemm_phase<EpiRes>(lds, g, S, E);
        }
        SEAM(12);
        for (int rep_ = 0; rep_ < ((PROBE_DUP >> 13) & 1) + 1; ++rep_) if (IN(13)) {
            IDS
            rms_phase(a.out, a.in[21] + l * 1024, WSP(WS_H), gw, ngw, lane);
        }
        SEAM(13);
        for (int rep_ = 0; rep_ < ((PROBE_DUP >> 14) & 1) + 1; ++rep_) if (IN(14)) {
            pg8::StaticOrder S; pg8::Gemm g{WSP(WS_H), WSP(WS_W + W_GU), MTOK, 5632, 1024, 1024, 0, 0}; S.init(MTOK, 5632, gd_opq(), bx_opq());
            EpiSwi E{WSP(WS_RX)}; pg8::gemm_phase<EpiSwi>(lds, g, S, E);
        }
        SEAM(14);
        if (IN(15)) {
            pg8::StaticOrder S; pg8::Gemm g{WSP(WS_RX), WSP(WS_W + W_D), MTOK, 1024, D_FF, D_FF, 0, 0}; S.init(MTOK, 1024, gd_opq(), bx_opq());
            EpiRes E{a.out, a.out}; pg8::gemm_phase<EpiRes>(lds, g, S, E);
        }
        SEAM(15);
    }
#undef IDS
#undef IN
#undef SEAM
}

extern "C" void kernel_launch(void* const* d_in, const int* in_sizes, int n_in, void* d_out, int out_size, void* d_ws, size_t ws_size, hipStream_t stream) {
    static int grid = 0;
    if (grid == 0) {
        if (n_in != 25 || out_size != MTOK * DM || ws_size < WS_END) { fprintf(stderr, "kernel_launch: unexpected problem (n_in %d, out %d, ws %zu)\n", n_in, out_size, ws_size); grid = -1; return; }
        int dev = 0, cus = 0, per_cu = 0;
        hipGetDevice(&dev); hipDeviceGetAttribute(&cus, hipDeviceAttributeMultiprocessorCount, dev);
        hipFuncSetAttribute((const void*)mega, hipFuncAttributeMaxDynamicSharedMemorySize, LDS_BYTES);
        if (hipOccupancyMaxActiveBlocksPerMultiprocessor(&per_cu, (const void*)mega, 512, LDS_BYTES) != hipSuccess || per_cu < 1) per_cu = 1;
        (void)hipGetLastError();
        grid = cus * per_cu;
        if (grid <= 0) grid = 256;
    }
    if (grid < 0) return;
    Args a{};
    for (int i = 0; i < 25; ++i) a.in[i] = (const float*)d_in[i];
    a.out = (float*)d_out; a.ws = (unsigned char*)d_ws;
#if MK_MULTI
    for (int p = 0; p < DEPTH * NPH; ++p) { a.ph_lo = p; a.ph_hi = p + 1; hipLaunchKernelGGL(mega, dim3(grid), dim3(512), LDS_BYTES, stream, a); }
#else
    a.ph_lo = 0; a.ph_hi = DEPTH * NPH;
    (void)hipMemsetAsync((char*)d_ws + WS_BAR, 0, 16384, stream);
    void* args[] = {&a};
    hipError_t e = hipLaunchCooperativeKernel((const void*)mega, dim3(grid), dim3(512), args, LDS_BYTES, stream);
    if (e != hipSuccess) fprintf(stderr, "cooperative launch failed: %s (grid %d)\n", hipGetErrorString(e), grid);
#endif
}
```

```cpp
#include <hip/hip_runtime.h>
#include <hip/hip_cooperative_groups.h>
#include <cstdio>
#include <cstdint>
namespace cg = cooperative_groups;

#ifndef PROBE_SYNC2
#define PROBE_SYNC2 0
#endif
#ifndef PROBE_DUP
#define PROBE_DUP 0
#endif
#ifndef MK_MULTI
#define MK_MULTI 0
#endif

#define LAS __attribute__((address_space(3)))
typedef unsigned short bf16_t;
typedef short bf16x8 __attribute__((ext_vector_type(8)));
typedef short s16x4 __attribute__((ext_vector_type(4)));
typedef float f32x2 __attribute__((ext_vector_type(2)));
typedef float f32x4 __attribute__((ext_vector_type(4)));
typedef float f32x16 __attribute__((ext_vector_type(16)));
typedef unsigned u32x2 __attribute__((ext_vector_type(2)));
typedef unsigned u32x4 __attribute__((ext_vector_type(4)));
typedef __bf16 bf16x2_t __attribute__((ext_vector_type(2)));

constexpr int DM = 1024, NB = 8, SEQ = 4096, MTOK = NB * SEQ, DEPTH = 2;
constexpr int D_IN = 6704, D_FF = 2816;
constexpr float EPS = 1e-6f;
constexpr float LOG2E = 1.4426950408889634f;
constexpr float QSCALE = 0.125f * LOG2E;

constexpr size_t MiB = 1u << 20;
constexpr size_t WS_CTL = 0;
constexpr size_t WS_BAR = 65536;
constexpr size_t WS_W = 1 * MiB;
constexpr size_t W_INA = 0, W_INB = 4 * MiB, W_G = 14 * MiB, W_C1 = 15 * MiB, W_YA = 17 * MiB, W_YB = 19 * MiB, W_O = 21 * MiB, W_GU = 23 * MiB, W_D = 34 * MiB;
constexpr size_t WS_H = 41 * MiB;
constexpr size_t WS_RX = 105 * MiB;
constexpr size_t WS_XR = 169 * MiB;
constexpr size_t WS_LA = 233 * MiB;
constexpr size_t WS_U = 297 * MiB;
constexpr size_t WS_YO = 361 * MiB;
constexpr size_t WS_NG = 489 * MiB;
constexpr size_t WS_HID = 497 * MiB;
constexpr size_t WS_KC = 505 * MiB;
constexpr size_t WS_VC = 506 * MiB;
constexpr size_t WS_AGG = 507 * MiB;
constexpr size_t WS_END = 511 * MiB;
constexpr size_t KVBUF = (size_t)32 * 4096 * 64;

__device__ __forceinline__ int bx_opq() { int t = blockIdx.x; asm volatile("" : "+s"(t)); return t; }
__device__ __forceinline__ int gd_opq() { int t = gridDim.x; asm volatile("" : "+s"(t)); return t; }
__device__ __forceinline__ int tid_opq() { int t = threadIdx.x; asm volatile("" : "+v"(t)); return t; }
__device__ __forceinline__ unsigned pk_bf16(float lo, float hi) { f32x2 v = {lo, hi}; bf16x2_t b = __builtin_convertvector(v, bf16x2_t); return __builtin_bit_cast(unsigned, b); }
__device__ __forceinline__ float bf_lo(unsigned w) { return __uint_as_float(w << 16); }
__device__ __forceinline__ float bf_hi(unsigned w) { return __uint_as_float(w & 0xffff0000u); }
__device__ __forceinline__ float ex2(float x) { return __builtin_amdgcn_exp2f(x); }
__device__ __forceinline__ float sigm(float x) { return __builtin_amdgcn_rcpf(1.f + ex2(-LOG2E * x)); }
__device__ __forceinline__ float gelu_t(float x) { const float y = 1.5957691216057308f * (x + 0.044715f * x * x * x); return x * sigm(y); }
__device__ __forceinline__ float wave_sum(float v) {
#pragma unroll
    for (int o = 1; o < 64; o <<= 1) v += __shfl_xor(v, o);
    return v;
}
__device__ __forceinline__ float wave_max(float v) {
#pragma unroll
    for (int o = 1; o < 64; o <<= 1) v = fmaxf(v, __shfl_xor(v, o));
    return v;
}
__device__ __forceinline__ u32x4 pack8(const f32x4 a, const f32x4 b) { u32x4 w; w.x = pk_bf16(a[0], a[1]); w.y = pk_bf16(a[2], a[3]); w.z = pk_bf16(b[0], b[1]); w.w = pk_bf16(b[2], b[3]); return w; }

namespace pg8 {
constexpr int BM = 256, BK = 64, HALF = 128, HTB = HALF * BK * 2, STAGE_BYTES = 8 * HTB, NXCD = 8, WGM = 8;
__host__ __device__ __forceinline__ int lds_byte(int r, int c) { const int st = (r >> 4) * 2 + (c >> 5), rr = r & 15, cc = c & 31, ob = rr * 64 + cc * 2; return st * 1024 + (ob ^ (((ob >> 9) & 1) << 5)); }
__host__ __device__ __forceinline__ void stage_rc(int b, int& R, int& C) { const int st = b / 1024, sb = b % 1024, swz = sb ^ (((sb >> 9) & 1) << 5); R = (st >> 1) * 16 + swz / 64; C = (st & 1) * 32 + (swz % 64) / 2; }
__host__ __device__ __forceinline__ int perm32(int rho) { const int n = rho >> 4, i = rho & 15; return 8 * (i >> 2) + 4 * n + (i & 3); }

struct Unit { int pm, pn; };
struct Gemm { const bf16_t* A; const bf16_t* Bt; int M, N, K, lda, a_div, b_div; };

struct StaticOrder {
    int nM, nN, nwg, G, c;
    __device__ void init(int M, int N, int G_, int c_) { nM = M / BM; nN = N / BM; nwg = nM * nN; G = G_; c = c_; }
    __device__ bool next(int i, Unit& u) const {
        const long L = (long)i * G + c; if (L >= nwg) return false;
        int wgid = (int)L; { const int q = nwg / NXCD, r = nwg % NXCD, xcd = wgid % NXCD, off = wgid / NXCD; wgid = (xcd < r ? xcd * (q + 1) : r * (q + 1) + (xcd - r) * q) + off; }
        const int nig = WGM * nN, gid = wgid / nig, fm = gid * WGM, gsz = (nM - fm) < WGM ? (nM - fm) : WGM;
        u.pm = fm + ((wgid % nig) % gsz); u.pn = (wgid % nig) / gsz; return true;
    }
};
__device__ __forceinline__ const char* unitA(const Gemm& g, const Unit& u, size_t tstepA) { return (const char*)g.A + (size_t)u.pm * tstepA + (g.a_div ? (size_t)(u.pn / g.a_div) * (size_t)g.K * 2 : (size_t)0); }
__device__ __forceinline__ const char* unitB(const Gemm& g, const Unit& u, size_t tstepB) { return (const char*)g.Bt + (size_t)(u.pn + (g.b_div ? (u.pm / g.b_div) * (g.N / BM) : 0)) * tstepB; }

template <class Epi>
__device__ __forceinline__ void gemm_phase(LAS unsigned char* lds, const Gemm g, const StaticOrder& S, const Epi& E) {
    const int tid = tid_opq(), wid = __builtin_amdgcn_readfirstlane(tid >> 6), lane = tid & 63, wr = wid >> 2, wc = wid & 3, fr = lane & 15, fq = lane >> 4;
    const int K = g.K, nt = K / BK;
    unsigned voffA[2], voffB[2];
#pragma unroll
    for (int i = 0; i < 2; ++i) { int R, C; stage_rc(tid * 16 + i * 8192, R, C); const int Rb = Epi::PERM ? ((R & ~31) + perm32(R & 31)) : R;
        voffA[i] = (unsigned)(R * g.lda + C) * 2u; voffB[i] = (unsigned)(Rb * K + C) * 2u; }
    const size_t kstep = (size_t)(BK * 2);
    const size_t hstepA = (size_t)HALF * g.lda * 2, hstepB = (size_t)HALF * K * 2;
    const size_t tstepA = 2 * hstepA, tstepB = 2 * hstepB;
    const unsigned ldsw = (unsigned)wid * 1024u;
    const int aoff = lds_byte(wr * 64 + fr, fq * 8), boff = lds_byte(wc * 32 + fr, fq * 8);
#define PG8_SA(b, h) (((b) * 2 + (h)) * HTB)
#define PG8_SB(b, h) ((4 + (b) * 2 + (h)) * HTB)
#define PG8_STAGE(bufoff, gbase, voff) do { _Pragma("unroll") for (int _i = 0; _i < 2; ++_i) \
        __builtin_amdgcn_global_load_lds((const unsigned*)((const char*)(gbase) + (voff)[_i]), (LAS unsigned*)(lds + (bufoff) + ldsw + _i * 8192), 16, 0, 0); } while (0)
#define PG8_LDA(dst, b, h) do { _Pragma("unroll") for (int m = 0; m < 4; ++m) _Pragma("unroll") for (int k = 0; k < 2; ++k) dst[m][k] = *(const LAS bf16x8*)(lds + PG8_SA(b, h) + aoff + m * 2048 + k * 1024); } while (0)
#define PG8_LDB(dst, b, h) do { _Pragma("unroll") for (int n = 0; n < 2; ++n) _Pragma("unroll") for (int k = 0; k < 2; ++k) dst[n][k] = *(const LAS bf16x8*)(lds + PG8_SB(b, h) + boff + n * 2048 + k * 1024); } while (0)
#define PG8_MMA(ai, bj, At, Bt) do { __builtin_amdgcn_s_setprio(1); _Pragma("unroll") for (int m = 0; m < 4; ++m) _Pragma("unroll") for (int n = 0; n < 2; ++n) _Pragma("unroll") for (int k = 0; k < 2; ++k) \
        acc[ai][bj][m][n] = __builtin_amdgcn_mfma_f32_16x16x32_bf16(Bt[n][k], At[m][k], acc[ai][bj][m][n], 0, 0, 0); __builtin_amdgcn_s_setprio(0); } while (0)
#define PG8_WAIT_V(n) asm volatile("s_waitcnt vmcnt(" #n ")" ::: "memory")
#define PG8_WAIT_L(n) asm volatile("s_waitcnt lgkmcnt(" #n ")" ::: "memory")
#define PG8_BAR __builtin_amdgcn_s_barrier()
#define PG8_SCHED __builtin_amdgcn_sched_barrier(0)
    Unit cur, nxt; int ui = 0;
    if (!S.next(0, cur)) return;
    f32x4 acc[2][2][4][2];
#pragma unroll
    for (int a = 0; a < 2; ++a)
#pragma unroll
        for (int b = 0; b < 2; ++b)
#pragma unroll
            for (int m = 0; m < 4; ++m)
#pragma unroll
                for (int n = 0; n < 2; ++n) acc[a][b][m][n] = (f32x4){0.f, 0.f, 0.f, 0.f};
    bf16x8 At[4][2], B0[2][2], B1[2][2];
    const char* cA = unitA(g, cur, tstepA); const char* cB = unitB(g, cur, tstepB);
    PG8_STAGE(PG8_SB(0, 0), cB, voffB); PG8_STAGE(PG8_SB(0, 1), cB + hstepB, voffB); PG8_STAGE(PG8_SA(0, 0), cA, voffA); PG8_STAGE(PG8_SA(0, 1), cA + hstepA, voffA);
    if (wr == 1) PG8_BAR;
    PG8_WAIT_V(2); PG8_BAR;
    PG8_STAGE(PG8_SB(1, 0), cB + kstep, voffB); PG8_STAGE(PG8_SA(1, 0), cA + kstep, voffA); PG8_STAGE(PG8_SB(1, 1), cB + hstepB + kstep, voffB);
    PG8_WAIT_V(6); PG8_BAR;
    for (;;) {
        const bool has_next = S.next(ui + 1, nxt);
        const char* nA = has_next ? unitA(g, nxt, tstepA) : cA; const char* nB = has_next ? unitB(g, nxt, tstepB) : cB;
#pragma unroll 1
        for (int t = 0; t < nt; t += 2) {
            const bool last = (t == nt - 2);
            const char* a1 = cA + (size_t)(t + 1) * kstep;
            const char* a2 = last ? nA : cA + (size_t)(t + 2) * kstep; const char* b2 = last ? nB : cB + (size_t)(t + 2) * kstep;
            const char* a3 = a2 + kstep; const char* b3 = b2 + kstep;
            if constexpr (Epi::MID) { if (t == nt / 2) E.mid(acc, cur, wr, wc, fr, fq); }
            PG8_LDB(B0, 0, 0); PG8_LDB(B1, 0, 1); PG8_SCHED; PG8_LDA(At, 0, 0); PG8_STAGE(PG8_SA(1, 1), a1 + hstepA, voffA);
            PG8_WAIT_V(8); PG8_WAIT_L(0); PG8_BAR; PG8_MMA(0, 0, At, B0); PG8_MMA(0, 1, At, B1); PG8_BAR; PG8_SCHED;
            PG8_LDA(At, 0, 1); PG8_STAGE(PG8_SB(0, 0), b2, voffB); PG8_STAGE(PG8_SB(0, 1), b2 + hstepB, voffB); PG8_STAGE(PG8_SA(0, 0), a2, voffA);
            PG8_WAIT_V(8); PG8_WAIT_L(0); PG8_BAR; PG8_MMA(1, 0, At, B0); PG8_MMA(1, 1, At, B1); PG8_BAR; PG8_SCHED;
            PG8_LDB(B0, 1, 0); PG8_LDB(B1, 1, 1); PG8_SCHED; PG8_LDA(At, 1, 0); PG8_STAGE(PG8_SA(0, 1), a2 + hstepA, voffA);
            PG8_WAIT_V(8); PG8_WAIT_L(0); PG8_BAR; PG8_MMA(0, 0, At, B0); PG8_MMA(0, 1, At, B1); PG8_BAR; PG8_SCHED;
            PG8_LDA(At, 1, 1); PG8_STAGE(PG8_SB(1, 0), b3, voffB); PG8_STAGE(PG8_SB(1, 1), b3 + hstepB, voffB); PG8_STAGE(PG8_SA(1, 0), a3, voffA);
            PG8_WAIT_V(8); PG8_WAIT_L(0); PG8_BAR; PG8_MMA(1, 0, At, B0); PG8_MMA(1, 1, At, B1); PG8_BAR; PG8_SCHED;
        }
        if (wr == 0) PG8_BAR;
        E(acc, cur, wr, wc, fr, fq);
        if (!has_next) break;
#pragma unroll
        for (int a = 0; a < 2; ++a)
#pragma unroll
            for (int b = 0; b < 2; ++b)
#pragma unroll
                for (int m = 0; m < 4; ++m)
#pragma unroll
                    for (int n = 0; n < 2; ++n) acc[a][b][m][n] = (f32x4){0.f, 0.f, 0.f, 0.f};
        cur = nxt; cA = nA; cB = nB; ++ui;
        if (wr == 1) PG8_BAR;
    }
    PG8_WAIT_V(0);
    PG8_BAR;
#undef PG8_SA
#undef PG8_SB
#undef PG8_STAGE
#undef PG8_LDA
#undef PG8_LDB
#undef PG8_MMA
#undef PG8_WAIT_V
#undef PG8_WAIT_L
#undef PG8_BAR
#undef PG8_SCHED
}
}
using pg8::Unit;
typedef const f32x4 (&AccRef)[2][2][4][2];

struct EpiInA {
    static constexpr bool PERM = true, MID = false;
    bf16_t* RX; bf16_t* YO;
    __device__ __forceinline__ void operator()(AccRef acc, const Unit& u, int wr, int wc, int fr, int fq) const {
        const bool isy = u.pn >= 4; bf16_t* base = isy ? YO : RX; const int ldc = isy ? 2048 : 1024;
        const int row0 = u.pm * 256 + wr * 64 + fr, col0 = (u.pn & 3) * 256 + wc * 32 + 8 * fq;
#pragma unroll
        for (int ai = 0; ai < 2; ++ai)
#pragma unroll
            for (int m = 0; m < 4; ++m) { bf16_t* rowp = base + (size_t)(row0 + ai * 128 + m * 16) * ldc + col0;
#pragma unroll
                for (int bj = 0; bj < 2; ++bj) { f32x4 v0 = acc[ai][bj][m][0], v1 = acc[ai][bj][m][1];
                    if (isy) {
#pragma unroll
                        for (int i = 0; i < 4; ++i) { v0[i] = gelu_t(v0[i]); v1[i] = gelu_t(v1[i]); } }
                    *(u32x4*)(rowp + bj * 128) = pack8(v0, v1); } }
    }
};
struct EpiInB {
    static constexpr bool PERM = true, MID = false;
    bf16_t* YO; bf16_t* KVB; bf16_t* MG; float* NG; const float* qn; const float* kn;
    __device__ __forceinline__ void operator()(AccRef acc, const Unit& u, int wr, int wc, int fr, int fq) const {
        const int t = u.pn; const int row0 = u.pm * 256 + wr * 64 + fr;
        if (t < 10) {
            const bool isq = t < 4; const bool nrm = isq || t == 6 || t == 8;
            const float* gw = isq ? qn : (kn + (t == 6 ? 64 : 128));
            const float osc = isq ? QSCALE : 1.f;
            f32x4 gvv[2][2];
#pragma unroll
            for (int bj = 0; bj < 2; ++bj)
#pragma unroll
                for (int n = 0; n < 2; ++n) gvv[bj][n] = nrm ? *(const f32x4*)(gw + 32 * bj + 8 * fq + 4 * n) : (f32x4){1.f, 1.f, 1.f, 1.f};
#pragma unroll
            for (int ai = 0; ai < 2; ++ai)
#pragma unroll
                for (int m = 0; m < 4; ++m) {
                    const int row = row0 + ai * 128 + m * 16;
                    float rinv = 1.f;
                    if (nrm) { float ss = 0.f;
#pragma unroll
                        for (int bj = 0; bj < 2; ++bj)
#pragma unroll
                            for (int n = 0; n < 2; ++n) { const f32x4 x = acc[ai][bj][m][n]; ss += (x[0] * x[0] + x[1] * x[1]) + (x[2] * x[2] + x[3] * x[3]); }
                        ss += __shfl_xor(ss, 16); ss += __shfl_xor(ss, 32);
                        rinv = rsqrtf(ss * (1.f / 64.f) + EPS) * osc; }
                    bf16_t* dst;
                    if (isq) dst = YO + (size_t)row * 2048 + 1024 + (t * 4 + wc) * 64 + 8 * fq;
                    else { const int b = row >> 12, s = row & 4095; dst = KVB + (size_t)(t - 4) * KVBUF + ((size_t)(b * 4 + wc) * 4096 + s) * 64 + 8 * fq; }
#pragma unroll
                    for (int bj = 0; bj < 2; ++bj) { const f32x4 g0 = gvv[bj][0], g1 = gvv[bj][1];
                        const f32x4 v0 = acc[ai][bj][m][0] * rinv * g0, v1 = acc[ai][bj][m][1] * rinv * g1;
                        *(u32x4*)(dst + 32 * bj) = pack8(v0, v1); }
                }
        } else if (t < 18) {
#pragma unroll
            for (int ai = 0; ai < 2; ++ai)
#pragma unroll
                for (int m = 0; m < 4; ++m) { bf16_t* dst = MG + (size_t)(row0 + ai * 128 + m * 16) * 2048 + (t - 10) * 256 + 64 * wc + 8 * fq;
#pragma unroll
                    for (int bj = 0; bj < 2; ++bj) { f32x4 v0 = acc[ai][bj][m][0], v1 = acc[ai][bj][m][1];
#pragma unroll
                        for (int i = 0; i < 4; ++i) { v0[i] = sigm(v0[i]); v1[i] = sigm(v1[i]); }
                        *(u32x4*)(dst + 32 * bj) = pack8(v0, v1); } }
        } else if (wc == 0) {
#pragma unroll
            for (int ai = 0; ai < 2; ++ai)
#pragma unroll
                for (int m = 0; m < 4; ++m) { float* dst = NG + (size_t)(row0 + ai * 128 + m * 16) * 64 + 8 * fq;
#pragma unroll
                    for (int bj = 0; bj < 2; ++bj)
#pragma unroll
                        for (int n = 0; n < 2; ++n) { f32x4 v = acc[ai][bj][m][n];
#pragma unroll
                            for (int i = 0; i < 4; ++i) v[i] = sigm(v[i]);
                            *(f32x4*)(dst + 32 * bj + 4 * n) = v; } }
        }
    }
};
struct EpiGate {
    static constexpr bool PERM = true, MID = false;
    const bf16_t* XR; bf16_t* LA; bf16_t* U; const float* ba; const float* bi; const float* lam;
    __device__ __forceinline__ void operator()(AccRef acc, const Unit& u, int wr, int wc, int fr, int fq) const {
        const int row0 = u.pm * 256 + wr * 64 + fr;
#pragma unroll
        for (int n = 0; n < 2; ++n) {
            const int ch0 = u.pn * 128 + wc * 32 + 8 * fq + 4 * n;
            const f32x4 bav = *(const f32x4*)(ba + ch0), biv = *(const f32x4*)(bi + ch0), spv = *(const f32x4*)(lam + ch0);
#pragma unroll
            for (int ai = 0; ai < 2; ++ai) {
                u32x2 xwv[4];
#pragma unroll
                for (int m = 0; m < 4; ++m) xwv[m] = *(const u32x2*)(XR + (size_t)(row0 + ai * 128 + m * 16) * 1024 + ch0);
#pragma unroll
                for (int m = 0; m < 4; ++m) { const int row = row0 + ai * 128 + m * 16; const bool first = (row & 4095) == 0;
                    const u32x2 xw = xwv[m];
                    const float xv[4] = {bf_lo(xw.x), bf_hi(xw.x), bf_lo(xw.y), bf_hi(xw.y)};
                    float la[4], uu[4];
#pragma unroll
                    for (int i = 0; i < 4; ++i) { const float rp = acc[ai][0][m][n][i] + bav[i], ip = acc[ai][1][m][n][i] + biv[i];
                        const float l2 = sigm(rp) * spv[i];
                        const float a2 = ex2(2.f * l2); float mult = __builtin_amdgcn_sqrtf(fmaxf(1.f - a2, 0.f)); if (first) mult = 1.f;
                        la[i] = l2; uu[i] = mult * sigm(ip) * xv[i]; }
                    u32x2 w0, w1; w0.x = pk_bf16(la[0], la[1]); w0.y = pk_bf16(la[2], la[3]); w1.x = pk_bf16(uu[0], uu[1]); w1.y = pk_bf16(uu[2], uu[3]);
                    *(u32x2*)(LA + (size_t)row * 1024 + ch0) = w0; *(u32x2*)(U + (size_t)row * 1024 + ch0) = w1; } }
        }
    }
};
struct EpiCmp1 {
    static constexpr bool PERM = true, MID = false;
    bf16_t* HID; const float* bias1;
    __device__ __forceinline__ void operator()(AccRef acc, const Unit& u, int wr, int wc, int fr, int fq) const {
        const int which = u.pm >> 5; const int row0 = u.pm * 256 + wr * 64 + fr;
#pragma unroll
        for (int ai = 0; ai < 2; ++ai)
#pragma unroll
            for (int m = 0; m < 4; ++m) { bf16_t* dst = HID + (size_t)(row0 + ai * 128 + m * 16) * 256 + wc * 32 + 8 * fq;
#pragma unroll
                for (int bj = 0; bj < 2; ++bj) { const float* bp = bias1 + which * 256 + bj * 128 + wc * 32 + 8 * fq;
                    f32x4 v0 = acc[ai][bj][m][0] + *(const f32x4*)bp, v1 = acc[ai][bj][m][1] + *(const f32x4*)(bp + 4);
#pragma unroll
                    for (int i = 0; i < 4; ++i) { v0[i] = gelu_t(v0[i]); v1[i] = gelu_t(v1[i]); }
                    *(u32x4*)(dst + bj * 128) = pack8(v0, v1); } }
    }
};
template <int ADD> struct EpiMix {
    static constexpr bool PERM = true, MID = false;
    bf16_t* MB; const bf16_t* MG; int sel;
    __device__ __forceinline__ void operator()(AccRef acc, const Unit& u, int wr, int wc, int fr, int fq) const {
        const int row0 = u.pm * 256 + wr * 64 + fr, col0 = u.pn * 256 + wc * 32 + 8 * fq;
#pragma unroll
        for (int ai = 0; ai < 2; ++ai)
#pragma unroll
            for (int mp = 0; mp < 2; ++mp) {
                u32x4 gwv[2][2], owv[2][2];
#pragma unroll
                for (int mm = 0; mm < 2; ++mm)
#pragma unroll
                    for (int bj = 0; bj < 2; ++bj) { const int row = row0 + ai * 128 + (2 * mp + mm) * 16, col = col0 + bj * 128;
                        gwv[mm][bj] = *(const u32x4*)(MG + (size_t)row * 2048 + sel * 1024 + col);
                        owv[mm][bj] = ADD ? *(const u32x4*)(MB + (size_t)row * 1024 + col) : (u32x4){0u, 0u, 0u, 0u}; }
#pragma unroll
                for (int mm = 0; mm < 2; ++mm)
#pragma unroll
                    for (int bj = 0; bj < 2; ++bj) { const int row = row0 + ai * 128 + (2 * mp + mm) * 16, col = col0 + bj * 128; const u32x4 gw = gwv[mm][bj], ow = owv[mm][bj];
                        f32x4 v0 = acc[ai][bj][2 * mp + mm][0], v1 = acc[ai][bj][2 * mp + mm][1];
                        v0[0] *= bf_lo(gw.x); v0[1] *= bf_hi(gw.x); v0[2] *= bf_lo(gw.y); v0[3] *= bf_hi(gw.y);
                        v1[0] *= bf_lo(gw.z); v1[1] *= bf_hi(gw.z); v1[2] *= bf_lo(gw.w); v1[3] *= bf_hi(gw.w);
                        if (ADD) { v0[0] += bf_lo(ow.x); v0[1] += bf_hi(ow.x); v0[2] += bf_lo(ow.y); v0[3] += bf_hi(ow.y);
                            v1[0] += bf_lo(ow.z); v1[1] += bf_hi(ow.z); v1[2] += bf_lo(ow.w); v1[3] += bf_hi(ow.w); }
                        *(u32x4*)(MB + (size_t)row * 1024 + col) = pack8(v0, v1); } }
    }
};
struct EpiMixM {
    static constexpr bool PERM = true, MID = true;
    bf16_t* MB; const bf16_t* MG;
    __device__ __forceinline__ void mid(f32x4 (&acc)[2][2][4][2], const Unit& u, int wr, int wc, int fr, int fq) const {
        int row0 = u.pm * 256 + wr * 64 + fr, col0 = u.pn * 256 + wc * 32 + 8 * fq; asm volatile("" : "+v"(row0), "+v"(col0));
#pragma unroll
        for (int ai = 0; ai < 2; ++ai)
#pragma unroll
            for (int m = 0; m < 4; ++m)
#pragma unroll
                for (int bj = 0; bj < 2; ++bj) { const bf16_t* gp = MG + (size_t)(row0 + ai * 128 + m * 16) * 2048 + col0 + bj * 128;
                    const u32x4 g0 = *(const u32x4*)gp, g1 = *(const u32x4*)(gp + 1024);
                    f32x4 r0, r1;
                    r0[0] = bf_lo(g0.x) * __builtin_amdgcn_rcpf(bf_lo(g1.x)); r0[1] = bf_hi(g0.x) * __builtin_amdgcn_rcpf(bf_hi(g1.x)); r0[2] = bf_lo(g0.y) * __builtin_amdgcn_rcpf(bf_lo(g1.y)); r0[3] = bf_hi(g0.y) * __builtin_amdgcn_rcpf(bf_hi(g1.y));
                    r1[0] = bf_lo(g0.z) * __builtin_amdgcn_rcpf(bf_lo(g1.z)); r1[1] = bf_hi(g0.z) * __builtin_amdgcn_rcpf(bf_hi(g1.z)); r1[2] = bf_lo(g0.w) * __builtin_amdgcn_rcpf(bf_lo(g1.w)); r1[3] = bf_hi(g0.w) * __builtin_amdgcn_rcpf(bf_hi(g1.w));
                    acc[ai][bj][m][0] *= r0; acc[ai][bj][m][1] *= r1; }
    }
    __device__ __forceinline__ void operator()(AccRef acc, const Unit& u, int wr, int wc, int fr, int fq) const {
        const int row0 = u.pm * 256 + wr * 64 + fr, col0 = u.pn * 256 + wc * 32 + 8 * fq;
#pragma unroll
        for (int ai = 0; ai < 2; ++ai) {
            u32x4 gwv[4][2];
#pragma unroll
            for (int m = 0; m < 4; ++m)
#pragma unroll
                for (int bj = 0; bj < 2; ++bj) gwv[m][bj] = *(const u32x4*)(MG + (size_t)(row0 + ai * 128 + m * 16) * 2048 + 1024 + col0 + bj * 128);
#pragma unroll
            for (int m = 0; m < 4; ++m)
#pragma unroll
                for (int bj = 0; bj < 2; ++bj) { const int row = row0 + ai * 128 + m * 16, col = col0 + bj * 128; const u32x4 gw = gwv[m][bj];
                    f32x4 v0 = acc[ai][bj][m][0], v1 = acc[ai][bj][m][1];
                    v0[0] *= bf_lo(gw.x); v0[1] *= bf_hi(gw.x); v0[2] *= bf_lo(gw.y); v0[3] *= bf_hi(gw.y);
                    v1[0] *= bf_lo(gw.z); v1[1] *= bf_hi(gw.z); v1[2] *= bf_lo(gw.w); v1[3] *= bf_hi(gw.w);
                    *(u32x4*)(MB + (size_t)row * 1024 + col) = pack8(v0, v1); } }
    }
};
struct EpiRes {
    static constexpr bool PERM = false, MID = false;
    const float* base; float* out;
    __device__ __forceinline__ void operator()(AccRef acc, const Unit& u, int wr, int wc, int fr, int fq) const {
        const int row0 = u.pm * 256 + wr * 64 + fr, col0 = u.pn * 256 + wc * 32 + 4 * fq;
#pragma unroll
        for (int ai = 0; ai < 2; ++ai)
#pragma unroll
            for (int mp = 0; mp < 2; ++mp) {
                f32x4 bs[2][2][2];
#pragma unroll
                for (int mm = 0; mm < 2; ++mm) { const size_t off = (size_t)(row0 + ai * 128 + (2 * mp + mm) * 16) * 1024 + col0;
#pragma unroll
                    for (int bj = 0; bj < 2; ++bj)
#pragma unroll
                        for (int n = 0; n < 2; ++n) bs[mm][bj][n] = *(const f32x4*)(base + off + bj * 128 + n * 16); }
#pragma unroll
                for (int mm = 0; mm < 2; ++mm) { const size_t off = (size_t)(row0 + ai * 128 + (2 * mp + mm) * 16) * 1024 + col0;
#pragma unroll
                    for (int bj = 0; bj < 2; ++bj)
#pragma unroll
                        for (int n = 0; n < 2; ++n) *(f32x4*)(out + off + bj * 128 + n * 16) = bs[mm][bj][n] + acc[ai][bj][2 * mp + mm][n]; } }
    }
};
struct EpiSwi {
    static constexpr bool PERM = true, MID = false;
    bf16_t* ACT;
    __device__ __forceinline__ void operator()(AccRef acc, const Unit& u, int wr, int wc, int fr, int fq) const {
        const int row0 = u.pm * 256 + wr * 64 + fr, ch0 = u.pn * 128 + wc * 32 + 8 * fq;
#pragma unroll
        for (int ai = 0; ai < 2; ++ai)
#pragma unroll
            for (int m = 0; m < 4; ++m) { f32x4 v0, v1;
#pragma unroll
                for (int i = 0; i < 4; ++i) { const float g0 = acc[ai][0][m][0][i], g1 = acc[ai][0][m][1][i];
                    v0[i] = g0 * sigm(g0) * acc[ai][1][m][0][i]; v1[i] = g1 * sigm(g1) * acc[ai][1][m][1][i]; }
                *(u32x4*)(ACT + (size_t)(row0 + ai * 128 + m * 16) * D_FF + ch0) = pack8(v0, v1); }
    }
};

__device__ __forceinline__ void xpose_item(const float* W, int Ns, int col0, int valid, bf16_t* dst, int K, int k0, LAS float* scr, int lane) {
#pragma unroll
    for (int i = 0; i < 32; ++i) { const int kk = 2 * i + (lane >> 5), n = lane & 31; scr[kk * 33 + n] = (n < valid) ? W[(size_t)(k0 + kk) * Ns + col0 + n] : 0.f; }
    asm volatile("s_waitcnt lgkmcnt(0)" ::: "memory");
    const int c = lane & 7;
#pragma unroll
    for (int j = 0; j < 4; ++j) { const int n = (lane >> 3) + 8 * j; const LAS float* s = scr + (8 * c) * 33 + n;
        u32x4 o; o.x = pk_bf16(s[0 * 33], s[1 * 33]); o.y = pk_bf16(s[2 * 33], s[3 * 33]); o.z = pk_bf16(s[4 * 33], s[5 * 33]); o.w = pk_bf16(s[6 * 33], s[7 * 33]);
        *(u32x4*)(dst + (size_t)n * K + k0 + 8 * c) = o; }
    asm volatile("s_waitcnt lgkmcnt(0)" ::: "memory");
}

struct Args { const float* in[25]; float* out; unsigned char* ws; int ph_lo, ph_hi; };
__device__ __forceinline__ unsigned char* opq(unsigned char* p);

__device__ __forceinline__ void weights_phase(const Args& a, int l, LAS unsigned char* lds, int gw, int ngw, int wave, int lane) {
    LAS float* scr = (LAS float*)(lds + wave * 16384);
    bf16_t* Wb = (bf16_t*)(opq(a.ws) + WS_W);
    const float* w_in = a.in[2] + (size_t)l * 1024 * D_IN;
    constexpr int I1 = 16 * 64, I2 = 16 * 152, I3 = 4 * 64, I4 = 32 * 16, I5 = 16 * 32, I6 = 16 * 176, I7 = 44 * 32;
    constexpr int NIT = I1 + I2 + I3 + I4 + 3 * I5 + I6 + I7;
    for (int it = gw; it < NIT; it += ngw) {
        int r = it;
        if (r < I1) { const int kb = r / 64, gi = r % 64; xpose_item(w_in, D_IN, 32 * gi, 32, Wb + W_INA / 2 + (size_t)(32 * gi) * 1024, 1024, 64 * kb, scr, lane); continue; } r -= I1;
        if (r < I2) { const int kb = r / 152, gi = r % 152; const int t = gi >> 3, gl = gi & 7, ca = 64 * (gl & 3) + 32 * (gl >> 2);
            int col0, valid = 32;
            if (t < 10) col0 = 2048 + 256 * t + ca; else if (t < 18) col0 = 4656 + 256 * (t - 10) + ca; else { col0 = 4608 + ca; valid = 48 - ca; valid = valid < 0 ? 0 : (valid > 32 ? 32 : valid); }
            xpose_item(w_in, D_IN, col0, valid, Wb + W_INB / 2 + (size_t)(32 * gi) * 1024, 1024, 64 * kb, scr, lane); continue; } r -= I2;
        if (r < I3) { const int kb = r / 64, gi = r % 64; const int pn = gi >> 3, gl = gi & 7, bj = gl >> 2, ch = 128 * pn + 32 * (gl & 3);
            const float* W = (bj ? a.in[7] : a.in[5]) + (size_t)l * 4 * 65536 + (size_t)(ch >> 8) * 65536;
            xpose_item(W, 256, ch & 255, 32, Wb + W_G / 2 + (size_t)(32 * gi) * 256, 256, 64 * kb, scr, lane); continue; } r -= I3;
        if (r < I4) { const int kb = r / 16, gi = r % 16; const float* W = ((gi >> 3) ? a.in[16] : a.in[14]) + (size_t)l * 2048 * 256;
            xpose_item(W, 256, 32 * (gi & 7), 32, Wb + W_C1 / 2 + (size_t)(32 * gi) * 2048, 2048, 64 * kb, scr, lane); continue; } r -= I4;
        if (r < 3 * I5) { const int which = r / I5; r -= which * I5; const int kb = r / 32, gi = r % 32;
            const float* W = a.in[18 + which] + (size_t)l * 1024 * 1024;
            if (which < 2) xpose_item(W, 1024, 32 * gi, 32, Wb + W_YA / 2 + (size_t)(32 * gi) * 2048 + which * 1024, 2048, 64 * kb, scr, lane);
            else xpose_item(W, 1024, 32 * gi, 32, Wb + W_O / 2 + (size_t)(32 * gi) * 1024, 1024, 64 * kb, scr, lane);
            continue; } r -= 3 * I5;
        if (r < I6) { const int kb = r / 176, gi = r % 176; const int pn = gi >> 3, gl = gi & 7, bj = gl >> 2;
            const float* W = (bj ? a.in[23] : a.in[22]) + (size_t)l * 1024 * D_FF;
            xpose_item(W, D_FF, 128 * pn + 32 * (gl & 3), 32, Wb + W_GU / 2 + (size_t)(32 * gi) * 1024, 1024, 64 * kb, scr, lane); continue; } r -= I6;
        { const int kb = r / 32, gi = r % 32; const float* W = a.in[24] + (size_t)l * D_FF * 1024;
            xpose_item(W, 1024, 32 * gi, 32, Wb + W_D / 2 + (size_t)(32 * gi) * D_FF, D_FF, 64 * kb, scr, lane); }
    }
}

__device__ __forceinline__ void rms_phase(const float* x, const float* g, bf16_t* out, int gw, int ngw, int lane) {
    f32x4 gv[4];
#pragma unroll
    for (int j = 0; j < 4; ++j) gv[j] = ((const f32x4*)g)[lane + 64 * j];
    for (int m0 = gw; m0 < MTOK; m0 += 4 * ngw) {
        f32x4 v[4][4];
#pragma unroll
        for (int e = 0; e < 4; ++e) { const int m = m0 + e * ngw; const f32x4* xr = (const f32x4*)(x + (size_t)(m < MTOK ? m : m0) * 1024) + lane;
#pragma unroll
            for (int j = 0; j < 4; ++j) v[e][j] = xr[64 * j]; }
#pragma unroll
        for (int e = 0; e < 4; ++e) { const int m = m0 + e * ngw; float s = 0.f;
#pragma unroll
            for (int j = 0; j < 4; ++j) s += (v[e][j][0] * v[e][j][0] + v[e][j][1] * v[e][j][1]) + (v[e][j][2] * v[e][j][2] + v[e][j][3] * v[e][j][3]);
            const float rinv = rsqrtf(wave_sum(s) * (1.f / 1024.f) + EPS);
            if (m < MTOK) { u32x2* o8 = (u32x2*)(out + (size_t)m * 1024) + lane;
#pragma unroll
                for (int j = 0; j < 4; ++j) { u32x2 w; w.x = pk_bf16(v[e][j][0] * rinv * gv[j][0], v[e][j][1] * rinv * gv[j][1]); w.y = pk_bf16(v[e][j][2] * rinv * gv[j][2], v[e][j][3] * rinv * gv[j][3]); o8[64 * j] = w; } } }
    }
}

namespace att {
constexpr int NST = 5, DEPTH_INFLIGHT = 4;
constexpr int STAGE = 16384;
constexpr int OFF_WS = NST * STAGE, WS_PER_WAVE = 8192 + 256;
__device__ __forceinline__ int crow(int r, int hi) { return (r & 3) + 8 * (r >> 2) + 4 * hi; }
__device__ __forceinline__ s16x4 vtr(const LAS unsigned char* p) { typedef short v4i16_t __attribute__((ext_vector_type(4))); return __builtin_bit_cast(s16x4, __builtin_amdgcn_ds_read_tr16_b64_v4i16((LAS v4i16_t*)p)); }

__device__ __forceinline__ void job_decode(int j, int nct, int qi, int kt0, int& type, int& tile) {
    if (j < nct) { type = 1; tile = j; } else if (j < nct + qi + 1) { type = 2; tile = j - nct; } else { type = 3; tile = kt0 + (j - nct - qi - 1); }
}

__device__ __forceinline__ void attn_phase(LAS unsigned char* lds, const bf16_t* KVB, const bf16_t* KC, const bf16_t* VC, const bf16_t* YO, bf16_t* OUT, int ldo, const float* NG, const float* qn, const float* kn) {
    const int tid = tid_opq(), lane = tid & 63, w = __builtin_amdgcn_readfirstlane(tid >> 6), q = lane & 31, hi = lane >> 5, hh = q >> 3, tl = q & 7;
    LAS float* impw = (LAS float*)(lds + OFF_WS + w * WS_PER_WAVE);
    LAS float* rs = impw + 2048;
    LAS float* rs2 = rs + 32;
    const float gq = wave_max(fabsf(qn[lane]));
    const float nB0 = -8.5f * LOG2E * gq * wave_max(fabsf(kn[lane]));
    const float nB1 = -8.5f * LOG2E * gq * wave_max(fabsf(kn[64 + lane]));
    const float nB2 = -8.5f * LOG2E * gq * wave_max(fabsf(kn[128 + lane]));
    const int G = gd_opq(), bx = bx_opq();
    const int drow = 8 * w + (lane >> 3), dsl = lane & 7;
    const unsigned dkoff = (unsigned)(drow * 128 + ((dsl ^ ((drow >> 1) & 7)) * 16));
    const unsigned dvoff = (unsigned)(drow * 128 + ((dsl ^ (4 * ((drow >> 1) & 1))) * 16));
    const unsigned ldsw = (unsigned)w * 1024u;
    const int kfx = (q >> 1) & 7;
    const int qrow = (lane & 15) >> 2, pcol = lane & 3, cgp = (lane >> 4) & 1, fbit = (qrow >> 1) & 1;
    const int vbase = (4 * hi + qrow) * 128 + (2 * cgp + (pcol >> 1)) * 16 + 8 * (pcol & 1);
    const int vb0 = vbase + fbit * 64, vb1 = vbase + (fbit ^ 1) * 64;
#define ATT_WAIT_BAR(N) asm volatile("s_waitcnt vmcnt(" #N ") lgkmcnt(0)\n\ts_barrier" ::: "memory")
    for (int it = 0;; ++it) {
        int qi, bg;
        if (G == 256) { if (it >= 8) break; const int r = bx >> 5; qi = 8 * (7 - it) + ((it & 1) ? r : 7 - r); bg = bx & 31; }
        else { const int idx = it * G + bx; if (idx >= 2048) break; qi = 63 - (idx >> 5); bg = idx & 31; }
        const int b = bg >> 2, g = bg & 3;
        const int tt = w * 8 + tl, tq = qi * 64 + tt;
        const size_t row = (size_t)b * 4096 + tq;
        const int head = g * 4 + hh;
        bf16x8 qf[4];
#pragma unroll
        for (int d0 = 0; d0 < 4; ++d0) qf[d0] = *(const bf16x8*)(YO + row * 2048 + 1024 + head * 64 + 16 * d0 + 8 * hi);
        const int cmaxq = (tq - 31) >> 4;
        const int nct = (4 * qi + 2) / 64 + 1;
        const int nw = (qi < 8 ? qi : 8) + 1, kt0 = qi - (nw - 1);
        const int NJ = nct + (qi + 1) + nw;
        const char* kcb = (const char*)(KC + (size_t)bg * 256 * 64); const char* vcb = (const char*)(VC + (size_t)bg * 256 * 64);
        const char* ksb = (const char*)(KVB + 2 * KVBUF + (size_t)bg * 4096 * 64); const char* vsb = (const char*)(KVB + 3 * KVBUF + (size_t)bg * 4096 * 64);
        const char* kwb = (const char*)(KVB + 4 * KVBUF + (size_t)bg * 4096 * 64); const char* vwb = (const char*)(KVB + 5 * KVBUF + (size_t)bg * 4096 * 64);
#define ATT_ISSUE(j_, st_) do { int ty_, tile_; job_decode((j_) < NJ ? (j_) : NJ - 1, nct, qi, kt0, ty_, tile_); \
            const char* kp_ = (ty_ < 2 ? kcb : (ty_ == 2 ? ksb : kwb)) + (size_t)tile_ * 8192; const char* vp_ = (ty_ < 2 ? vcb : (ty_ == 2 ? vsb : vwb)) + (size_t)tile_ * 8192; \
            __builtin_amdgcn_global_load_lds((const unsigned*)(kp_ + dkoff), (LAS unsigned*)(lds + (st_) * STAGE + ldsw), 16, 0, 0); \
            __builtin_amdgcn_global_load_lds((const unsigned*)(vp_ + dvoff), (LAS unsigned*)(lds + (st_) * STAGE + 8192 + ldsw), 16, 0, 0); } while (0)
        ATT_ISSUE(0, 0); ATT_ISSUE(1, 1); ATT_ISSUE(2, 2);
        f32x16 ofin[2], ocur[2];
#pragma unroll
        for (int r = 0; r < 16; ++r) { ofin[0][r] = 0.f; ofin[1][r] = 0.f; ocur[0][r] = 0.f; ocur[1][r] = 0.f; }
        float lsum = 0.f, carry = 0.f;
        unsigned long long mymask = (2ull << qi) - 1ull, unionmask = mymask;
        int st_cur = 0, st_iss = 3;
        for (int jp = 0; jp < NJ; jp += 2) {
            ATT_WAIT_BAR(2);
            ATT_ISSUE(jp + 3, st_iss); st_iss = (st_iss == NST - 1) ? 0 : st_iss + 1;
            ATT_ISSUE(jp + 4, st_iss); st_iss = (st_iss == NST - 1) ? 0 : st_iss + 1;
          for (int half = 0; half < 2; ++half) {
            const int j = jp + half; if (j >= NJ) break;
            int type, tile; job_decode(j, nct, qi, kt0, type, tile);
            const LAS unsigned char* Kb = lds + st_cur * STAGE;
            const LAS unsigned char* Vb = Kb + 8192;
            st_cur = (st_cur == NST - 1) ? 0 : st_cur + 1;
            const bool skip = (type == 2) && (((unionmask >> tile) & 1ull) == 0ull);
            if (!skip) {
                const float nbT = type < 2 ? nB0 : (type == 2 ? nB1 : nB2);
                const unsigned long long msel = (type == 2) ? mymask : ~0ull;
                const float rowsel = (float)(unsigned)((msel >> tile) & 1ull);
                const float nB = fmaf(rowsel, nbT, fmaf(rowsel, 30000.f, -30000.f));
                f32x16 p0, p1, cin;
#pragma unroll
                for (int r = 0; r < 16; ++r) cin[r] = nB;
#define ATT_QK2() do { \
                p0 = __builtin_amdgcn_mfma_f32_32x32x16_bf16(*(const LAS bf16x8*)(Kb + q * 128 + (hi ^ kfx) * 16), qf[0], cin, 0, 0, 0); \
                _Pragma("unroll") for (int d0 = 1; d0 < 4; ++d0) p0 = __builtin_amdgcn_mfma_f32_32x32x16_bf16(*(const LAS bf16x8*)(Kb + q * 128 + ((2 * d0 + hi) ^ kfx) * 16), qf[d0], p0, 0, 0, 0); \
                p1 = __builtin_amdgcn_mfma_f32_32x32x16_bf16(*(const LAS bf16x8*)(Kb + (32 + q) * 128 + (hi ^ kfx) * 16), qf[0], cin, 0, 0, 0); \
                _Pragma("unroll") for (int d0 = 1; d0 < 4; ++d0) p1 = __builtin_amdgcn_mfma_f32_32x32x16_bf16(*(const LAS bf16x8*)(Kb + (32 + q) * 128 + ((2 * d0 + hi) ^ kfx) * 16), qf[d0], p1, 0, 0, 0); } while (0)
#define ATT_PV2() do { _Pragma("unroll") for (int s = 0; s < 4; ++s) { u32x4 pw; \
                    if (s < 2) { pw.x = pk_bf16(p0[8 * s], p0[8 * s + 1]); pw.y = pk_bf16(p0[8 * s + 2], p0[8 * s + 3]); pw.z = pk_bf16(p0[8 * s + 4], p0[8 * s + 5]); pw.w = pk_bf16(p0[8 * s + 6], p0[8 * s + 7]); } \
                    else { const int s2 = s - 2; pw.x = pk_bf16(p1[8 * s2], p1[8 * s2 + 1]); pw.y = pk_bf16(p1[8 * s2 + 2], p1[8 * s2 + 3]); pw.z = pk_bf16(p1[8 * s2 + 4], p1[8 * s2 + 5]); pw.w = pk_bf16(p1[8 * s2 + 6], p1[8 * s2 + 7]); } \
                    const bf16x8 pa = __builtin_bit_cast(bf16x8, pw); \
                    { const s16x4 vlo = vtr(Vb + s * 2048 + vb0), vhi = vtr(Vb + s * 2048 + 1024 + vb0); \
                      const bf16x8 vf = (bf16x8){vlo[0], vlo[1], vlo[2], vlo[3], vhi[0], vhi[1], vhi[2], vhi[3]}; ocur[0] = __builtin_amdgcn_mfma_f32_32x32x16_bf16(pa, vf, ocur[0], 0, 0, 0); } \
                    { const s16x4 vlo = vtr(Vb + s * 2048 + vb1), vhi = vtr(Vb + s * 2048 + 1024 + vb1); \
                      const bf16x8 vf = (bf16x8){vlo[0], vlo[1], vlo[2], vlo[3], vhi[0], vhi[1], vhi[2], vhi[3]}; ocur[1] = __builtin_amdgcn_mfma_f32_32x32x16_bf16(pa, vf, ocur[1], 0, 0, 0); } } } while (0)
                const bool interior = (type == 2 && tile < qi) || (type == 3 && tile > qi - 8 && tile < qi);
                if (interior) {
                    ATT_QK2();
                    float ps = 0.f, ps1 = 0.f;
#pragma unroll
                    for (int r = 0; r < 16; ++r) { p0[r] = ex2(p0[r]); ps += p0[r]; }
#pragma unroll
                    for (int r = 0; r < 16; ++r) { p1[r] = ex2(p1[r]); ps1 += p1[r]; }
                    lsum += ps + ps1;
                    ATT_PV2();
                } else {
                    ATT_QK2();
                    int lo = 0, hiq = 63;
                    if (type < 2) hiq = cmaxq - 64 * tile;
                    else if (type == 2) { if (tile == qi) hiq = tt; }
                    else { if (tile == qi - 8) lo = tt + 1; if (tile == qi) hiq = tt; }
                    float ps = 0.f;
#pragma unroll
                    for (int r = 0; r < 16; ++r) { const int k0i = crow(r, hi), k1i = k0i + 32;
                        p0[r] = (k0i >= lo && k0i <= hiq) ? ex2(p0[r]) : 0.f; p1[r] = (k1i >= lo && k1i <= hiq) ? ex2(p1[r]) : 0.f; ps += p0[r] + p1[r]; }
                    lsum += ps;
                    if (type == 1 && qi >= 16) {
                        float s4[8], b3[8], pb[8];
#pragma unroll
                        for (int a = 0; a < 4; ++a) { s4[a] = (p0[4 * a] + p0[4 * a + 1]) + (p0[4 * a + 2] + p0[4 * a + 3]); b3[a] = p0[4 * a + 3];
                            s4[4 + a] = (p1[4 * a] + p1[4 * a + 1]) + (p1[4 * a + 2] + p1[4 * a + 3]); b3[4 + a] = p1[4 * a + 3]; }
#pragma unroll
                        for (int x = 0; x < 8; ++x) pb[x] = __shfl_xor(b3[x], 32);
#pragma unroll
                        for (int x = 0; x < 8; ++x) { const float extra = hi ? pb[x] : (x == 0 ? carry : pb[x == 0 ? 0 : x - 1]);
                            const int n = 16 * tile + 2 * (x & 3) + hi + 8 * (x >> 2);
                            impw[q * 64 + n] = s4[x] + extra; }
                        carry = pb[7];
                    }
                    ATT_PV2();
                }
#undef ATT_QK2
#undef ATT_PV2
            }
            const bool end_c2 = (type == 1 && tile == nct - 1), end_s = (type == 2 && tile == qi), end_w = (type == 3 && tile == qi);
            if (end_c2 || end_s || end_w) {
                const float l = lsum + __shfl_xor(lsum, 32);
                const float gt_ = NG[row * 64 + (end_c2 ? 0 : (end_s ? 16 : 32)) + head];
                const float linv = l > 0.f ? 1.f / l : 0.f;
                const float sc = gt_ * linv;
                if (hi == 0) { rs[q] = sc; if (end_c2) rs2[q] = linv; }
#pragma unroll
                for (int r = 0; r < 16; ++r) { const float f = rs[crow(r, hi)]; ofin[0][r] += f * ocur[0][r]; ofin[1][r] += f * ocur[1][r]; ocur[0][r] = 0.f; ocur[1][r] = 0.f; }
                lsum = 0.f;
            }
            if (end_c2 && qi >= 16) {
                unionmask = 0ull; mymask = 0ull;
                for (int i = 0; i < 8; ++i) {
                    const int n = lane; const bool valid = n <= qi, forced = (n == 0) || (n == qi) || (n == qi - 1);
                    const float sc = forced ? 1e6f : (impw[i * 64 + n] * rs2[i] + impw[(8 + i) * 64 + n] * rs2[8 + i]) + (impw[(16 + i) * 64 + n] * rs2[16 + i] + impw[(24 + i) * 64 + n] * rs2[24 + i]);
                    const unsigned key = valid ? ((__float_as_uint(sc) & ~63u) | (unsigned)(63 - n)) : 0u;
                    unsigned T = 0u;
#pragma unroll
                    for (int bit = 30; bit >= 0; --bit) { const unsigned cand = T | (1u << bit); const unsigned long long bm = __ballot(key >= cand); if (__popcll(bm) >= 16) T = cand; }
                    const unsigned long long mk = __ballot(valid && key >= T);
                    unionmask |= mk; if (tl == i) mymask = mk;
                }
            }
          }
        }
#pragma unroll
        for (int r = 0; r < 16; ++r) { const int qq = crow(r, hi); const size_t orow = (size_t)b * 4096 + qi * 64 + w * 8 + (qq & 7);
            bf16_t* op = OUT + orow * ldo + (g * 4 + (qq >> 3)) * 64 + q;
            op[0] = (bf16_t)(pk_bf16(ofin[0][r], 0.f) & 0xffffu); op[32] = (bf16_t)(pk_bf16(ofin[1][r], 0.f) & 0xffffu); }
        ATT_WAIT_BAR(0);
#undef ATT_ISSUE
    }
#undef ATT_WAIT_BAR
}
}


#define XB_TMO      128
#define XB_XCNT(j)  (256  + 64 * (j))
#define XB_XSUB(j)  (1280 + 64 * (j))
#define XB_XGEN(j)  (2304 + 64 * (j))
#define XB_TOP      3328
#define XB_TOPGEN   3392
#define XCD_BAR_WORDS 3456
#define XB_SPIN_CAP (1u << 22)
__device__ __forceinline__ unsigned xb_ld(unsigned* p)              { return __hip_atomic_load(p, __ATOMIC_RELAXED, __HIP_MEMORY_SCOPE_AGENT); }
__device__ __forceinline__ unsigned xb_add(unsigned* p, unsigned v) { return __hip_atomic_fetch_add(p, v, __ATOMIC_RELAXED, __HIP_MEMORY_SCOPE_AGENT); }
__device__ __forceinline__ unsigned xb_xcc_id() { return (unsigned)__builtin_amdgcn_s_getreg((3 << 11) | 20) & 0xFu; }
#define XB_SPIN(cond, bar) do { unsigned _sp = 0; while (cond) { __builtin_amdgcn_s_sleep(1); \
    if ((++_sp & 255u) == 0u) { if (xb_ld(&(bar)[XB_TMO])) break; if (_sp > XB_SPIN_CAP) { atomicAdd(&(bar)[XB_TMO], 1u); break; } } } } while (0)
struct XcdBarrier { unsigned* bar; unsigned x; volatile LAS unsigned* st; };
__device__ __forceinline__ void xcd_barrier_complete(unsigned* bar, unsigned x, unsigned& nloc, unsigned& nx) {
    const unsigned G = gridDim.x * gridDim.y * gridDim.z;
    unsigned sum, cnt, mine, sp = 0u;
    for (;;) {
        sum = 0u; cnt = 0u; mine = 0u;
#pragma unroll
        for (unsigned j = 0; j < 16; ++j) { const unsigned c = xb_ld(&bar[XB_XCNT(j)]); sum += c; cnt += (c > 0u) ? 1u : 0u; mine = (j == x) ? c : mine; }
        if (sum == G) break;
        __builtin_amdgcn_s_sleep(1);
        if ((++sp & 255u) == 0u) { if (xb_ld(&bar[XB_TMO])) break; if (sp > XB_SPIN_CAP) { atomicAdd(&bar[XB_TMO], 1u); break; } }
    }
    nloc = mine > 0u ? mine : 1u; nx = cnt > 0u ? cnt : 1u;
}
__device__ __forceinline__ void xcd_barrier(unsigned* bar, volatile LAS unsigned* st) {
    asm volatile("s_waitcnt vmcnt(0)" ::: "memory");
    __syncthreads();
    if (threadIdx.x == 0) {
        const unsigned x = xb_xcc_id();
        __builtin_amdgcn_s_waitcnt(0);
        unsigned nloc = st[0], nx = st[1];
        if (nloc == 0u) { xcd_barrier_complete(bar, x, nloc, nx); st[0] = nloc; st[1] = nx; }
        const unsigned old = xb_add(&bar[XB_XSUB(x)], 1u);
        const unsigned gen = old / nloc;
        if (old + 1u == (gen + 1u) * nloc) {
            __builtin_amdgcn_fence(__ATOMIC_RELEASE, "agent");
            asm volatile("s_waitcnt vmcnt(0)" ::: "memory");
            const unsigned og = xb_add(&bar[XB_TOP], 1u);
            const unsigned tg = og / nx;
            if (og + 1u == (tg + 1u) * nx) xb_add(&bar[XB_TOPGEN], 1u);
            else XB_SPIN(xb_ld(&bar[XB_TOPGEN]) == tg, bar);
            __builtin_amdgcn_fence(__ATOMIC_ACQUIRE, "agent");
            xb_add(&bar[XB_XGEN(x)], 1u);
            asm volatile("s_waitcnt vmcnt(0)" ::: "memory");
        } else {
            XB_SPIN(xb_ld(&bar[XB_XGEN(x)]) == gen, bar);
            __builtin_amdgcn_fence(__ATOMIC_ACQUIRE, "agent");
            asm volatile("s_waitcnt vmcnt(0)" ::: "memory");
        }
    }
    __syncthreads();
}

constexpr int LDS_BYTES = 155648;
constexpr int NPH = 16;

__device__ __forceinline__ unsigned char* opq(unsigned char* p) { asm volatile("" : "+s"(p)); return p; }
#define WSP(off) ((bf16_t*)(opq(a.ws) + (off)))
#define WSF(off) ((float*)(opq(a.ws) + (off)))

__global__ void __launch_bounds__(512, 2) mega(Args a) {
    extern __shared__ __attribute__((aligned(16))) unsigned char lds_raw[];
    LAS unsigned char* lds = (LAS unsigned char*)lds_raw;
    cg::grid_group grid = cg::this_grid();
    const int lo = a.ph_lo, hi = a.ph_hi;
    volatile LAS unsigned* xst = (volatile LAS unsigned*)(lds + 155648 - 64);
    if (threadIdx.x == 0) { xst[0] = 0u; xst[1] = 0u; if (hi - lo > 1) (void)xb_add(&((unsigned*)(a.ws + WS_BAR))[XB_XCNT(xb_xcc_id())], 1u); }
    __syncthreads();
#define IDS const int tid = tid_opq(), lane = tid & 63, wave = __builtin_amdgcn_readfirstlane(tid >> 6); const int G = gd_opq(), bx = bx_opq(); \
    const int gw = bx * 8 + wave, ngw = G * 8, gt = bx * 512 + tid, ngt = G * 512; (void)lane; (void)gw; (void)ngw; (void)gt; (void)ngt;
#define IN(k) (lo <= (l * NPH + (k)) && (l * NPH + (k)) < hi)
#define SEAM(k) do { if (lo <= (l * NPH + (k)) && (l * NPH + (k)) + 1 < hi) { if (hi < 0) grid.sync(); xcd_barrier((unsigned*)(opq(a.ws) + WS_BAR), xst); if (PROBE_SYNC2) xcd_barrier((unsigned*)(opq(a.ws) + WS_BAR), xst); } } while (0)
    for (int l = 0; l < DEPTH; ++l) {
        for (int rep_ = 0; rep_ < ((PROBE_DUP >> 0) & 1) + 1; ++rep_) if (IN(0)) {
            IDS
            weights_phase(a, l, lds, gw, ngw, wave, lane);
            rms_phase((l == 0) ? a.in[0] : a.out, a.in[1] + l * 1024, WSP(WS_H), gw, ngw, lane);
        }
        SEAM(0);
        for (int rep_ = 0; rep_ < ((PROBE_DUP >> 1) & 1) + 1; ++rep_) if (IN(1)) {
            pg8::StaticOrder S; pg8::Gemm g{WSP(WS_H), WSP(WS_W + W_INA), MTOK, 2048, 1024, 1024, 0, 0}; S.init(MTOK, 2048, gd_opq(), bx_opq());
            EpiInA E{WSP(WS_RX), WSP(WS_YO)}; pg8::gemm_phase<EpiInA>(lds, g, S, E);
        }
        SEAM(1);
        for (int rep_ = 0; rep_ < ((PROBE_DUP >> 2) & 1) + 1; ++rep_) if (IN(2)) {
            IDS
            const bf16_t* RX = WSP(WS_RX); bf16_t* XR = WSP(WS_XR); const bf16_t* Wc1 = WSP(WS_W + W_C1); float* bias1 = WSF(WS_CTL);
            const float* cw = a.in[3] + l * 4 * 1024; const float* cb = a.in[4] + l * 1024;
            {
                const int ch = (gt & 127) * 8;
                f32x4 cwv[4][2]; f32x4 cbv[2];
#pragma unroll
                for (int kk = 0; kk < 4; ++kk) { cwv[kk][0] = *(const f32x4*)(cw + kk * 1024 + ch); cwv[kk][1] = *(const f32x4*)(cw + kk * 1024 + ch + 4); }
                cbv[0] = *(const f32x4*)(cb + ch); cbv[1] = *(const f32x4*)(cb + ch + 4);
                const bool chfix = (ngt & 127) == 0;
                for (int it0 = gt; it0 < MTOK * 128; it0 += 2 * ngt) {
                    u32x4 xw[2][4]; int rowv[2]; bool ok[2];
#pragma unroll
                    for (int e = 0; e < 2; ++e) { const int it = it0 + e * ngt; ok[e] = it < MTOK * 128; const int itc = ok[e] ? it : it0; rowv[e] = itc >> 7; const int s = rowv[e] & 4095;
#pragma unroll
                        for (int kk = 0; kk < 4; ++kk) xw[e][kk] = (s - 3 + kk >= 0) ? *(const u32x4*)(RX + (size_t)(rowv[e] - 3 + kk) * 1024 + ch) : (u32x4){0u, 0u, 0u, 0u}; }
#pragma unroll
                    for (int e = 0; e < 2; ++e) {
                        float acc[8] = {cbv[0][0], cbv[0][1], cbv[0][2], cbv[0][3], cbv[1][0], cbv[1][1], cbv[1][2], cbv[1][3]};
#pragma unroll
                        for (int kk = 0; kk < 4; ++kk) { const u32x4 w4 = xw[e][kk]; const f32x4 c0 = cwv[kk][0], c1 = cwv[kk][1];
                            acc[0] += c0[0] * bf_lo(w4.x); acc[1] += c0[1] * bf_hi(w4.x); acc[2] += c0[2] * bf_lo(w4.y); acc[3] += c0[3] * bf_hi(w4.y);
                            acc[4] += c1[0] * bf_lo(w4.z); acc[5] += c1[1] * bf_hi(w4.z); acc[6] += c1[2] * bf_lo(w4.w); acc[7] += c1[3] * bf_hi(w4.w); }
                        u32x4 o; o.x = pk_bf16(acc[0], acc[1]); o.y = pk_bf16(acc[2], acc[3]); o.z = pk_bf16(acc[4], acc[5]); o.w = pk_bf16(acc[6], acc[7]);
                        if (ok[e] && chfix) *(u32x4*)(XR + (size_t)rowv[e] * 1024 + ch) = o; } }
                if (!chfix) {
                    for (int it = gt; it < MTOK * 128; it += ngt) { const int row = it >> 7, c2 = (it & 127) * 8, s = row & 4095; float acc[8];
#pragma unroll
                        for (int i = 0; i < 8; ++i) acc[i] = cb[c2 + i];
#pragma unroll
                        for (int kk = 0; kk < 4; ++kk) if (s - 3 + kk >= 0) { const u32x4 w4 = *(const u32x4*)(RX + (size_t)(row - 3 + kk) * 1024 + c2); const f32x4 c0 = *(const f32x4*)(cw + kk * 1024 + c2), c1 = *(const f32x4*)(cw + kk * 1024 + c2 + 4);
                            acc[0] += c0[0] * bf_lo(w4.x); acc[1] += c0[1] * bf_hi(w4.x); acc[2] += c0[2] * bf_lo(w4.y); acc[3] += c0[3] * bf_hi(w4.y);
                            acc[4] += c1[0] * bf_lo(w4.z); acc[5] += c1[1] * bf_hi(w4.z); acc[6] += c1[2] * bf_lo(w4.w); acc[7] += c1[3] * bf_hi(w4.w); }
                        u32x4 o; o.x = pk_bf16(acc[0], acc[1]); o.y = pk_bf16(acc[2], acc[3]); o.z = pk_bf16(acc[4], acc[5]); o.w = pk_bf16(acc[6], acc[7]);
                        *(u32x4*)(XR + (size_t)row * 1024 + c2) = o; } }
            }
            if (gt < 1024) { const float lm = a.in[9][l * 1024 + gt]; const float e = __expf(-fabsf(lm)); const float lp = e < 0.03f ? e * (1.f - e * (0.5f - e * (0.33333333f - 0.25f * e))) : __logf(1.f + e); bias1[1024 + gt] = -8.f * LOG2E * (fmaxf(-lm, 0.f) + lp); }
            for (int j = gw; j < 512; j += ngw) { const float* pos = (j >> 8 ? a.in[13] : a.in[12]) + l * 2048; const bf16_t* wr_ = Wc1 + (size_t)j * 2048;
                float s = 0.f;
                for (int kk = lane; kk < 2048; kk += 64) s += pos[kk] * __uint_as_float((unsigned)wr_[kk] << 16);
                s = wave_sum(s); if (lane == 0) bias1[j] = s; }
        }
        SEAM(2);
        for (int rep_ = 0; rep_ < ((PROBE_DUP >> 3) & 1) + 1; ++rep_) if (IN(3)) {
            pg8::StaticOrder S; pg8::Gemm g{WSP(WS_XR), WSP(WS_W + W_G), MTOK, 2048, 256, 1024, 2, 0}; S.init(MTOK, 2048, gd_opq(), bx_opq());
            EpiGate E{WSP(WS_XR), WSP(WS_LA), WSP(WS_U), a.in[6] + l * 1024, a.in[8] + l * 1024, WSF(WS_CTL) + 1024}; pg8::gemm_phase<EpiGate>(lds, g, S, E);
        }
        SEAM(3);
        for (int rep_ = 0; rep_ < ((PROBE_DUP >> 4) & 1) + 1; ++rep_) if (IN(4)) {
            IDS
            const bf16_t* LA = WSP(WS_LA); const bf16_t* U = WSP(WS_U); float* AGA = WSF(WS_AGG); float* AGH = AGA + 8 * 64 * 1024;
            for (int it = gt; it < 8 * 64 * 256; it += ngt) { const int cq = it & 255, bc = it >> 8; const int ch = 4 * cq; const size_t row0 = (size_t)bc * 64;
                float s[4] = {0.f, 0.f, 0.f, 0.f}, h[4] = {0.f, 0.f, 0.f, 0.f};
#pragma unroll 8
                for (int t = 0; t < 64; ++t) { const u32x2 wl = *(const u32x2*)(LA + (row0 + t) * 1024 + ch), wu = *(const u32x2*)(U + (row0 + t) * 1024 + ch);
                    const float l0 = bf_lo(wl.x), l1 = bf_hi(wl.x), l2 = bf_lo(wl.y), l3 = bf_hi(wl.y); s[0] += l0; s[1] += l1; s[2] += l2; s[3] += l3;
                    h[0] = ex2(l0) * h[0] + bf_lo(wu.x); h[1] = ex2(l1) * h[1] + bf_hi(wu.x); h[2] = ex2(l2) * h[2] + bf_lo(wu.y); h[3] = ex2(l3) * h[3] + bf_hi(wu.y); }
                *(f32x4*)(AGA + (size_t)bc * 1024 + ch) = (f32x4){ex2(s[0]), ex2(s[1]), ex2(s[2]), ex2(s[3])}; *(f32x4*)(AGH + (size_t)bc * 1024 + ch) = (f32x4){h[0], h[1], h[2], h[3]}; }
        }
        SEAM(4);
        if (IN(5)) {
            IDS
            const bf16_t* LA = WSP(WS_LA); const bf16_t* U = WSP(WS_U); bf16_t* YO = WSP(WS_YO); const float* AGA = WSF(WS_AGG); const float* AGH = AGA + 8 * 64 * 1024;
            for (int it = gt; it < 8 * 64 * 256; it += ngt) { const int cq = it & 255, bc = it >> 8; const int ch = 4 * cq; const size_t row0 = (size_t)bc * 64; const int c = bc & 63, b0 = bc - c;
                f32x4 h = (f32x4){0.f, 0.f, 0.f, 0.f};
                {   int cc = 0;
                    for (; cc + 8 <= c; cc += 8) { f32x4 A[8], Hh[8];
#pragma unroll
                        for (int k = 0; k < 8; ++k) { A[k] = *(const f32x4*)(AGA + (size_t)(b0 + cc + k) * 1024 + ch); Hh[k] = *(const f32x4*)(AGH + (size_t)(b0 + cc + k) * 1024 + ch); }
#pragma unroll
                        for (int k = 0; k < 8; ++k) h = A[k] * h + Hh[k]; }
                    for (; cc < c; ++cc) { const f32x4 A = *(const f32x4*)(AGA + (size_t)(b0 + cc) * 1024 + ch), Hh = *(const f32x4*)(AGH + (size_t)(b0 + cc) * 1024 + ch); h = A * h + Hh; } }
                for (int t0 = 0; t0 < 64; t0 += 8) { u32x2 wl[8], wu[8], gy[8];
#pragma unroll
                    for (int k = 0; k < 8; ++k) { wl[k] = *(const u32x2*)(LA + (row0 + t0 + k) * 1024 + ch); wu[k] = *(const u32x2*)(U + (row0 + t0 + k) * 1024 + ch); gy[k] = *(const u32x2*)(YO + (row0 + t0 + k) * 2048 + ch); }
#pragma unroll
                    for (int k = 0; k < 8; ++k) { h[0] = ex2(bf_lo(wl[k].x)) * h[0] + bf_lo(wu[k].x); h[1] = ex2(bf_hi(wl[k].x)) * h[1] + bf_hi(wu[k].x); h[2] = ex2(bf_lo(wl[k].y)) * h[2] + bf_lo(wu[k].y); h[3] = ex2(bf_hi(wl[k].y)) * h[3] + bf_hi(wu[k].y);
                        u32x2 o; o.x = pk_bf16(h[0] * bf_lo(gy[k].x), h[1] * bf_hi(gy[k].x)); o.y = pk_bf16(h[2] * bf_lo(gy[k].y), h[3] * bf_hi(gy[k].y)); gy[k] = o; }
#pragma unroll
                    for (int k = 0; k < 8; ++k) *(u32x2*)(YO + (row0 + t0 + k) * 2048 + ch) = gy[k]; }
            }
        }
        SEAM(5);
        for (int rep_ = 0; rep_ < ((PROBE_DUP >> 6) & 1) + 1; ++rep_) if (IN(6)) {
            pg8::StaticOrder S; pg8::Gemm g{WSP(WS_H), WSP(WS_W + W_INB), MTOK, 4864, 1024, 1024, 0, 0}; S.init(MTOK, 4864, gd_opq(), bx_opq());
            EpiInB E{WSP(WS_YO), WSP(WS_RX), WSP(WS_LA), WSF(WS_NG), a.in[10] + l * 64, a.in[11] + l * 192}; pg8::gemm_phase<EpiInB>(lds, g, S, E);
        }
        SEAM(6);
        for (int rep_ = 0; rep_ < ((PROBE_DUP >> 7) & 1) + 1; ++rep_) if (IN(7)) {
            pg8::StaticOrder S; pg8::Gemm g{WSP(WS_RX), WSP(WS_W + W_C1), 16384, 256, 2048, 1024, 0, 32}; S.init(16384, 256, gd_opq(), bx_opq());
            EpiCmp1 E{WSP(WS_HID), WSF(WS_CTL)}; pg8::gemm_phase<EpiCmp1>(lds, g, S, E);
        }
        SEAM(7);
        for (int rep_ = 0; rep_ < ((PROBE_DUP >> 8) & 1) + 1; ++rep_) if (IN(8)) {
            IDS
            const bf16_t* HID = WSP(WS_HID); bf16_t* KC = WSP(WS_KC); bf16_t* VC = WSP(WS_VC);
            const float* kn0 = a.in[11] + l * 192;
            LAS float* w2s = (LAS float*)lds;
            for (int i = tid; i < 2 * 4096; i += 512) { const f32x4 v = (i < 4096) ? ((const f32x4*)(a.in[15] + (size_t)l * 16384))[i] : ((const f32x4*)(a.in[17] + (size_t)l * 16384))[i - 4096]; *(LAS f32x4*)(w2s + 4 * i) = v; }
            __syncthreads();
            for (int r0 = gw * 4; r0 < 16384; r0 += ngw * 4) {
                const int which = r0 >> 13;
                const LAS float* wq = w2s + which * 16384 + lane;
                const unsigned* hp = (const unsigned*)(HID + (size_t)r0 * 256);
                float acc0 = 0.f, acc1 = 0.f, acc2 = 0.f, acc3 = 0.f;
#pragma unroll 4
                for (int h2 = 0; h2 < 128; ++h2) {
                    const float w0 = wq[(2 * h2) * 64], w1 = wq[(2 * h2 + 1) * 64];
                    const unsigned x0 = hp[h2], x1 = hp[128 + h2], x2 = hp[256 + h2], x3 = hp[384 + h2];
                    acc0 += bf_lo(x0) * w0 + bf_hi(x0) * w1; acc1 += bf_lo(x1) * w0 + bf_hi(x1) * w1;
                    acc2 += bf_lo(x2) * w0 + bf_hi(x2) * w1; acc3 += bf_lo(x3) * w0 + bf_hi(x3) * w1; }
                float accv[4] = {acc0, acc1, acc2, acc3};
#pragma unroll
                for (int e = 0; e < 4; ++e) { const int r = r0 + e, rr = r & 8191, c = rr & 255, bgi = rr >> 8;
                    bf16_t* dst = (which ? VC : KC) + ((size_t)bgi * 256 + c) * 64;
                    float v = accv[e];
                    if (!which) { const float ss = wave_sum(v * v); v *= rsqrtf(ss * (1.f / 64.f) + EPS) * kn0[lane]; }
                    if (c == 255) v = 0.f;
                    dst[lane] = (bf16_t)(pk_bf16(v, 0.f) & 0xffffu); }
            }
            __syncthreads();
        }
        SEAM(8);
        if (IN(9)) {
            if (PROBE_DUP & (1 << 9)) att::attn_phase(lds, WSP(WS_RX), WSP(WS_KC), WSP(WS_VC), WSP(WS_YO), WSP(WS_H), 1024, WSF(WS_NG), a.in[10] + l * 64, a.in[11] + l * 192);
            att::attn_phase(lds, WSP(WS_RX), WSP(WS_KC), WSP(WS_VC), WSP(WS_YO), WSP(WS_YO) + 1024, 2048, WSF(WS_NG), a.in[10] + l * 64, a.in[11] + l * 192);
        }
        SEAM(9);
        if (IN(10)) {
            pg8::StaticOrder S; pg8::Gemm g{WSP(WS_YO), WSP(WS_W + W_YA), MTOK, 1024, 2048, 2048, 0, 0}; S.init(MTOK, 1024, gd_opq(), bx_opq());
            EpiMixM E{WSP(WS_H), WSP(WS_LA)}; pg8::gemm_phase<EpiMixM>(lds, g, S, E);
        }
        SEAM(10);
        if (IN(12)) {
            pg8::StaticOrder S; pg8::Gemm g{WSP(WS_H), WSP(WS_W + W_O), MTOK, 1024, 1024, 1024, 0, 0}; S.init(MTOK, 1024, gd_opq(), bx_opq());
            EpiRes E{(l == 0) ? a.in[0] : a.out, a.out}; pg8::gemm_phase<EpiRes>(lds, g, S, E);
        }
        SEAM(12);
        for (int rep_ = 0; rep_ < ((PROBE_DUP >> 13) & 1) + 1; ++rep_) if (IN(13)) {
            IDS
            rms_phase(a.out, a.in[21] + l * 1024, WSP(WS_H), gw, ngw, lane);
        }
        SEAM(13);
        for (int rep_ = 0; rep_ < ((PROBE_DUP >> 14) & 1) + 1; ++rep_) if (IN(14)) {
            pg8::StaticOrder S; pg8::Gemm g{WSP(WS_H), WSP(WS_W + W_GU), MTOK, 5632, 1024, 1024, 0, 0}; S.init(MTOK, 5632, gd_opq(), bx_opq());
            EpiSwi E{WSP(WS_RX)}; pg8::gemm_phase<EpiSwi>(lds, g, S, E);
        }
        SEAM(14);
        if (IN(15)) {
            pg8::StaticOrder S; pg8::Gemm g{WSP(WS_RX), WSP(WS_W + W_D), MTOK, 1024, D_FF, D_FF, 0, 0}; S.init(MTOK, 1024, gd_opq(), bx_opq());
            EpiRes E{a.out, a.out}; pg8::gemm_phase<EpiRes>(lds, g, S, E);
        }
        SEAM(15);
    }
#undef IDS
#undef IN
#undef SEAM
}

extern "C" void kernel_launch(void* const* d_in, const int* in_sizes, int n_in, void* d_out, int out_size, void* d_ws, size_t ws_size, hipStream_t stream) {
    static int grid = 0;
    if (grid == 0) {
        if (n_in != 25 || out_size != MTOK * DM || ws_size < WS_END) { fprintf(stderr, "kernel_launch: unexpected problem (n_in %d, out %d, ws %zu)\n", n_in, out_size, ws_size); grid = -1; return; }
        int dev = 0, cus = 0, per_cu = 0;
        hipGetDevice(&dev); hipDeviceGetAttribute(&cus, hipDeviceAttributeMultiprocessorCount, dev);
        hipFuncSetAttribute((const void*)mega, hipFuncAttributeMaxDynamicSharedMemorySize, LDS_BYTES);
        if (hipOccupancyMaxActiveBlocksPerMultiprocessor(&per_cu, (const void*)mega, 512, LDS_BYTES) != hipSuccess || per_cu < 1) per_cu = 1;
        (void)hipGetLastError();
        grid = cus * per_cu;
        if (grid <= 0) grid = 256;
    }
    if (grid < 0) return;
    Args a{};
    for (int i = 0; i < 25; ++i) a.in[i] = (const float*)d_in[i];
    a.out = (float*)d_out; a.ws = (unsigned char*)d_ws;
#if MK_MULTI
    for (int p = 0; p < DEPTH * NPH; ++p) { a.ph_lo = p; a.ph_hi = p + 1; hipLaunchKernelGGL(mega, dim3(grid), dim3(512), LDS_BYTES, stream, a); }
#else
    a.ph_lo = 0; a.ph_hi = DEPTH * NPH;
    (void)hipMemsetAsync((char*)d_ws + WS_BAR, 0, 16384, stream);
    void* args[] = {&a};
    hipError_t e = hipLaunchCooperativeKernel((const void*)mega, dim3(grid), dim3(512), args, LDS_BYTES, stream);
    if (e != hipSuccess) fprintf(stderr, "cooperative launch failed: %s (grid %d)\n", hipGetErrorString(e), grid);
#endif
}
```

```cpp
#include <hip/hip_runtime.h>
#include <hip/hip_cooperative_groups.h>
#include <cstdio>
#include <cstdint>
namespace cg = cooperative_groups;

#ifndef PROBE_SYNC2
#define PROBE_SYNC2 0
#endif
#ifndef PROBE_DUP
#define PROBE_DUP 0
#endif
#ifndef MK_MULTI
#define MK_MULTI 0
#endif

#define LAS __attribute__((address_space(3)))
typedef unsigned short bf16_t;
typedef short bf16x8 __attribute__((ext_vector_type(8)));
typedef short s16x4 __attribute__((ext_vector_type(4)));
typedef float f32x2 __attribute__((ext_vector_type(2)));
typedef float f32x4 __attribute__((ext_vector_type(4)));
typedef float f32x16 __attribute__((ext_vector_type(16)));
typedef unsigned u32x2 __attribute__((ext_vector_type(2)));
typedef unsigned u32x4 __attribute__((ext_vector_type(4)));
typedef __bf16 bf16x2_t __attribute__((ext_vector_type(2)));

constexpr int DM = 1024, NB = 8, SEQ = 4096, MTOK = NB * SEQ, DEPTH = 2;
constexpr int D_IN = 6704, D_FF = 2816;
constexpr float EPS = 1e-6f;
constexpr float LOG2E = 1.4426950408889634f;
constexpr float QSCALE = 0.125f * LOG2E;

constexpr size_t MiB = 1u << 20;
constexpr size_t WS_CTL = 0;
constexpr size_t WS_BAR = 65536;
constexpr size_t WS_W = 1 * MiB;
constexpr size_t W_INA = 0, W_INB = 4 * MiB, W_G = 14 * MiB, W_C1 = 15 * MiB, W_YA = 17 * MiB, W_YB = 19 * MiB, W_O = 21 * MiB, W_GU = 23 * MiB, W_D = 34 * MiB;
constexpr size_t WS_H = 41 * MiB;
constexpr size_t WS_RX = 105 * MiB;
constexpr size_t WS_XR = 169 * MiB;
constexpr size_t WS_LA = 233 * MiB;
constexpr size_t WS_U = 297 * MiB;
constexpr size_t WS_YO = 361 * MiB;
constexpr size_t WS_NG = 489 * MiB;
constexpr size_t WS_HID = 497 * MiB;
constexpr size_t WS_KC = 505 * MiB;
constexpr size_t WS_VC = 506 * MiB;
constexpr size_t WS_AGG = 507 * MiB;
constexpr size_t WS_END = 511 * MiB;
constexpr size_t KVBUF = (size_t)32 * 4096 * 64;

__device__ __forceinline__ int bx_opq() { int t = blockIdx.x; asm volatile("" : "+s"(t)); return t; }
__device__ __forceinline__ int gd_opq() { int t = gridDim.x; asm volatile("" : "+s"(t)); return t; }
__device__ __forceinline__ int tid_opq() { int t = threadIdx.x; asm volatile("" : "+v"(t)); return t; }
__device__ __forceinline__ unsigned pk_bf16(float lo, float hi) { f32x2 v = {lo, hi}; bf16x2_t b = __builtin_convertvector(v, bf16x2_t); return __builtin_bit_cast(unsigned, b); }
__device__ __forceinline__ float bf_lo(unsigned w) { return __uint_as_float(w << 16); }
__device__ __forceinline__ float bf_hi(unsigned w) { return __uint_as_float(w & 0xffff0000u); }
__device__ __forceinline__ float ex2(float x) { return __builtin_amdgcn_exp2f(x); }
__device__ __forceinline__ float sigm(float x) { return __builtin_amdgcn_rcpf(1.f + ex2(-LOG2E * x)); }
__device__ __forceinline__ float gelu_t(float x) { const float y = 1.5957691216057308f * (x + 0.044715f * x * x * x); return x * sigm(y); }
__device__ __forceinline__ float wave_sum(float v) {
#pragma unroll
    for (int o = 1; o < 64; o <<= 1) v += __shfl_xor(v, o);
    return v;
}
__device__ __forceinline__ float wave_max(float v) {
#pragma unroll
    for (int o = 1; o < 64; o <<= 1) v = fmaxf(v, __shfl_xor(v, o));
    return v;
}
__device__ __forceinline__ u32x4 pack8(const f32x4 a, const f32x4 b) { u32x4 w; w.x = pk_bf16(a[0], a[1]); w.y = pk_bf16(a[2], a[3]); w.z = pk_bf16(b[0], b[1]); w.w = pk_bf16(b[2], b[3]); return w; }

namespace pg8 {
constexpr int BM = 256, BK = 64, HALF = 128, HTB = HALF * BK * 2, STAGE_BYTES = 8 * HTB, NXCD = 8, WGM = 8;
__host__ __device__ __forceinline__ int lds_byte(int r, int c) { const int st = (r >> 4) * 2 + (c >> 5), rr = r & 15, cc = c & 31, ob = rr * 64 + cc * 2; return st * 1024 + (ob ^ (((ob >> 9) & 1) << 5)); }
__host__ __device__ __forceinline__ void stage_rc(int b, int& R, int& C) { const int st = b / 1024, sb = b % 1024, swz = sb ^ (((sb >> 9) & 1) << 5); R = (st >> 1) * 16 + swz / 64; C = (st & 1) * 32 + (swz % 64) / 2; }
__host__ __device__ __forceinline__ int perm32(int rho) { const int n = rho >> 4, i = rho & 15; return 8 * (i >> 2) + 4 * n + (i & 3); }

struct Unit { int pm, pn; };
struct Gemm { const bf16_t* A; const bf16_t* Bt; int M, N, K, lda, a_div, b_div; };

struct StaticOrder {
    int nM, nN, nwg, G, c;
    __device__ void init(int M, int N, int G_, int c_) { nM = M / BM; nN = N / BM; nwg = nM * nN; G = G_; c = c_; }
    __device__ bool next(int i, Unit& u) const {
        const long L = (long)i * G + c; if (L >= nwg) return false;
        int wgid = (int)L; { const int q = nwg / NXCD, r = nwg % NXCD, xcd = wgid % NXCD, off = wgid / NXCD; wgid = (xcd < r ? xcd * (q + 1) : r * (q + 1) + (xcd - r) * q) + off; }
        const int nig = WGM * nN, gid = wgid / nig, fm = gid * WGM, gsz = (nM - fm) < WGM ? (nM - fm) : WGM;
        u.pm = fm + ((wgid % nig) % gsz); u.pn = (wgid % nig) / gsz; return true;
    }
};
__device__ __forceinline__ const char* unitA(const Gemm& g, const Unit& u, size_t tstepA) { return (const char*)g.A + (size_t)u.pm * tstepA + (g.a_div ? (size_t)(u.pn / g.a_div) * (size_t)g.K * 2 : (size_t)0); }
__device__ __forceinline__ const char* unitB(const Gemm& g, const Unit& u, size_t tstepB) { return (const char*)g.Bt + (size_t)(u.pn + (g.b_div ? (u.pm / g.b_div) * (g.N / BM) : 0)) * tstepB; }

template <class Epi>
__device__ __forceinline__ void gemm_phase(LAS unsigned char* lds, const Gemm g, const StaticOrder& S, const Epi& E) {
    const int tid = tid_opq(), wid = __builtin_amdgcn_readfirstlane(tid >> 6), lane = tid & 63, wr = wid >> 2, wc = wid & 3, fr = lane & 15, fq = lane >> 4;
    const int K = g.K, nt = K / BK;
    unsigned voffA[2], voffB[2];
#pragma unroll
    for (int i = 0; i < 2; ++i) { int R, C; stage_rc(tid * 16 + i * 8192, R, C); const int Rb = Epi::PERM ? ((R & ~31) + perm32(R & 31)) : R;
        voffA[i] = (unsigned)(R * g.lda + C) * 2u; voffB[i] = (unsigned)(Rb * K + C) * 2u; }
    const size_t kstep = (size_t)(BK * 2);
    const size_t hstepA = (size_t)HALF * g.lda * 2, hstepB = (size_t)HALF * K * 2;
    const size_t tstepA = 2 * hstepA, tstepB = 2 * hstepB;
    const unsigned ldsw = (unsigned)wid * 1024u;
    const int aoff = lds_byte(wr * 64 + fr, fq * 8), boff = lds_byte(wc * 32 + fr, fq * 8);
#define PG8_SA(b, h) (((b) * 2 + (h)) * HTB)
#define PG8_SB(b, h) ((4 + (b) * 2 + (h)) * HTB)
#define PG8_STAGE(bufoff, gbase, voff) do { _Pragma("unroll") for (int _i = 0; _i < 2; ++_i) \
        __builtin_amdgcn_global_load_lds((const unsigned*)((const char*)(gbase) + (voff)[_i]), (LAS unsigned*)(lds + (bufoff) + ldsw + _i * 8192), 16, 0, 0); } while (0)
#define PG8_LDA(dst, b, h) do { _Pragma("unroll") for (int m = 0; m < 4; ++m) _Pragma("unroll") for (int k = 0; k < 2; ++k) dst[m][k] = *(const LAS bf16x8*)(lds + PG8_SA(b, h) + aoff + m * 2048 + k * 1024); } while (0)
#define PG8_LDB(dst, b, h) do { _Pragma("unroll") for (int n = 0; n < 2; ++n) _Pragma("unroll") for (int k = 0; k < 2; ++k) dst[n][k] = *(const LAS bf16x8*)(lds + PG8_SB(b, h) + boff + n * 2048 + k * 1024); } while (0)
#define PG8_MMA(ai, bj, At, Bt) do { __builtin_amdgcn_s_setprio(1); _Pragma("unroll") for (int m = 0; m < 4; ++m) _Pragma("unroll") for (int n = 0; n < 2; ++n) _Pragma("unroll") for (int k = 0; k < 2; ++k) \
        acc[ai][bj][m][n] = __builtin_amdgcn_mfma_f32_16x16x32_bf16(Bt[n][k], At[m][k], acc[ai][bj][m][n], 0, 0, 0); __builtin_amdgcn_s_setprio(0); } while (0)
#define PG8_WAIT_V(n) asm volatile("s_waitcnt vmcnt(" #n ")" ::: "memory")
#define PG8_WAIT_L(n) asm volatile("s_waitcnt lgkmcnt(" #n ")" ::: "memory")
#define PG8_BAR __builtin_amdgcn_s_barrier()
#define PG8_SCHED __builtin_amdgcn_sched_barrier(0)
    Unit cur, nxt; int ui = 0;
    if (!S.next(0, cur)) return;
    f32x4 acc[2][2][4][2];
#pragma unroll
    for (int a = 0; a < 2; ++a)
#pragma unroll
        for (int b = 0; b < 2; ++b)
#pragma unroll
            for (int m = 0; m < 4; ++m)
#pragma unroll
                for (int n = 0; n < 2; ++n) acc[a][b][m][n] = (f32x4){0.f, 0.f, 0.f, 0.f};
    bf16x8 At[4][2], B0[2][2], B1[2][2];
    const char* cA = unitA(g, cur, tstepA); const char* cB = unitB(g, cur, tstepB);
    PG8_STAGE(PG8_SB(0, 0), cB, voffB); PG8_STAGE(PG8_SB(0, 1), cB + hstepB, voffB); PG8_STAGE(PG8_SA(0, 0), cA, voffA); PG8_STAGE(PG8_SA(0, 1), cA + hstepA, voffA);
    if (wr == 1) PG8_BAR;
    PG8_WAIT_V(2); PG8_BAR;
    PG8_STAGE(PG8_SB(1, 0), cB + kstep, voffB); PG8_STAGE(PG8_SA(1, 0), cA + kstep, voffA); PG8_STAGE(PG8_SB(1, 1), cB + hstepB + kstep, voffB);
    PG8_WAIT_V(6); PG8_BAR;
    for (;;) {
        const bool has_next = S.next(ui + 1, nxt);
        const char* nA = has_next ? unitA(g, nxt, tstepA) : cA; const char* nB = has_next ? unitB(g, nxt, tstepB) : cB;
#pragma unroll 1
        for (int t = 0; t < nt; t += 2) {
            const bool last = (t == nt - 2);
            const char* a1 = cA + (size_t)(t + 1) * kstep;
            const char* a2 = last ? nA : cA + (size_t)(t + 2) * kstep; const char* b2 = last ? nB : cB + (size_t)(t + 2) * kstep;
            const char* a3 = a2 + kstep; const char* b3 = b2 + kstep;
            if constexpr (Epi::MID) { if (t == nt / 2) E.mid(acc, cur, wr, wc, fr, fq); }
            PG8_LDB(B0, 0, 0); PG8_LDB(B1, 0, 1); PG8_SCHED; PG8_LDA(At, 0, 0); PG8_STAGE(PG8_SA(1, 1), a1 + hstepA, voffA);
            PG8_WAIT_V(8); PG8_WAIT_L(0); PG8_BAR; PG8_MMA(0, 0, At, B0); PG8_MMA(0, 1, At, B1); PG8_BAR; PG8_SCHED;
            PG8_LDA(At, 0, 1); PG8_STAGE(PG8_SB(0, 0), b2, voffB); PG8_STAGE(PG8_SB(0, 1), b2 + hstepB, voffB); PG8_STAGE(PG8_SA(0, 0), a2, voffA);
            PG8_WAIT_V(8); PG8_WAIT_L(0); PG8_BAR; PG8_MMA(1, 0, At, B0); PG8_MMA(1, 1, At, B1); PG8_BAR; PG8_SCHED;
            PG8_LDB(B0, 1, 0); PG8_LDB(B1, 1, 1); PG8_SCHED; PG8_LDA(At, 1, 0); PG8_STAGE(PG8_SA(0, 1), a2 + hstepA, voffA);
            PG8_WAIT_V(8); PG8_WAIT_L(0); PG8_BAR; PG8_MMA(0, 0, At, B0); PG8_MMA(0, 1, At, B1); PG8_BAR; PG8_SCHED;
            PG8_LDA(At, 1, 1); PG8_STAGE(PG8_SB(1, 0), b3, voffB); PG8_STAGE(PG8_SB(1, 1), b3 + hstepB, voffB); PG8_STAGE(PG8_SA(1, 0), a3, voffA);
            PG8_WAIT_V(8); PG8_WAIT_L(0); PG8_BAR; PG8_MMA(1, 0, At, B0); PG8_MMA(1, 1, At, B1); PG8_BAR; PG8_SCHED;
        }
        if (wr == 0) PG8_BAR;
        E(acc, cur, wr, wc, fr, fq);
        if (!has_next) break;
#pragma unroll
        for (int a = 0; a < 2; ++a)
#pragma unroll
            for (int b = 0; b < 2; ++b)
#pragma unroll
                for (int m = 0; m < 4; ++m)
#pragma unroll
                    for (int n = 0; n < 2; ++n) acc[a][b][m][n] = (f32x4){0.f, 0.f, 0.f, 0.f};
        cur = nxt; cA = nA; cB = nB; ++ui;
        if (wr == 1) PG8_BAR;
    }
    PG8_WAIT_V(0);
    PG8_BAR;
#undef PG8_SA
#undef PG8_SB
#undef PG8_STAGE
#undef PG8_LDA
#undef PG8_LDB
#undef PG8_MMA
#undef PG8_WAIT_V
#undef PG8_WAIT_L
#undef PG8_BAR
#undef PG8_SCHED
}
}
using pg8::Unit;
typedef const f32x4 (&AccRef)[2][2][4][2];

struct EpiInA {
    static constexpr bool PERM = true, MID = false;
    bf16_t* RX; bf16_t* YO;
    __device__ __forceinline__ void operator()(AccRef acc, const Unit& u, int wr, int wc, int fr, int fq) const {
        const bool isy = u.pn >= 4; bf16_t* base = isy ? YO : RX; const int ldc = isy ? 2048 : 1024;
        const int row0 = u.pm * 256 + wr * 64 + fr, col0 = (u.pn & 3) * 256 + wc * 32 + 8 * fq;
#pragma unroll
        for (int ai = 0; ai < 2; ++ai)
#pragma unroll
            for (int m = 0; m < 4; ++m) { bf16_t* rowp = base + (size_t)(row0 + ai * 128 + m * 16) * ldc + col0;
#pragma unroll
                for (int bj = 0; bj < 2; ++bj) { f32x4 v0 = acc[ai][bj][m][0], v1 = acc[ai][bj][m][1];
                    if (isy) {
#pragma unroll
                        for (int i = 0; i < 4; ++i) { v0[i] = gelu_t(v0[i]); v1[i] = gelu_t(v1[i]); } }
                    *(u32x4*)(rowp + bj * 128) = pack8(v0, v1); } }
    }
};
struct EpiInB {
    static constexpr bool PERM = true, MID = false;
    bf16_t* YO; bf16_t* KVB; bf16_t* MG; float* NG; const float* qn; const float* kn;
    __device__ __forceinline__ void operator()(AccRef acc, const Unit& u, int wr, int wc, int fr, int fq) const {
        const int t = u.pn; const int row0 = u.pm * 256 + wr * 64 + fr;
        if (t < 10) {
            const bool isq = t < 4; const bool nrm = isq || t == 6 || t == 8;
            const float* gw = isq ? qn : (kn + (t == 6 ? 64 : 128));
            const float osc = isq ? QSCALE : 1.f;
            f32x4 gvv[2][2];
#pragma unroll
            for (int bj = 0; bj < 2; ++bj)
#pragma unroll
                for (int n = 0; n < 2; ++n) gvv[bj][n] = nrm ? *(const f32x4*)(gw + 32 * bj + 8 * fq + 4 * n) : (f32x4){1.f, 1.f, 1.f, 1.f};
#pragma unroll
            for (int ai = 0; ai < 2; ++ai)
#pragma unroll
                for (int m = 0; m < 4; ++m) {
                    const int row = row0 + ai * 128 + m * 16;
                    float rinv = 1.f;
                    if (nrm) { float ss = 0.f;
#pragma unroll
                        for (int bj = 0; bj < 2; ++bj)
#pragma unroll
                            for (int n = 0; n < 2; ++n) { const f32x4 x = acc[ai][bj][m][n]; ss += (x[0] * x[0] + x[1] * x[1]) + (x[2] * x[2] + x[3] * x[3]); }
                        ss += __shfl_xor(ss, 16); ss += __shfl_xor(ss, 32);
                        rinv = rsqrtf(ss * (1.f / 64.f) + EPS) * osc; }
                    bf16_t* dst;
                    if (isq) dst = YO + (size_t)row * 2048 + 1024 + (t * 4 + wc) * 64 + 8 * fq;
                    else { const int b = row >> 12, s = row & 4095; dst = KVB + (size_t)(t - 4) * KVBUF + ((size_t)(b * 4 + wc) * 4096 + s) * 64 + 8 * fq; }
#pragma unroll
                    for (int bj = 0; bj < 2; ++bj) { const f32x4 g0 = gvv[bj][0], g1 = gvv[bj][1];
                        const f32x4 v0 = acc[ai][bj][m][0] * rinv * g0, v1 = acc[ai][bj][m][1] * rinv * g1;
                        *(u32x4*)(dst + 32 * bj) = pack8(v0, v1); }
                }
        } else if (t < 18) {
#pragma unroll
            for (int ai = 0; ai < 2; ++ai)
#pragma unroll
                for (int m = 0; m < 4; ++m) { bf16_t* dst = MG + (size_t)(row0 + ai * 128 + m * 16) * 2048 + (t - 10) * 256 + 64 * wc + 8 * fq;
#pragma unroll
                    for (int bj = 0; bj < 2; ++bj) { f32x4 v0 = acc[ai][bj][m][0], v1 = acc[ai][bj][m][1];
#pragma unroll
                        for (int i = 0; i < 4; ++i) { v0[i] = sigm(v0[i]); v1[i] = sigm(v1[i]); }
                        *(u32x4*)(dst + 32 * bj) = pack8(v0, v1); } }
        } else if (wc == 0) {
#pragma unroll
            for (int ai = 0; ai < 2; ++ai)
#pragma unroll
                for (int m = 0; m < 4; ++m) { float* dst = NG + (size_t)(row0 + ai * 128 + m * 16) * 64 + 8 * fq;
#pragma unroll
                    for (int bj = 0; bj < 2; ++bj)
#pragma unroll
                        for (int n = 0; n < 2; ++n) { f32x4 v = acc[ai][bj][m][n];
#pragma unroll
                            for (int i = 0; i < 4; ++i) v[i] = sigm(v[i]);
                            *(f32x4*)(dst + 32 * bj + 4 * n) = v; } }
        }
    }
};
struct EpiGate {
    static constexpr bool PERM = true, MID = false;
    const bf16_t* XR; bf16_t* LA; bf16_t* U; const float* ba; const float* bi; const float* lam;
    __device__ __forceinline__ void operator()(AccRef acc, const Unit& u, int wr, int wc, int fr, int fq) const {
        const int row0 = u.pm * 256 + wr * 64 + fr;
#pragma unroll
        for (int n = 0; n < 2; ++n) {
            const int ch0 = u.pn * 128 + wc * 32 + 8 * fq + 4 * n;
            const f32x4 bav = *(const f32x4*)(ba + ch0), biv = *(const f32x4*)(bi + ch0), spv = *(const f32x4*)(lam + ch0);
#pragma unroll
            for (int ai = 0; ai < 2; ++ai) {
                u32x2 xwv[4];
#pragma unroll
                for (int m = 0; m < 4; ++m) xwv[m] = *(const u32x2*)(XR + (size_t)(row0 + ai * 128 + m * 16) * 1024 + ch0);
#pragma unroll
                for (int m = 0; m < 4; ++m) { const int row = row0 + ai * 128 + m * 16; const bool first = (row & 4095) == 0;
                    const u32x2 xw = xwv[m];
                    const float xv[4] = {bf_lo(xw.x), bf_hi(xw.x), bf_lo(xw.y), bf_hi(xw.y)};
                    float la[4], uu[4];
#pragma unroll
                    for (int i = 0; i < 4; ++i) { const float rp = acc[ai][0][m][n][i] + bav[i], ip = acc[ai][1][m][n][i] + biv[i];
                        const float l2 = sigm(rp) * spv[i];
                        const float a2 = ex2(2.f * l2); float mult = __builtin_amdgcn_sqrtf(fmaxf(1.f - a2, 0.f)); if (first) mult = 1.f;
                        la[i] = l2; uu[i] = mult * sigm(ip) * xv[i]; }
                    u32x2 w0, w1; w0.x = pk_bf16(la[0], la[1]); w0.y = pk_bf16(la[2], la[3]); w1.x = pk_bf16(uu[0], uu[1]); w1.y = pk_bf16(uu[2], uu[3]);
                    *(u32x2*)(LA + (size_t)row * 1024 + ch0) = w0; *(u32x2*)(U + (size_t)row * 1024 + ch0) = w1; } }
        }
    }
};
struct EpiCmp1 {
    static constexpr bool PERM = true, MID = false;
    bf16_t* HID; const float* bias1;
    __device__ __forceinline__ void operator()(AccRef acc, const Unit& u, int wr, int wc, int fr, int fq) const {
        const int which = u.pm >> 5; const int row0 = u.pm * 256 + wr * 64 + fr;
#pragma unroll
        for (int ai = 0; ai < 2; ++ai)
#pragma unroll
            for (int m = 0; m < 4; ++m) { bf16_t* dst = HID + (size_t)(row0 + ai * 128 + m * 16) * 256 + wc * 32 + 8 * fq;
#pragma unroll
                for (int bj = 0; bj < 2; ++bj) { const float* bp = bias1 + which * 256 + bj * 128 + wc * 32 + 8 * fq;
                    f32x4 v0 = acc[ai][bj][m][0] + *(const f32x4*)bp, v1 = acc[ai][bj][m][1] + *(const f32x4*)(bp + 4);
#pragma unroll
                    for (int i = 0; i < 4; ++i) { v0[i] = gelu_t(v0[i]); v1[i] = gelu_t(v1[i]); }
                    *(u32x4*)(dst + bj * 128) = pack8(v0, v1); } }
    }
};
template <int ADD> struct EpiMix {
    static constexpr bool PERM = true, MID = false;
    bf16_t* MB; const bf16_t* MG; int sel;
    __device__ __forceinline__ void operator()(AccRef acc, const Unit& u, int wr, int wc, int fr, int fq) const {
        const int row0 = u.pm * 256 + wr * 64 + fr, col0 = u.pn * 256 + wc * 32 + 8 * fq;
#pragma unroll
        for (int ai = 0; ai < 2; ++ai)
#pragma unroll
            for (int mp = 0; mp < 2; ++mp) {
                u32x4 gwv[2][2], owv[2][2];
#pragma unroll
                for (int mm = 0; mm < 2; ++mm)
#pragma unroll
                    for (int bj = 0; bj < 2; ++bj) { const int row = row0 + ai * 128 + (2 * mp + mm) * 16, col = col0 + bj * 128;
                        gwv[mm][bj] = *(const u32x4*)(MG + (size_t)row * 2048 + sel * 1024 + col);
                        owv[mm][bj] = ADD ? *(const u32x4*)(MB + (size_t)row * 1024 + col) : (u32x4){0u, 0u, 0u, 0u}; }
#pragma unroll
                for (int mm = 0; mm < 2; ++mm)
#pragma unroll
                    for (int bj = 0; bj < 2; ++bj) { const int row = row0 + ai * 128 + (2 * mp + mm) * 16, col = col0 + bj * 128; const u32x4 gw = gwv[mm][bj], ow = owv[mm][bj];
                        f32x4 v0 = acc[ai][bj][2 * mp + mm][0], v1 = acc[ai][bj][2 * mp + mm][1];
                        v0[0] *= bf_lo(gw.x); v0[1] *= bf_hi(gw.x); v0[2] *= bf_lo(gw.y); v0[3] *= bf_hi(gw.y);
                        v1[0] *= bf_lo(gw.z); v1[1] *= bf_hi(gw.z); v1[2] *= bf_lo(gw.w); v1[3] *= bf_hi(gw.w);
                        if (ADD) { v0[0] += bf_lo(ow.x); v0[1] += bf_hi(ow.x); v0[2] += bf_lo(ow.y); v0[3] += bf_hi(ow.y);
                            v1[0] += bf_lo(ow.z); v1[1] += bf_hi(ow.z); v1[2] += bf_lo(ow.w); v1[3] += bf_hi(ow.w); }
                        *(u32x4*)(MB + (size_t)row * 1024 + col) = pack8(v0, v1); } }
    }
};
struct EpiMixM {
    static constexpr bool PERM = true, MID = true;
    bf16_t* MB; const bf16_t* MG;
    __device__ __forceinline__ void mid(f32x4 (&acc)[2][2][4][2], const Unit& u, int wr, int wc, int fr, int fq) const {
        int row0 = u.pm * 256 + wr * 64 + fr, col0 = u.pn * 256 + wc * 32 + 8 * fq; asm volatile("" : "+v"(row0), "+v"(col0));
#pragma unroll
        for (int ai = 0; ai < 2; ++ai)
#pragma unroll
            for (int m = 0; m < 4; ++m)
#pragma unroll
                for (int bj = 0; bj < 2; ++bj) { const bf16_t* gp = MG + (size_t)(row0 + ai * 128 + m * 16) * 2048 + col0 + bj * 128;
                    const u32x4 g0 = *(const u32x4*)gp, g1 = *(const u32x4*)(gp + 1024);
                    f32x4 r0, r1;
                    r0[0] = bf_lo(g0.x) * __builtin_amdgcn_rcpf(bf_lo(g1.x)); r0[1] = bf_hi(g0.x) * __builtin_amdgcn_rcpf(bf_hi(g1.x)); r0[2] = bf_lo(g0.y) * __builtin_amdgcn_rcpf(bf_lo(g1.y)); r0[3] = bf_hi(g0.y) * __builtin_amdgcn_rcpf(bf_hi(g1.y));
                    r1[0] = bf_lo(g0.z) * __builtin_amdgcn_rcpf(bf_lo(g1.z)); r1[1] = bf_hi(g0.z) * __builtin_amdgcn_rcpf(bf_hi(g1.z)); r1[2] = bf_lo(g0.w) * __builtin_amdgcn_rcpf(bf_lo(g1.w)); r1[3] = bf_hi(g0.w) * __builtin_amdgcn_rcpf(bf_hi(g1.w));
                    acc[ai][bj][m][0] *= r0; acc[ai][bj][m][1] *= r1; }
    }
    __device__ __forceinline__ void operator()(AccRef acc, const Unit& u, int wr, int wc, int fr, int fq) const {
        const int row0 = u.pm * 256 + wr * 64 + fr, col0 = u.pn * 256 + wc * 32 + 8 * fq;
#pragma unroll
        for (int ai = 0; ai < 2; ++ai) {
            u32x4 gwv[4][2];
#pragma unroll
            for (int m = 0; m < 4; ++m)
#pragma unroll
                for (int bj = 0; bj < 2; ++bj) gwv[m][bj] = *(const u32x4*)(MG + (size_t)(row0 + ai * 128 + m * 16) * 2048 + 1024 + col0 + bj * 128);
#pragma unroll
            for (int m = 0; m < 4; ++m)
#pragma unroll
                for (int bj = 0; bj < 2; ++bj) { const int row = row0 + ai * 128 + m * 16, col = col0 + bj * 128; const u32x4 gw = gwv[m][bj];
                    f32x4 v0 = acc[ai][bj][m][0], v1 = acc[ai][bj][m][1];
                    v0[0] *= bf_lo(gw.x); v0[1] *= bf_hi(gw.x); v0[2] *= bf_lo(gw.y); v0[3] *= bf_hi(gw.y);
                    v1[0] *= bf_lo(gw.z); v1[1] *= bf_hi(gw.z); v1[2] *= bf_lo(gw.w); v1[3] *= bf_hi(gw.w);
                    *(u32x4*)(MB + (size_t)row * 1024 + col) = pack8(v0, v1); } }
    }
};
struct EpiRes {
    static constexpr bool PERM = false, MID = false;
    const float* base; float* out;
    __device__ __forceinline__ void operator()(AccRef acc, const Unit& u, int wr, int wc, int fr, int fq) const {
        const int row0 = u.pm * 256 + wr * 64 + fr, col0 = u.pn * 256 + wc * 32 + 4 * fq;
#pragma unroll
        for (int ai = 0; ai < 2; ++ai)
#pragma unroll
            for (int mp = 0; mp < 2; ++mp) {
                f32x4 bs[2][2][2];
#pragma unroll
                for (int mm = 0; mm < 2; ++mm) { const size_t off = (size_t)(row0 + ai * 128 + (2 * mp + mm) * 16) * 1024 + col0;
#pragma unroll
                    for (int bj = 0; bj < 2; ++bj)
#pragma unroll
                        for (int n = 0; n < 2; ++n) bs[mm][bj][n] = *(const f32x4*)(base + off + bj * 128 + n * 16); }
#pragma unroll
                for (int mm = 0; mm < 2; ++mm) { const size_t off = (size_t)(row0 + ai * 128 + (2 * mp + mm) * 16) * 1024 + col0;
#pragma unroll
                    for (int bj = 0; bj < 2; ++bj)
#pragma unroll
                        for (int n = 0; n < 2; ++n) *(f32x4*)(out + off + bj * 128 + n * 16) = bs[mm][bj][n] + acc[ai][bj][2 * mp + mm][n]; } }
    }
};
struct EpiSwi {
    static constexpr bool PERM = true, MID = false;
    bf16_t* ACT;
    __device__ __forceinline__ void operator()(AccRef acc, const Unit& u, int wr, int wc, int fr, int fq) const {
        const int row0 = u.pm * 256 + wr * 64 + fr, ch0 = u.pn * 128 + wc * 32 + 8 * fq;
#pragma unroll
        for (int ai = 0; ai < 2; ++ai)
#pragma unroll
            for (int m = 0; m < 4; ++m) { f32x4 v0, v1;
#pragma unroll
                for (int i = 0; i < 4; ++i) { const float g0 = acc[ai][0][m][0][i], g1 = acc[ai][0][m][1][i];
                    v0[i] = g0 * sigm(g0) * acc[ai][1][m][0][i]; v1[i] = g1 * sigm(g1) * acc[ai][1][m][1][i]; }
                *(u32x4*)(ACT + (size_t)(row0 + ai * 128 + m * 16) * D_FF + ch0) = pack8(v0, v1); }
    }
};

__device__ __forceinline__ void xpose_item(const float* W, int Ns, int col0, int valid, bf16_t* dst, int K, int k0, LAS float* scr, int lane) {
#pragma unroll
    for (int i = 0; i < 32; ++i) { const int kk = 2 * i + (lane >> 5), n = lane & 31; scr[kk * 33 + n] = (n < valid) ? W[(size_t)(k0 + kk) * Ns + col0 + n] : 0.f; }
    asm volatile("s_waitcnt lgkmcnt(0)" ::: "memory");
    const int c = lane & 7;
#pragma unroll
    for (int j = 0; j < 4; ++j) { const int n = (lane >> 3) + 8 * j; const LAS float* s = scr + (8 * c) * 33 + n;
        u32x4 o; o.x = pk_bf16(s[0 * 33], s[1 * 33]); o.y = pk_bf16(s[2 * 33], s[3 * 33]); o.z = pk_bf16(s[4 * 33], s[5 * 33]); o.w = pk_bf16(s[6 * 33], s[7 * 33]);
        *(u32x4*)(dst + (size_t)n * K + k0 + 8 * c) = o; }
    asm volatile("s_waitcnt lgkmcnt(0)" ::: "memory");
}

struct Args { const float* in[25]; float* out; unsigned char* ws; int ph_lo, ph_hi; };
__device__ __forceinline__ unsigned char* opq(unsigned char* p);

__device__ __forceinline__ void weights_phase(const Args& a, int l, LAS unsigned char* lds, int gw, int ngw, int wave, int lane) {
    LAS float* scr = (LAS float*)(lds + wave * 16384);
    bf16_t* Wb = (bf16_t*)(opq(a.ws) + WS_W);
    const float* w_in = a.in[2] + (size_t)l * 1024 * D_IN;
    constexpr int I1 = 16 * 64, I2 = 16 * 152, I3 = 4 * 64, I4 = 32 * 16, I5 = 16 * 32, I6 = 16 * 176, I7 = 44 * 32;
    constexpr int NIT = I1 + I2 + I3 + I4 + 3 * I5 + I6 + I7;
    for (int it = gw; it < NIT; it += ngw) {
        int r = it;
        if (r < I1) { const int kb = r / 64, gi = r % 64; xpose_item(w_in, D_IN, 32 * gi, 32, Wb + W_INA / 2 + (size_t)(32 * gi) * 1024, 1024, 64 * kb, scr, lane); continue; } r -= I1;
        if (r < I2) { const int kb = r / 152, gi = r % 152; const int t = gi >> 3, gl = gi & 7, ca = 64 * (gl & 3) + 32 * (gl >> 2);
            int col0, valid = 32;
            if (t < 10) col0 = 2048 + 256 * t + ca; else if (t < 18) col0 = 4656 + 256 * (t - 10) + ca; else { col0 = 4608 + ca; valid = 48 - ca; valid = valid < 0 ? 0 : (valid > 32 ? 32 : valid); }
            xpose_item(w_in, D_IN, col0, valid, Wb + W_INB / 2 + (size_t)(32 * gi) * 1024, 1024, 64 * kb, scr, lane); continue; } r -= I2;
        if (r < I3) { const int kb = r / 64, gi = r % 64; const int pn = gi >> 3, gl = gi & 7, bj = gl >> 2, ch = 128 * pn + 32 * (gl & 3);
            const float* W = (bj ? a.in[7] : a.in[5]) + (size_t)l * 4 * 65536 + (size_t)(ch >> 8) * 65536;
            xpose_item(W, 256, ch & 255, 32, Wb + W_G / 2 + (size_t)(32 * gi) * 256, 256, 64 * kb, scr, lane); continue; } r -= I3;
        if (r < I4) { const int kb = r / 16, gi = r % 16; const float* W = ((gi >> 3) ? a.in[16] : a.in[14]) + (size_t)l * 2048 * 256;
            xpose_item(W, 256, 32 * (gi & 7), 32, Wb + W_C1 / 2 + (size_t)(32 * gi) * 2048, 2048, 64 * kb, scr, lane); continue; } r -= I4;
        if (r < 3 * I5) { const int which = r / I5; r -= which * I5; const int kb = r / 32, gi = r % 32;
            const float* W = a.in[18 + which] + (size_t)l * 1024 * 1024;
            if (which < 2) xpose_item(W, 1024, 32 * gi, 32, Wb + W_YA / 2 + (size_t)(32 * gi) * 2048 + which * 1024, 2048, 64 * kb, scr, lane);
            else xpose_item(W, 1024, 32 * gi, 32, Wb + W_O / 2 + (size_t)(32 * gi) * 1024, 1024, 64 * kb, scr, lane);
            continue; } r -= 3 * I5;
        if (r < I6) { const int kb = r / 176, gi = r % 176; const int pn = gi >> 3, gl = gi & 7, bj = gl >> 2;
            const float* W = (bj ? a.in[23] : a.in[22]) + (size_t)l * 1024 * D_FF;
            xpose_item(W, D_FF, 128 * pn + 32 * (gl & 3), 32, Wb + W_GU / 2 + (size_t)(32 * gi) * 1024, 1024, 64 * kb, scr, lane); continue; } r -= I6;
        { const int kb = r / 32, gi = r % 32; const float* W = a.in[24] + (size_t)l * D_FF * 1024;
            xpose_item(W, 1024, 32 * gi, 32, Wb + W_D / 2 + (size_t)(32 * gi) * D_FF, D_FF, 64 * kb, scr, lane); }
    }
}

__device__ __forceinline__ void rms_phase(const float* x, const float* g, bf16_t* out, int gw, int ngw, int lane) {
    f32x4 gv[4];
#pragma unroll
    for (int j = 0; j < 4; ++j) gv[j] = ((const f32x4*)g)[lane + 64 * j];
    for (int m0 = gw; m0 < MTOK; m0 += 4 * ngw) {
        f32x4 v[4][4];
#pragma unroll
        for (int e = 0; e < 4; ++e) { const int m = m0 + e * ngw; const f32x4* xr = (const f32x4*)(x + (size_t)(m < MTOK ? m : m0) * 1024) + lane;
#pragma unroll
            for (int j = 0; j < 4; ++j) v[e][j] = xr[64 * j]; }
#pragma unroll
        for (int e = 0; e < 4; ++e) { const int m = m0 + e * ngw; float s = 0.f;
#pragma unroll
            for (int j = 0; j < 4; ++j) s += (v[e][j][0] * v[e][j][0] + v[e][j][1] * v[e][j][1]) + (v[e][j][2] * v[e][j][2] + v[e][j][3] * v[e][j][3]);
            const float rinv = rsqrtf(wave_sum(s) * (1.f / 1024.f) + EPS);
            if (m < MTOK) { u32x2* o8 = (u32x2*)(out + (size_t)m * 1024) + lane;
#pragma unroll
                for (int j = 0; j < 4; ++j) { u32x2 w; w.x = pk_bf16(v[e][j][0] * rinv * gv[j][0], v[e][j][1] * rinv * gv[j][1]); w.y = pk_bf16(v[e][j][2] * rinv * gv[j][2], v[e][j][3] * rinv * gv[j][3]); o8[64 * j] = w; } } }
    }
}

namespace att {
constexpr int NST = 5, DEPTH_INFLIGHT = 4;
constexpr int STAGE = 16384;
constexpr int OFF_WS = NST * STAGE, WS_PER_WAVE = 8192 + 256;
__device__ __forceinline__ int crow(int r, int hi) { return (r & 3) + 8 * (r >> 2) + 4 * hi; }
__device__ __forceinline__ s16x4 vtr(const LAS unsigned char* p) { typedef short v4i16_t __attribute__((ext_vector_type(4))); return __builtin_bit_cast(s16x4, __builtin_amdgcn_ds_read_tr16_b64_v4i16((LAS v4i16_t*)p)); }

__device__ __forceinline__ void job_decode(int j, int nct, int qi, int kt0, int& type, int& tile) {
    if (j < nct) { type = 1; tile = j; } else if (j < nct + qi + 1) { type = 2; tile = j - nct; } else { type = 3; tile = kt0 + (j - nct - qi - 1); }
}

__device__ __forceinline__ void attn_phase(LAS unsigned char* lds, const bf16_t* KVB, const bf16_t* KC, const bf16_t* VC, const bf16_t* YO, bf16_t* OUT, int ldo, const float* NG, const float* qn, const float* kn) {
    const int tid = tid_opq(), lane = tid & 63, w = __builtin_amdgcn_readfirstlane(tid >> 6), q = lane & 31, hi = lane >> 5, hh = q >> 3, tl = q & 7;
    LAS float* impw = (LAS float*)(lds + OFF_WS + w * WS_PER_WAVE);
    LAS float* rs = impw + 2048;
    LAS float* rs2 = rs + 32;
    const float gq = wave_max(fabsf(qn[lane]));
    const float nB0 = -8.5f * LOG2E * gq * wave_max(fabsf(kn[lane]));
    const float nB1 = -8.5f * LOG2E * gq * wave_max(fabsf(kn[64 + lane]));
    const float nB2 = -8.5f * LOG2E * gq * wave_max(fabsf(kn[128 + lane]));
    const int G = gd_opq(), bx = bx_opq();
    const int drow = 8 * w + (lane >> 3), dsl = lane & 7;
    const unsigned dkoff = (unsigned)(drow * 128 + ((dsl ^ ((drow >> 1) & 7)) * 16));
    const unsigned dvoff = (unsigned)(drow * 128 + ((dsl ^ (4 * ((drow >> 1) & 1))) * 16));
    const unsigned ldsw = (unsigned)w * 1024u;
    const int kfx = (q >> 1) & 7;
    const int qrow = (lane & 15) >> 2, pcol = lane & 3, cgp = (lane >> 4) & 1, fbit = (qrow >> 1) & 1;
    const int vbase = (4 * hi + qrow) * 128 + (2 * cgp + (pcol >> 1)) * 16 + 8 * (pcol & 1);
    const int vb0 = vbase + fbit * 64, vb1 = vbase + (fbit ^ 1) * 64;
#define ATT_WAIT_BAR(N) asm volatile("s_waitcnt vmcnt(" #N ") lgkmcnt(0)\n\ts_barrier" ::: "memory")
    for (int it = 0;; ++it) {
        int qi, bg;
        if (G == 256) { if (it >= 8) break; const int r = bx >> 5; qi = 8 * (7 - it) + ((it & 1) ? r : 7 - r); bg = bx & 31; }
        else { const int idx = it * G + bx; if (idx >= 2048) break; qi = 63 - (idx >> 5); bg = idx & 31; }
        const int b = bg >> 2, g = bg & 3;
        const int tt = w * 8 + tl, tq = qi * 64 + tt;
        const size_t row = (size_t)b * 4096 + tq;
        const int head = g * 4 + hh;
        bf16x8 qf[4];
#pragma unroll
        for (int d0 = 0; d0 < 4; ++d0) qf[d0] = *(const bf16x8*)(YO + row * 2048 + 1024 + head * 64 + 16 * d0 + 8 * hi);
        const int cmaxq = (tq - 31) >> 4;
        const int nct = (4 * qi + 2) / 64 + 1;
        const int nw = (qi < 8 ? qi : 8) + 1, kt0 = qi - (nw - 1);
        const int NJ = nct + (qi + 1) + nw;
        const char* kcb = (const char*)(KC + (size_t)bg * 256 * 64); const char* vcb = (const char*)(VC + (size_t)bg * 256 * 64);
        const char* ksb = (const char*)(KVB + 2 * KVBUF + (size_t)bg * 4096 * 64); const char* vsb = (const char*)(KVB + 3 * KVBUF + (size_t)bg * 4096 * 64);
        const char* kwb = (const char*)(KVB + 4 * KVBUF + (size_t)bg * 4096 * 64); const char* vwb = (const char*)(KVB + 5 * KVBUF + (size_t)bg * 4096 * 64);
#define ATT_ISSUE(j_, st_) do { int ty_, tile_; job_decode((j_) < NJ ? (j_) : NJ - 1, nct, qi, kt0, ty_, tile_); \
            const char* kp_ = (ty_ < 2 ? kcb : (ty_ == 2 ? ksb : kwb)) + (size_t)tile_ * 8192; const char* vp_ = (ty_ < 2 ? vcb : (ty_ == 2 ? vsb : vwb)) + (size_t)tile_ * 8192; \
            __builtin_amdgcn_global_load_lds((const unsigned*)(kp_ + dkoff), (LAS unsigned*)(lds + (st_) * STAGE + ldsw), 16, 0, 0); \
            __builtin_amdgcn_global_load_lds((const unsigned*)(vp_ + dvoff), (LAS unsigned*)(lds + (st_) * STAGE + 8192 + ldsw), 16, 0, 0); } while (0)
        ATT_ISSUE(0, 0); ATT_ISSUE(1, 1); ATT_ISSUE(2, 2);
        f32x16 ofin[2], ocur[2];
#pragma unroll
        for (int r = 0; r < 16; ++r) { ofin[0][r] = 0.f; ofin[1][r] = 0.f; ocur[0][r] = 0.f; ocur[1][r] = 0.f; }
        float lsum = 0.f, carry = 0.f;
        unsigned long long mymask = (2ull << qi) - 1ull, unionmask = mymask;
        int st_cur = 0, st_iss = 3;
        for (int jp = 0; jp < NJ; jp += 2) {
            ATT_WAIT_BAR(2);
            ATT_ISSUE(jp + 3, st_iss); st_iss = (st_iss == NST - 1) ? 0 : st_iss + 1;
            ATT_ISSUE(jp + 4, st_iss); st_iss = (st_iss == NST - 1) ? 0 : st_iss + 1;
          for (int half = 0; half < 2; ++half) {
            const int j = jp + half; if (j >= NJ) break;
            int type, tile; job_decode(j, nct, qi, kt0, type, tile);
            const LAS unsigned char* Kb = lds + st_cur * STAGE;
            const LAS unsigned char* Vb = Kb + 8192;
            st_cur = (st_cur == NST - 1) ? 0 : st_cur + 1;
            const bool skip = (type == 2) && (((unionmask >> tile) & 1ull) == 0ull);
            if (!skip) {
                const float nbT = type < 2 ? nB0 : (type == 2 ? nB1 : nB2);
                const unsigned long long msel = (type == 2) ? mymask : ~0ull;
                const float rowsel = (float)(unsigned)((msel >> tile) & 1ull);
                const float nB = fmaf(rowsel, nbT, fmaf(rowsel, 30000.f, -30000.f));
                f32x16 p0, p1, cin;
#pragma unroll
                for (int r = 0; r < 16; ++r) cin[r] = nB;
#define ATT_QK2() do { \
                p0 = __builtin_amdgcn_mfma_f32_32x32x16_bf16(*(const LAS bf16x8*)(Kb + q * 128 + (hi ^ kfx) * 16), qf[0], cin, 0, 0, 0); \
                _Pragma("unroll") for (int d0 = 1; d0 < 4; ++d0) p0 = __builtin_amdgcn_mfma_f32_32x32x16_bf16(*(const LAS bf16x8*)(Kb + q * 128 + ((2 * d0 + hi) ^ kfx) * 16), qf[d0], p0, 0, 0, 0); \
                p1 = __builtin_amdgcn_mfma_f32_32x32x16_bf16(*(const LAS bf16x8*)(Kb + (32 + q) * 128 + (hi ^ kfx) * 16), qf[0], cin, 0, 0, 0); \
                _Pragma("unroll") for (int d0 = 1; d0 < 4; ++d0) p1 = __builtin_amdgcn_mfma_f32_32x32x16_bf16(*(const LAS bf16x8*)(Kb + (32 + q) * 128 + ((2 * d0 + hi) ^ kfx) * 16), qf[d0], p1, 0, 0, 0); } while (0)
#define ATT_PV2() do { _Pragma("unroll") for (int s = 0; s < 4; ++s) { u32x4 pw; \
                    if (s < 2) { pw.x = pk_bf16(p0[8 * s], p0[8 * s + 1]); pw.y = pk_bf16(p0[8 * s + 2], p0[8 * s + 3]); pw.z = pk_bf16(p0[8 * s + 4], p0[8 * s + 5]); pw.w = pk_bf16(p0[8 * s + 6], p0[8 * s + 7]); } \
                    else { const int s2 = s - 2; pw.x = pk_bf16(p1[8 * s2], p1[8 * s2 + 1]); pw.y = pk_bf16(p1[8 * s2 + 2], p1[8 * s2 + 3]); pw.z = pk_bf16(p1[8 * s2 + 4], p1[8 * s2 + 5]); pw.w = pk_bf16(p1[8 * s2 + 6], p1[8 * s2 + 7]); } \
                    const bf16x8 pa = __builtin_bit_cast(bf16x8, pw); \
                    { const s16x4 vlo = vtr(Vb + s * 2048 + vb0), vhi = vtr(Vb + s * 2048 + 1024 + vb0); \
                      const bf16x8 vf = (bf16x8){vlo[0], vlo[1], vlo[2], vlo[3], vhi[0], vhi[1], vhi[2], vhi[3]}; ocur[0] = __builtin_amdgcn_mfma_f32_32x32x16_bf16(pa, vf, ocur[0], 0, 0, 0); } \
                    { const s16x4 vlo = vtr(Vb + s * 2048 + vb1), vhi = vtr(Vb + s * 2048 + 1024 + vb1); \
                      const bf16x8 vf = (bf16x8){vlo[0], vlo[1], vlo[2], vlo[3], vhi[0], vhi[1], vhi[2], vhi[3]}; ocur[1] = __builtin_amdgcn_mfma_f32_32x32x16_bf16(pa, vf, ocur[1], 0, 0, 0); } } } while (0)
                const bool interior = (type == 2 && tile < qi) || (type == 3 && tile > qi - 8 && tile < qi);
                if (interior) {
                    ATT_QK2();
                    float ps = 0.f, ps1 = 0.f;
#pragma unroll
                    for (int r = 0; r < 16; ++r) { p0[r] = ex2(p0[r]); ps += p0[r]; }
#pragma unroll
                    for (int r = 0; r < 16; ++r) { p1[r] = ex2(p1[r]); ps1 += p1[r]; }
                    lsum += ps + ps1;
                    ATT_PV2();
                } else {
                    ATT_QK2();
                    int lo = 0, hiq = 63;
                    if (type < 2) hiq = cmaxq - 64 * tile;
                    else if (type == 2) { if (tile == qi) hiq = tt; }
                    else { if (tile == qi - 8) lo = tt + 1; if (tile == qi) hiq = tt; }
                    float ps = 0.f;
#pragma unroll
                    for (int r = 0; r < 16; ++r) { const int k0i = crow(r, hi), k1i = k0i + 32;
                        p0[r] = (k0i >= lo && k0i <= hiq) ? ex2(p0[r]) : 0.f; p1[r] = (k1i >= lo && k1i <= hiq) ? ex2(p1[r]) : 0.f; ps += p0[r] + p1[r]; }
                    lsum += ps;
                    if (type == 1 && qi >= 16) {
                        float s4[8], b3[8], pb[8];
#pragma unroll
                        for (int a = 0; a < 4; ++a) { s4[a] = (p0[4 * a] + p0[4 * a + 1]) + (p0[4 * a + 2] + p0[4 * a + 3]); b3[a] = p0[4 * a + 3];
                            s4[4 + a] = (p1[4 * a] + p1[4 * a + 1]) + (p1[4 * a + 2] + p1[4 * a + 3]); b3[4 + a] = p1[4 * a + 3]; }
#pragma unroll
                        for (int x = 0; x < 8; ++x) pb[x] = __shfl_xor(b3[x], 32);
#pragma unroll
                        for (int x = 0; x < 8; ++x) { const float extra = hi ? pb[x] : (x == 0 ? carry : pb[x == 0 ? 0 : x - 1]);
                            const int n = 16 * tile + 2 * (x & 3) + hi + 8 * (x >> 2);
                            impw[q * 64 + n] = s4[x] + extra; }
                        carry = pb[7];
                    }
                    ATT_PV2();
                }
#undef ATT_QK2
#undef ATT_PV2
            }
            const bool end_c2 = (type == 1 && tile == nct - 1), end_s = (type == 2 && tile == qi), end_w = (type == 3 && tile == qi);
            if (end_c2 || end_s || end_w) {
                const float l = lsum + __shfl_xor(lsum, 32);
                const float gt_ = NG[row * 64 + (end_c2 ? 0 : (end_s ? 16 : 32)) + head];
                const float linv = l > 0.f ? 1.f / l : 0.f;
                const float sc = gt_ * linv;
                if (hi == 0) { rs[q] = sc; if (end_c2) rs2[q] = linv; }
#pragma unroll
                for (int r = 0; r < 16; ++r) { const float f = rs[crow(r, hi)]; ofin[0][r] += f * ocur[0][r]; ofin[1][r] += f * ocur[1][r]; ocur[0][r] = 0.f; ocur[1][r] = 0.f; }
                lsum = 0.f;
            }
            if (end_c2 && qi >= 16) {
                unionmask = 0ull; mymask = 0ull;
                for (int i = 0; i < 8; ++i) {
                    const int n = lane; const bool valid = n <= qi, forced = (n == 0) || (n == qi) || (n == qi - 1);
                    const float sc = forced ? 1e6f : (impw[i * 64 + n] * rs2[i] + impw[(8 + i) * 64 + n] * rs2[8 + i]) + (impw[(16 + i) * 64 + n] * rs2[16 + i] + impw[(24 + i) * 64 + n] * rs2[24 + i]);
                    const unsigned key = valid ? ((__float_as_uint(sc) & ~63u) | (unsigned)(63 - n)) : 0u;
                    unsigned T = 0u;
#pragma unroll
                    for (int bit = 30; bit >= 0; --bit) { const unsigned cand = T | (1u << bit); const unsigned long long bm = __ballot(key >= cand); if (__popcll(bm) >= 16) T = cand; }
                    const unsigned long long mk = __ballot(valid && key >= T);
                    unionmask |= mk; if (tl == i) mymask = mk;
                }
            }
          }
        }
#pragma unroll
        for (int r = 0; r < 16; ++r) { const int qq = crow(r, hi); const size_t orow = (size_t)b * 4096 + qi * 64 + w * 8 + (qq & 7);
            bf16_t* op = OUT + orow * ldo + (g * 4 + (qq >> 3)) * 64 + q;
            op[0] = (bf16_t)(pk_bf16(ofin[0][r], 0.f) & 0xffffu); op[32] = (bf16_t)(pk_bf16(ofin[1][r], 0.f) & 0xffffu); }
        ATT_WAIT_BAR(0);
#undef ATT_ISSUE
    }
#undef ATT_WAIT_BAR
}
}


#define XB_TMO      128
#define XB_XCNT(j)  (256  + 64 * (j))
#define XB_XSUB(j)  (1280 + 64 * (j))
#define XB_XGEN(j)  (2304 + 64 * (j))
#define XB_TOP      3328
#define XB_TOPGEN   3392
#define XCD_BAR_WORDS 3456
#define XB_SPIN_CAP (1u << 22)
__device__ __forceinline__ unsigned xb_ld(unsigned* p)              { return __hip_atomic_load(p, __ATOMIC_RELAXED, __HIP_MEMORY_SCOPE_AGENT); }
__device__ __forceinline__ unsigned xb_add(unsigned* p, unsigned v) { return __hip_atomic_fetch_add(p, v, __ATOMIC_RELAXED, __HIP_MEMORY_SCOPE_AGENT); }
__device__ __forceinline__ unsigned xb_xcc_id() { return (unsigned)__builtin_amdgcn_s_getreg((3 << 11) | 20) & 0xFu; }
#define XB_SPIN(cond, bar) do { unsigned _sp = 0; while (cond) { __builtin_amdgcn_s_sleep(1); \
    if ((++_sp & 255u) == 0u) { if (xb_ld(&(bar)[XB_TMO])) break; if (_sp > XB_SPIN_CAP) { atomicAdd(&(bar)[XB_TMO], 1u); break; } } } } while (0)
struct XcdBarrier { unsigned* bar; unsigned x; volatile LAS unsigned* st; };
__device__ __forceinline__ void xcd_barrier_complete(unsigned* bar, unsigned x, unsigned& nloc, unsigned& nx) {
    const unsigned G = gridDim.x * gridDim.y * gridDim.z;
    unsigned sum, cnt, mine, sp = 0u;
    for (;;) {
        sum = 0u; cnt = 0u; mine = 0u;
#pragma unroll
        for (unsigned j = 0; j < 16; ++j) { const unsigned c = xb_ld(&bar[XB_XCNT(j)]); sum += c; cnt += (c > 0u) ? 1u : 0u; mine = (j == x) ? c : mine; }
        if (sum == G) break;
        __builtin_amdgcn_s_sleep(1);
        if ((++sp & 255u) == 0u) { if (xb_ld(&bar[XB_TMO])) break; if (sp > XB_SPIN_CAP) { atomicAdd(&bar[XB_TMO], 1u); break; } }
    }
    nloc = mine > 0u ? mine : 1u; nx = cnt > 0u ? cnt : 1u;
}
__device__ __forceinline__ void xcd_barrier(unsigned* bar, volatile LAS unsigned* st) {
    asm volatile("s_waitcnt vmcnt(0)" ::: "memory");
    __syncthreads();
    if (threadIdx.x == 0) {
        const unsigned x = xb_xcc_id();
        __builtin_amdgcn_s_waitcnt(0);
        unsigned nloc = st[0], nx = st[1];
        if (nloc == 0u) { xcd_barrier_complete(bar, x, nloc, nx); st[0] = nloc; st[1] = nx; }
        const unsigned old = xb_add(&bar[XB_XSUB(x)], 1u);
        const unsigned gen = old / nloc;
        if (old + 1u == (gen + 1u) * nloc) {
            __builtin_amdgcn_fence(__ATOMIC_RELEASE, "agent");
            asm volatile("s_waitcnt vmcnt(0)" ::: "memory");
            const unsigned og = xb_add(&bar[XB_TOP], 1u);
            const unsigned tg = og / nx;
            if (og + 1u == (tg + 1u) * nx) xb_add(&bar[XB_TOPGEN], 1u);
            else XB_SPIN(xb_ld(&bar[XB_TOPGEN]) == tg, bar);
            __builtin_amdgcn_fence(__ATOMIC_ACQUIRE, "agent");
            xb_add(&bar[XB_XGEN(x)], 1u);
            asm volatile("s_waitcnt vmcnt(0)" ::: "memory");
        } else {
            XB_SPIN(xb_ld(&bar[XB_XGEN(x)]) == gen, bar);
            __builtin_amdgcn_fence(__ATOMIC_ACQUIRE, "agent");
            asm volatile("s_waitcnt vmcnt(0)" ::: "memory");
        }
    }
    __syncthreads();
}

constexpr int LDS_BYTES = 155648;
constexpr int NPH = 16;

__device__ __forceinline__ unsigned char* opq(unsigned char* p) { asm volatile("" : "+s"(p)); return p; }
#define WSP(off) ((bf16_t*)(opq(a.ws) + (off)))
#define WSF(off) ((float*)(opq(a.ws) + (off)))

__global__ void __launch_bounds__(512, 2) mega(Args a) {
    extern __shared__ __attribute__((aligned(16))) unsigned char lds_raw[];
    LAS unsigned char* lds = (LAS unsigned char*)lds_raw;
    cg::grid_group grid = cg::this_grid();
    const int lo = a.ph_lo, hi = a.ph_hi;
    volatile LAS unsigned* xst = (volatile LAS unsigned*)(lds + 155648 - 64);
    if (threadIdx.x == 0) { xst[0] = 0u; xst[1] = 0u; if (hi - lo > 1) (void)xb_add(&((unsigned*)(a.ws + WS_BAR))[XB_XCNT(xb_xcc_id())], 1u); }
    __syncthreads();
#define IDS const int tid = tid_opq(), lane = tid & 63, wave = __builtin_amdgcn_readfirstlane(tid >> 6); const int G = gd_opq(), bx = bx_opq(); \
    const int gw = bx * 8 + wave, ngw = G * 8, gt = bx * 512 + tid, ngt = G * 512; (void)lane; (void)gw; (void)ngw; (void)gt; (void)ngt;
#define IN(k) (lo <= (l * NPH + (k)) && (l * NPH + (k)) < hi)
#define SEAM(k) do { if (lo <= (l * NPH + (k)) && (l * NPH + (k)) + 1 < hi) { if (hi < 0) grid.sync(); xcd_barrier((unsigned*)(opq(a.ws) + WS_BAR), xst); if (PROBE_SYNC2) xcd_barrier((unsigned*)(opq(a.ws) + WS_BAR), xst); } } while (0)
    for (int l = 0; l < DEPTH; ++l) {
        for (int rep_ = 0; rep_ < ((PROBE_DUP >> 0) & 1) + 1; ++rep_) if (IN(0)) {
            IDS
            weights_phase(a, l, lds, gw, ngw, wave, lane);
            rms_phase((l == 0) ? a.in[0] : a.out, a.in[1] + l * 1024, WSP(WS_H), gw, ngw, lane);
        }
        SEAM(0);
        for (int rep_ = 0; rep_ < ((PROBE_DUP >> 1) & 1) + 1; ++rep_) if (IN(1)) {
            pg8::StaticOrder S; pg8::Gemm g{WSP(WS_H), WSP(WS_W + W_INA), MTOK, 2048, 1024, 1024, 0, 0}; S.init(MTOK, 2048, gd_opq(), bx_opq());
            EpiInA E{WSP(WS_RX), WSP(WS_YO)}; pg8::gemm_phase<EpiInA>(lds, g, S, E);
        }
        SEAM(1);
        for (int rep_ = 0; rep_ < ((PROBE_DUP >> 2) & 1) + 1; ++rep_) if (IN(2)) {
            IDS
            const bf16_t* RX = WSP(WS_RX); bf16_t* XR = WSP(WS_XR); const bf16_t* Wc1 = WSP(WS_W + W_C1); float* bias1 = WSF(WS_CTL);
            const float* cw = a.in[3] + l * 4 * 1024; const float* cb = a.in[4] + l * 1024;
            {
                const int ch = (gt & 127) * 8;
                f32x4 cwv[4][2]; f32x4 cbv[2];
#pragma unroll
                for (int kk = 0; kk < 4; ++kk) { cwv[kk][0] = *(const f32x4*)(cw + kk * 1024 + ch); cwv[kk][1] = *(const f32x4*)(cw + kk * 1024 + ch + 4); }
                cbv[0] = *(const f32x4*)(cb + ch); cbv[1] = *(const f32x4*)(cb + ch + 4);
                const bool chfix = (ngt & 127) == 0;
                for (int it0 = gt; it0 < MTOK * 128; it0 += 4 * ngt) {
                    u32x4 xw[4][4]; int rowv[4]; bool ok[4];
#pragma unroll
                    for (int e = 0; e < 4; ++e) { const int it = it0 + e * ngt; ok[e] = it < MTOK * 128; const int itc = ok[e] ? it : it0; rowv[e] = itc >> 7; const int s = rowv[e] & 4095;
#pragma unroll
                        for (int kk = 0; kk < 4; ++kk) xw[e][kk] = (s - 3 + kk >= 0) ? *(const u32x4*)(RX + (size_t)(rowv[e] - 3 + kk) * 1024 + ch) : (u32x4){0u, 0u, 0u, 0u}; }
#pragma unroll
                    for (int e = 0; e < 4; ++e) {
                        float acc[8] = {cbv[0][0], cbv[0][1], cbv[0][2], cbv[0][3], cbv[1][0], cbv[1][1], cbv[1][2], cbv[1][3]};
#pragma unroll
                        for (int kk = 0; kk < 4; ++kk) { const u32x4 w4 = xw[e][kk]; const f32x4 c0 = cwv[kk][0], c1 = cwv[kk][1];
                            acc[0] += c0[0] * bf_lo(w4.x); acc[1] += c0[1] * bf_hi(w4.x); acc[2] += c0[2] * bf_lo(w4.y); acc[3] += c0[3] * bf_hi(w4.y);
                            acc[4] += c1[0] * bf_lo(w4.z); acc[5] += c1[1] * bf_hi(w4.z); acc[6] += c1[2] * bf_lo(w4.w); acc[7] += c1[3] * bf_hi(w4.w); }
                        u32x4 o; o.x = pk_bf16(acc[0], acc[1]); o.y = pk_bf16(acc[2], acc[3]); o.z = pk_bf16(acc[4], acc[5]); o.w = pk_bf16(acc[6], acc[7]);
                        if (ok[e] && chfix) *(u32x4*)(XR + (size_t)rowv[e] * 1024 + ch) = o; } }
                if (!chfix) {
                    for (int it = gt; it < MTOK * 128; it += ngt) { const int row = it >> 7, c2 = (it & 127) * 8, s = row & 4095; float acc[8];
#pragma unroll
                        for (int i = 0; i < 8; ++i) acc[i] = cb[c2 + i];
#pragma unroll
                        for (int kk = 0; kk < 4; ++kk) if (s - 3 + kk >= 0) { const u32x4 w4 = *(const u32x4*)(RX + (size_t)(row - 3 + kk) * 1024 + c2); const f32x4 c0 = *(const f32x4*)(cw + kk * 1024 + c2), c1 = *(const f32x4*)(cw + kk * 1024 + c2 + 4);
                            acc[0] += c0[0] * bf_lo(w4.x); acc[1] += c0[1] * bf_hi(w4.x); acc[2] += c0[2] * bf_lo(w4.y); acc[3] += c0[3] * bf_hi(w4.y);
                            acc[4] += c1[0] * bf_lo(w4.z); acc[5] += c1[1] * bf_hi(w4.z); acc[6] += c1[2] * bf_lo(w4.w); acc[7] += c1[3] * bf_hi(w4.w); }
                        u32x4 o; o.x = pk_bf16(acc[0], acc[1]); o.y = pk_bf16(acc[2], acc[3]); o.z = pk_bf16(acc[4], acc[5]); o.w = pk_bf16(acc[6], acc[7]);
                        *(u32x4*)(XR + (size_t)row * 1024 + c2) = o; } }
            }
            if (gt < 1024) { const float lm = a.in[9][l * 1024 + gt]; const float e = __expf(-fabsf(lm)); const float lp = e < 0.03f ? e * (1.f - e * (0.5f - e * (0.33333333f - 0.25f * e))) : __logf(1.f + e); bias1[1024 + gt] = -8.f * LOG2E * (fmaxf(-lm, 0.f) + lp); }
            for (int j = gw; j < 512; j += ngw) { const float* pos = (j >> 8 ? a.in[13] : a.in[12]) + l * 2048; const bf16_t* wr_ = Wc1 + (size_t)j * 2048;
                float s = 0.f;
                for (int kk = lane; kk < 2048; kk += 64) s += pos[kk] * __uint_as_float((unsigned)wr_[kk] << 16);
                s = wave_sum(s); if (lane == 0) bias1[j] = s; }
        }
        SEAM(2);
        for (int rep_ = 0; rep_ < ((PROBE_DUP >> 3) & 1) + 1; ++rep_) if (IN(3)) {
            pg8::StaticOrder S; pg8::Gemm g{WSP(WS_XR), WSP(WS_W + W_G), MTOK, 2048, 256, 1024, 2, 0}; S.init(MTOK, 2048, gd_opq(), bx_opq());
            EpiGate E{WSP(WS_XR), WSP(WS_LA), WSP(WS_U), a.in[6] + l * 1024, a.in[8] + l * 1024, WSF(WS_CTL) + 1024}; pg8::gemm_phase<EpiGate>(lds, g, S, E);
        }
        SEAM(3);
        for (int rep_ = 0; rep_ < ((PROBE_DUP >> 4) & 1) + 1; ++rep_) if (IN(4)) {
            IDS
            const bf16_t* LA = WSP(WS_LA); const bf16_t* U = WSP(WS_U); float* AGA = WSF(WS_AGG); float* AGH = AGA + 8 * 64 * 1024;
            for (int it = gt; it < 8 * 64 * 256; it += ngt) { const int cq = it & 255, bc = it >> 8; const int ch = 4 * cq; const size_t row0 = (size_t)bc * 64;
                float s[4] = {0.f, 0.f, 0.f, 0.f}, h[4] = {0.f, 0.f, 0.f, 0.f};
#pragma unroll 8
                for (int t = 0; t < 64; ++t) { const u32x2 wl = *(const u32x2*)(LA + (row0 + t) * 1024 + ch), wu = *(const u32x2*)(U + (row0 + t) * 1024 + ch);
                    const float l0 = bf_lo(wl.x), l1 = bf_hi(wl.x), l2 = bf_lo(wl.y), l3 = bf_hi(wl.y); s[0] += l0; s[1] += l1; s[2] += l2; s[3] += l3;
                    h[0] = ex2(l0) * h[0] + bf_lo(wu.x); h[1] = ex2(l1) * h[1] + bf_hi(wu.x); h[2] = ex2(l2) * h[2] + bf_lo(wu.y); h[3] = ex2(l3) * h[3] + bf_hi(wu.y); }
                *(f32x4*)(AGA + (size_t)bc * 1024 + ch) = (f32x4){ex2(s[0]), ex2(s[1]), ex2(s[2]), ex2(s[3])}; *(f32x4*)(AGH + (size_t)bc * 1024 + ch) = (f32x4){h[0], h[1], h[2], h[3]}; }
        }
        SEAM(4);
        if (IN(5)) {
            IDS
            const bf16_t* LA = WSP(WS_LA); const bf16_t* U = WSP(WS_U); bf16_t* YO = WSP(WS_YO); const float* AGA = WSF(WS_AGG); const float* AGH = AGA + 8 * 64 * 1024;
            for (int it = gt; it < 8 * 64 * 256; it += ngt) { const int cq = it & 255, bc = it >> 8; const int ch = 4 * cq; const size_t row0 = (size_t)bc * 64; const int c = bc & 63, b0 = bc - c;
                f32x4 h = (f32x4){0.f, 0.f, 0.f, 0.f};
                {   int cc = 0;
                    for (; cc + 8 <= c; cc += 8) { f32x4 A[8], Hh[8];
#pragma unroll
                        for (int k = 0; k < 8; ++k) { A[k] = *(const f32x4*)(AGA + (size_t)(b0 + cc + k) * 1024 + ch); Hh[k] = *(const f32x4*)(AGH + (size_t)(b0 + cc + k) * 1024 + ch); }
#pragma unroll
                        for (int k = 0; k < 8; ++k) h = A[k] * h + Hh[k]; }
                    for (; cc < c; ++cc) { const f32x4 A = *(const f32x4*)(AGA + (size_t)(b0 + cc) * 1024 + ch), Hh = *(const f32x4*)(AGH + (size_t)(b0 + cc) * 1024 + ch); h = A * h + Hh; } }
                for (int t0 = 0; t0 < 64; t0 += 8) { u32x2 wl[8], wu[8], gy[8];
#pragma unroll
                    for (int k = 0; k < 8; ++k) { wl[k] = *(const u32x2*)(LA + (row0 + t0 + k) * 1024 + ch); wu[k] = *(const u32x2*)(U + (row0 + t0 + k) * 1024 + ch); gy[k] = *(const u32x2*)(YO + (row0 + t0 + k) * 2048 + ch); }
#pragma unroll
                    for (int k = 0; k < 8; ++k) { h[0] = ex2(bf_lo(wl[k].x)) * h[0] + bf_lo(wu[k].x); h[1] = ex2(bf_hi(wl[k].x)) * h[1] + bf_hi(wu[k].x); h[2] = ex2(bf_lo(wl[k].y)) * h[2] + bf_lo(wu[k].y); h[3] = ex2(bf_hi(wl[k].y)) * h[3] + bf_hi(wu[k].y);
                        u32x2 o; o.x = pk_bf16(h[0] * bf_lo(gy[k].x), h[1] * bf_hi(gy[k].x)); o.y = pk_bf16(h[2] * bf_lo(gy[k].y), h[3] * bf_hi(gy[k].y)); gy[k] = o; }
#pragma unroll
                    for (int k = 0; k < 8; ++k) *(u32x2*)(YO + (row0 + t0 + k) * 2048 + ch) = gy[k]; }
            }
        }
        SEAM(5);
        for (int rep_ = 0; rep_ < ((PROBE_DUP >> 6) & 1) + 1; ++rep_) if (IN(6)) {
            pg8::StaticOrder S; pg8::Gemm g{WSP(WS_H), WSP(WS_W + W_INB), MTOK, 4864, 1024, 1024, 0, 0}; S.init(MTOK, 4864, gd_opq(), bx_opq());
            EpiInB E{WSP(WS_YO), WSP(WS_RX), WSP(WS_LA), WSF(WS_NG), a.in[10] + l * 64, a.in[11] + l * 192}; pg8::gemm_phase<EpiInB>(lds, g, S, E);
        }
        SEAM(6);
        for (int rep_ = 0; rep_ < ((PROBE_DUP >> 7) & 1) + 1; ++rep_) if (IN(7)) {
            pg8::StaticOrder S; pg8::Gemm g{WSP(WS_RX), WSP(WS_W + W_C1), 16384, 256, 2048, 1024, 0, 32}; S.init(16384, 256, gd_opq(), bx_opq());
            EpiCmp1 E{WSP(WS_HID), WSF(WS_CTL)}; pg8::gemm_phase<EpiCmp1>(lds, g, S, E);
        }
        SEAM(7);
        for (int rep_ = 0; rep_ < ((PROBE_DUP >> 8) & 1) + 1; ++rep_) if (IN(8)) {
            IDS
            const bf16_t* HID = WSP(WS_HID); bf16_t* KC = WSP(WS_KC); bf16_t* VC = WSP(WS_VC);
            const float* kn0 = a.in[11] + l * 192;
            LAS float* w2s = (LAS float*)lds;
            for (int i = tid; i < 2 * 4096; i += 512) { const f32x4 v = (i < 4096) ? ((const f32x4*)(a.in[15] + (size_t)l * 16384))[i] : ((const f32x4*)(a.in[17] + (size_t)l * 16384))[i - 4096]; *(LAS f32x4*)(w2s + 4 * i) = v; }
            __syncthreads();
            for (int r0 = gw * 4; r0 < 16384; r0 += ngw * 4) {
                const int which = r0 >> 13;
                const LAS float* wq = w2s + which * 16384 + lane;
                const unsigned* hp = (const unsigned*)(HID + (size_t)r0 * 256);
                float acc0 = 0.f, acc1 = 0.f, acc2 = 0.f, acc3 = 0.f;
#pragma unroll 4
                for (int h2 = 0; h2 < 128; ++h2) {
                    const float w0 = wq[(2 * h2) * 64], w1 = wq[(2 * h2 + 1) * 64];
                    const unsigned x0 = hp[h2], x1 = hp[128 + h2], x2 = hp[256 + h2], x3 = hp[384 + h2];
                    acc0 += bf_lo(x0) * w0 + bf_hi(x0) * w1; acc1 += bf_lo(x1) * w0 + bf_hi(x1) * w1;
                    acc2 += bf_lo(x2) * w0 + bf_hi(x2) * w1; acc3 += bf_lo(x3) * w0 + bf_hi(x3) * w1; }
                float accv[4] = {acc0, acc1, acc2, acc3};
#pragma unroll
                for (int e = 0; e < 4; ++e) { const int r = r0 + e, rr = r & 8191, c = rr & 255, bgi = rr >> 8;
                    bf16_t* dst = (which ? VC : KC) + ((size_t)bgi * 256 + c) * 64;
                    float v = accv[e];
                    if (!which) { const float ss = wave_sum(v * v); v *= rsqrtf(ss * (1.f / 64.f) + EPS) * kn0[lane]; }
                    if (c == 255) v = 0.f;
                    dst[lane] = (bf16_t)(pk_bf16(v, 0.f) & 0xffffu); }
            }
            __syncthreads();
        }
        SEAM(8);
        if (IN(9)) {
            if (PROBE_DUP & (1 << 9)) att::attn_phase(lds, WSP(WS_RX), WSP(WS_KC), WSP(WS_VC), WSP(WS_YO), WSP(WS_H), 1024, WSF(WS_NG), a.in[10] + l * 64, a.in[11] + l * 192);
            att::attn_phase(lds, WSP(WS_RX), WSP(WS_KC), WSP(WS_VC), WSP(WS_YO), WSP(WS_YO) + 1024, 2048, WSF(WS_NG), a.in[10] + l * 64, a.in[11] + l * 192);
        }
        SEAM(9);
        if (IN(10)) {
            pg8::StaticOrder S; pg8::Gemm g{WSP(WS_YO), WSP(WS_W + W_YA), MTOK, 1024, 2048, 2048, 0, 0}; S.init(MTOK, 1024, gd_opq(), bx_opq());
            EpiMixM E{WSP(WS_H), WSP(WS_LA)}; pg8::gemm_phase<EpiMixM>(lds, g, S, E);
        }
        SEAM(10);
        if (IN(12)) {
            pg8::StaticOrder S; pg8::Gemm g{WSP(WS_H), WSP(WS_W + W_O), MTOK, 1024, 1024, 1024, 0, 0}; S.init(MTOK, 1024, gd_opq(), bx_opq());
            EpiRes E{(l == 0) ? a.in[0] : a.out, a.out}; pg8::gemm_phase<EpiRes>(lds, g, S, E);
        }
        SEAM(12);
        for (int rep_ = 0; rep_ < ((PROBE_DUP >> 13) & 1) + 1; ++rep_) if (IN(13)) {
            IDS
            rms_phase(a.out, a.in[21] + l * 1024, WSP(WS_H), gw, ngw, lane);
        }
        SEAM(13);
        for (int rep_ = 0; rep_ < ((PROBE_DUP >> 14) & 1) + 1; ++rep_) if (IN(14)) {
            pg8::StaticOrder S; pg8::Gemm g{WSP(WS_H), WSP(WS_W + W_GU), MTOK, 5632, 1024, 1024, 0, 0}; S.init(MTOK, 5632, gd_opq(), bx_opq());
            EpiSwi E{WSP(WS_RX)}; pg8::gemm_phase<EpiSwi>(lds, g, S, E);
        }
        SEAM(14);
        if (IN(15)) {
            pg8::StaticOrder S; pg8::Gemm g{WSP(WS_RX), WSP(WS_W + W_D), MTOK, 1024, D_FF, D_FF, 0, 0}; S.init(MTOK, 1024, gd_opq(), bx_opq());
            EpiRes E{a.out, a.out}; pg8::gemm_phase<EpiRes>(lds, g, S, E);
        }
        SEAM(15);
    }
#undef IDS
#undef IN
#undef SEAM
}

extern "C" void kernel_launch(void* const* d_in, const int* in_sizes, int n_in, void* d_out, int out_size, void* d_ws, size_t ws_size, hipStream_t stream) {
    static int grid = 0;
    if (grid == 0) {
        if (n_in != 25 || out_size != MTOK * DM || ws_size < WS_END) { fprintf(stderr, "kernel_launch: unexpected problem (n_in %d, out %d, ws %zu)\n", n_in, out_size, ws_size); grid = -1; return; }
        int dev = 0, cus = 0, per_cu = 0;
        hipGetDevice(&dev); hipDeviceGetAttribute(&cus, hipDeviceAttributeMultiprocessorCount, dev);
        hipFuncSetAttribute((const void*)mega, hipFuncAttributeMaxDynamicSharedMemorySize, LDS_BYTES);
        if (hipOccupancyMaxActiveBlocksPerMultiprocessor(&per_cu, (const void*)mega, 512, LDS_BYTES) != hipSuccess || per_cu < 1) per_cu = 1;
        (void)hipGetLastError();
        grid = cus * per_cu;
        if (grid <= 0) grid = 256;
    }
    if (grid < 0) return;
    Args a{};
    for (int i = 0; i < 25; ++i) a.in[i] = (const float*)d_in[i];
    a.out = (float*)d_out; a.ws = (unsigned char*)d_ws;
#if MK_MULTI
    for (int p = 0; p < DEPTH * NPH; ++p) { a.ph_lo = p; a.ph_hi = p + 1; hipLaunchKernelGGL(mega, dim3(grid), dim3(512), LDS_BYTES, stream, a); }
#else
    a.ph_lo = 0; a.ph_hi = DEPTH * NPH;
    (void)hipMemsetAsync((char*)d_ws + WS_BAR, 0, 16384, stream);
    void* args[] = {&a};
    hipError_t e = hipLaunchCooperativeKernel((const void*)mega, dim3(grid), dim3(512), args, LDS_BYTES, stream);
    if (e != hipSuccess) fprintf(stderr, "cooperative launch failed: %s (grid %d)\n", hipGetErrorString(e), grid);
#endif
}
```

```cpp
#include <hip/hip_runtime.h>
#include <hip/hip_cooperative_groups.h>
#include <cstdio>
#include <cstdint>
namespace cg = cooperative_groups;

#ifndef PROBE_SYNC2
#define PROBE_SYNC2 0
#endif
#ifndef PROBE_DUP
#define PROBE_DUP 0
#endif
#ifndef MK_MULTI
#define MK_MULTI 0
#endif

#define LAS __attribute__((address_space(3)))
typedef unsigned short bf16_t;
typedef short bf16x8 __attribute__((ext_vector_type(8)));
typedef short s16x4 __attribute__((ext_vector_type(4)));
typedef float f32x2 __attribute__((ext_vector_type(2)));
typedef float f32x4 __attribute__((ext_vector_type(4)));
typedef float f32x16 __attribute__((ext_vector_type(16)));
typedef unsigned u32x2 __attribute__((ext_vector_type(2)));
typedef unsigned u32x4 __attribute__((ext_vector_type(4)));
typedef __bf16 bf16x2_t __attribute__((ext_vector_type(2)));

constexpr int DM = 1024, NB = 8, SEQ = 4096, MTOK = NB * SEQ, DEPTH = 2;
constexpr int D_IN = 6704, D_FF = 2816;
constexpr float EPS = 1e-6f;
constexpr float LOG2E = 1.4426950408889634f;
constexpr float QSCALE = 0.125f * LOG2E;

constexpr size_t MiB = 1u << 20;
constexpr size_t WS_CTL = 0;
constexpr size_t WS_BAR = 65536;
constexpr size_t WS_W = 1 * MiB;
constexpr size_t W_INA = 0, W_INB = 4 * MiB, W_G = 14 * MiB, W_C1 = 15 * MiB, W_YA = 17 * MiB, W_YB = 19 * MiB, W_O = 21 * MiB, W_GU = 23 * MiB, W_D = 34 * MiB;
constexpr size_t WS_H = 41 * MiB;
constexpr size_t WS_RX = 105 * MiB;
constexpr size_t WS_XR = 169 * MiB;
constexpr size_t WS_LA = 233 * MiB;
constexpr size_t WS_U = 297 * MiB;
constexpr size_t WS_YO = 361 * MiB;
constexpr size_t WS_NG = 489 * MiB;
constexpr size_t WS_HID = 497 * MiB;
constexpr size_t WS_KC = 505 * MiB;
constexpr size_t WS_VC = 506 * MiB;
constexpr size_t WS_AGG = 507 * MiB;
constexpr size_t WS_END = 511 * MiB;
constexpr size_t KVBUF = (size_t)32 * 4096 * 64;

__device__ __forceinline__ int bx_opq() { int t = blockIdx.x; asm volatile("" : "+s"(t)); return t; }
__device__ __forceinline__ int gd_opq() { int t = gridDim.x; asm volatile("" : "+s"(t)); return t; }
__device__ __forceinline__ int tid_opq() { int t = threadIdx.x; asm volatile("" : "+v"(t)); return t; }
__device__ __forceinline__ unsigned pk_bf16(float lo, float hi) { f32x2 v = {lo, hi}; bf16x2_t b = __builtin_convertvector(v, bf16x2_t); return __builtin_bit_cast(unsigned, b); }
__device__ __forceinline__ float bf_lo(unsigned w) { return __uint_as_float(w << 16); }
__device__ __forceinline__ float bf_hi(unsigned w) { return __uint_as_float(w & 0xffff0000u); }
__device__ __forceinline__ float ex2(float x) { return __builtin_amdgcn_exp2f(x); }
__device__ __forceinline__ float sigm(float x) { return __builtin_amdgcn_rcpf(1.f + ex2(-LOG2E * x)); }
__device__ __forceinline__ float gelu_t(float x) { const float y = 1.5957691216057308f * (x + 0.044715f * x * x * x); return x * sigm(y); }
__device__ __forceinline__ float wave_sum(float v) {
#pragma unroll
    for (int o = 1; o < 64; o <<= 1) v += __shfl_xor(v, o);
    return v;
}
__device__ __forceinline__ float wave_max(float v) {
#pragma unroll
    for (int o = 1; o < 64; o <<= 1) v = fmaxf(v, __shfl_xor(v, o));
    return v;
}
__device__ __forceinline__ u32x4 pack8(const f32x4 a, const f32x4 b) { u32x4 w; w.x = pk_bf16(a[0], a[1]); w.y = pk_bf16(a[2], a[3]); w.z = pk_bf16(b[0], b[1]); w.w = pk_bf16(b[2], b[3]); return w; }

namespace pg8 {
constexpr int BM = 256, BK = 64, HALF = 128, HTB = HALF * BK * 2, STAGE_BYTES = 8 * HTB, NXCD = 8, WGM = 8;
__host__ __device__ __forceinline__ int lds_byte(int r, int c) { const int st = (r >> 4) * 2 + (c >> 5), rr = r & 15, cc = c & 31, ob = rr * 64 + cc * 2; return st * 1024 + (ob ^ (((ob >> 9) & 1) << 5)); }
__host__ __device__ __forceinline__ void stage_rc(int b, int& R, int& C) { const int st = b / 1024, sb = b % 1024, swz = sb ^ (((sb >> 9) & 1) << 5); R = (st >> 1) * 16 + swz / 64; C = (st & 1) * 32 + (swz % 64) / 2; }
__host__ __device__ __forceinline__ int perm32(int rho) { const int n = rho >> 4, i = rho & 15; return 8 * (i >> 2) + 4 * n + (i & 3); }

struct Unit { int pm, pn; };
struct Gemm { const bf16_t* A; const bf16_t* Bt; int M, N, K, lda, a_div, b_div; };

struct StaticOrder {
    int nM, nN, nwg, G, c;
    __device__ void init(int M, int N, int G_, int c_) { nM = M / BM; nN = N / BM; nwg = nM * nN; G = G_; c = c_; }
    __device__ bool next(int i, Unit& u) const {
        const long L = (long)i * G + c; if (L >= nwg) return false;
        int wgid = (int)L; { const int q = nwg / NXCD, r = nwg % NXCD, xcd = wgid % NXCD, off = wgid / NXCD; wgid = (xcd < r ? xcd * (q + 1) : r * (q + 1) + (xcd - r) * q) + off; }
        const int nig = WGM * nN, gid = wgid / nig, fm = gid * WGM, gsz = (nM - fm) < WGM ? (nM - fm) : WGM;
        u.pm = fm + ((wgid % nig) % gsz); u.pn = (wgid % nig) / gsz; return true;
    }
};
__device__ __forceinline__ const char* unitA(const Gemm& g, const Unit& u, size_t tstepA) { return (const char*)g.A + (size_t)u.pm * tstepA + (g.a_div ? (size_t)(u.pn / g.a_div) * (size_t)g.K * 2 : (size_t)0); }
__device__ __forceinline__ const char* unitB(const Gemm& g, const Unit& u, size_t tstepB) { return (const char*)g.Bt + (size_t)(u.pn + (g.b_div ? (u.pm / g.b_div) * (g.N / BM) : 0)) * tstepB; }

template <class Epi>
__device__ __forceinline__ void gemm_phase(LAS unsigned char* lds, const Gemm g, const StaticOrder& S, const Epi& E) {
    const int tid = tid_opq(), wid = __builtin_amdgcn_readfirstlane(tid >> 6), lane = tid & 63, wr = wid >> 2, wc = wid & 3, fr = lane & 15, fq = lane >> 4;
    const int K = g.K, nt = K / BK;
    unsigned voffA[2], voffB[2];
#pragma unroll
    for (int i = 0; i < 2; ++i) { int R, C; stage_rc(tid * 16 + i * 8192, R, C); const int Rb = Epi::PERM ? ((R & ~31) + perm32(R & 31)) : R;
        voffA[i] = (unsigned)(R * g.lda + C) * 2u; voffB[i] = (unsigned)(Rb * K + C) * 2u; }
    const size_t kstep = (size_t)(BK * 2);
    const size_t hstepA = (size_t)HALF * g.lda * 2, hstepB = (size_t)HALF * K * 2;
    const size_t tstepA = 2 * hstepA, tstepB = 2 * hstepB;
    const unsigned ldsw = (unsigned)wid * 1024u;
    const int aoff = lds_byte(wr * 64 + fr, fq * 8), boff = lds_byte(wc * 32 + fr, fq * 8);
#define PG8_SA(b, h) (((b) * 2 + (h)) * HTB)
#define PG8_SB(b, h) ((4 + (b) * 2 + (h)) * HTB)
#define PG8_STAGE(bufoff, gbase, voff) do { _Pragma("unroll") for (int _i = 0; _i < 2; ++_i) \
        __builtin_amdgcn_global_load_lds((const unsigned*)((const char*)(gbase) + (voff)[_i]), (LAS unsigned*)(lds + (bufoff) + ldsw + _i * 8192), 16, 0, 0); } while (0)
#define PG8_LDA(dst, b, h) do { _Pragma("unroll") for (int m = 0; m < 4; ++m) _Pragma("unroll") for (int k = 0; k < 2; ++k) dst[m][k] = *(const LAS bf16x8*)(lds + PG8_SA(b, h) + aoff + m * 2048 + k * 1024); } while (0)
#define PG8_LDB(dst, b, h) do { _Pragma("unroll") for (int n = 0; n < 2; ++n) _Pragma("unroll") for (int k = 0; k < 2; ++k) dst[n][k] = *(const LAS bf16x8*)(lds + PG8_SB(b, h) + boff + n * 2048 + k * 1024); } while (0)
#define PG8_MMA(ai, bj, At, Bt) do { __builtin_amdgcn_s_setprio(1); _Pragma("unroll") for (int m = 0; m < 4; ++m) _Pragma("unroll") for (int n = 0; n < 2; ++n) _Pragma("unroll") for (int k = 0; k < 2; ++k) \
        acc[ai][bj][m][n] = __builtin_amdgcn_mfma_f32_16x16x32_bf16(Bt[n][k], At[m][k], acc[ai][bj][m][n], 0, 0, 0); __builtin_amdgcn_s_setprio(0); } while (0)
#define PG8_WAIT_V(n) asm volatile("s_waitcnt vmcnt(" #n ")" ::: "memory")
#define PG8_WAIT_L(n) asm volatile("s_waitcnt lgkmcnt(" #n ")" ::: "memory")
#define PG8_BAR __builtin_amdgcn_s_barrier()
#define PG8_SCHED __builtin_amdgcn_sched_barrier(0)
    Unit cur, nxt; int ui = 0;
    if (!S.next(0, cur)) return;
    f32x4 acc[2][2][4][2];
#pragma unroll
    for (int a = 0; a < 2; ++a)
#pragma unroll
        for (int b = 0; b < 2; ++b)
#pragma unroll
            for (int m = 0; m < 4; ++m)
#pragma unroll
                for (int n = 0; n < 2; ++n) acc[a][b][m][n] = (f32x4){0.f, 0.f, 0.f, 0.f};
    bf16x8 At[4][2], B0[2][2], B1[2][2];
    const char* cA = unitA(g, cur, tstepA); const char* cB = unitB(g, cur, tstepB);
    PG8_STAGE(PG8_SB(0, 0), cB, voffB); PG8_STAGE(PG8_SB(0, 1), cB + hstepB, voffB); PG8_STAGE(PG8_SA(0, 0), cA, voffA); PG8_STAGE(PG8_SA(0, 1), cA + hstepA, voffA);
    if (wr == 1) PG8_BAR;
    PG8_WAIT_V(2); PG8_BAR;
    PG8_STAGE(PG8_SB(1, 0), cB + kstep, voffB); PG8_STAGE(PG8_SA(1, 0), cA + kstep, voffA); PG8_STAGE(PG8_SB(1, 1), cB + hstepB + kstep, voffB);
    PG8_WAIT_V(6); PG8_BAR;
    for (;;) {
        const bool has_next = S.next(ui + 1, nxt);
        const char* nA = has_next ? unitA(g, nxt, tstepA) : cA; const char* nB = has_next ? unitB(g, nxt, tstepB) : cB;
#pragma unroll 1
        for (int t = 0; t < nt; t += 2) {
            const bool last = (t == nt - 2);
            const char* a1 = cA + (size_t)(t + 1) * kstep;
            const char* a2 = last ? nA : cA + (size_t)(t + 2) * kstep; const char* b2 = last ? nB : cB + (size_t)(t + 2) * kstep;
            const char* a3 = a2 + kstep; const char* b3 = b2 + kstep;
            if constexpr (Epi::MID) { if (t == nt / 2) E.mid(acc, cur, wr, wc, fr, fq); }
            PG8_LDB(B0, 0, 0); PG8_LDB(B1, 0, 1); PG8_SCHED; PG8_LDA(At, 0, 0); PG8_STAGE(PG8_SA(1, 1), a1 + hstepA, voffA);
            PG8_WAIT_V(8); PG8_WAIT_L(0); PG8_BAR; PG8_MMA(0, 0, At, B0); PG8_MMA(0, 1, At, B1); PG8_BAR; PG8_SCHED;
            PG8_LDA(At, 0, 1); PG8_STAGE(PG8_SB(0, 0), b2, voffB); PG8_STAGE(PG8_SB(0, 1), b2 + hstepB, voffB); PG8_STAGE(PG8_SA(0, 0), a2, voffA);
            PG8_WAIT_V(8); PG8_WAIT_L(0); PG8_BAR; PG8_MMA(1, 0, At, B0); PG8_MMA(1, 1, At, B1); PG8_BAR; PG8_SCHED;
            PG8_LDB(B0, 1, 0); PG8_LDB(B1, 1, 1); PG8_SCHED; PG8_LDA(At, 1, 0); PG8_STAGE(PG8_SA(0, 1), a2 + hstepA, voffA);
            PG8_WAIT_V(8); PG8_WAIT_L(0); PG8_BAR; PG8_MMA(0, 0, At, B0); PG8_MMA(0, 1, At, B1); PG8_BAR; PG8_SCHED;
            PG8_LDA(At, 1, 1); PG8_STAGE(PG8_SB(1, 0), b3, voffB); PG8_STAGE(PG8_SB(1, 1), b3 + hstepB, voffB); PG8_STAGE(PG8_SA(1, 0), a3, voffA);
            PG8_WAIT_V(8); PG8_WAIT_L(0); PG8_BAR; PG8_MMA(1, 0, At, B0); PG8_MMA(1, 1, At, B1); PG8_BAR; PG8_SCHED;
        }
        if (wr == 0) PG8_BAR;
        E(acc, cur, wr, wc, fr, fq);
        if (!has_next) break;
#pragma unroll
        for (int a = 0; a < 2; ++a)
#pragma unroll
            for (int b = 0; b < 2; ++b)
#pragma unroll
                for (int m = 0; m < 4; ++m)
#pragma unroll
                    for (int n = 0; n < 2; ++n) acc[a][b][m][n] = (f32x4){0.f, 0.f, 0.f, 0.f};
        cur = nxt; cA = nA; cB = nB; ++ui;
        if (wr == 1) PG8_BAR;
    }
    PG8_WAIT_V(0);
    PG8_BAR;
#undef PG8_SA
#undef PG8_SB
#undef PG8_STAGE
#undef PG8_LDA
#undef PG8_LDB
#undef PG8_MMA
#undef PG8_WAIT_V
#undef PG8_WAIT_L
#undef PG8_BAR
#undef PG8_SCHED
}
}
using pg8::Unit;
typedef const f32x4 (&AccRef)[2][2][4][2];

struct EpiInA {
    static constexpr bool PERM = true, MID = false;
    bf16_t* RX; bf16_t* YO;
    __device__ __forceinline__ void operator()(AccRef acc, const Unit& u, int wr, int wc, int fr, int fq) const {
        const bool isy = u.pn >= 4; bf16_t* base = isy ? YO : RX; const int ldc = isy ? 2048 : 1024;
        const int row0 = u.pm * 256 + wr * 64 + fr, col0 = (u.pn & 3) * 256 + wc * 32 + 8 * fq;
#pragma unroll
        for (int ai = 0; ai < 2; ++ai)
#pragma unroll
            for (int m = 0; m < 4; ++m) { bf16_t* rowp = base + (size_t)(row0 + ai * 128 + m * 16) * ldc + col0;
#pragma unroll
                for (int bj = 0; bj < 2; ++bj) { f32x4 v0 = acc[ai][bj][m][0], v1 = acc[ai][bj][m][1];
                    if (isy) {
#pragma unroll
                        for (int i = 0; i < 4; ++i) { v0[i] = gelu_t(v0[i]); v1[i] = gelu_t(v1[i]); } }
                    *(u32x4*)(rowp + bj * 128) = pack8(v0, v1); } }
    }
};
struct EpiInB {
    static constexpr bool PERM = true, MID = false;
    bf16_t* YO; bf16_t* KVB; bf16_t* MG; float* NG; const float* qn; const float* kn;
    __device__ __forceinline__ void operator()(AccRef acc, const Unit& u, int wr, int wc, int fr, int fq) const {
        const int t = u.pn; const int row0 = u.pm * 256 + wr * 64 + fr;
        if (t < 10) {
            const bool isq = t < 4; const bool nrm = isq || t == 6 || t == 8;
            const float* gw = isq ? qn : (kn + (t == 6 ? 64 : 128));
            const float osc = isq ? QSCALE : 1.f;
            f32x4 gvv[2][2];
#pragma unroll
            for (int bj = 0; bj < 2; ++bj)
#pragma unroll
                for (int n = 0; n < 2; ++n) gvv[bj][n] = nrm ? *(const f32x4*)(gw + 32 * bj + 8 * fq + 4 * n) : (f32x4){1.f, 1.f, 1.f, 1.f};
#pragma unroll
            for (int ai = 0; ai < 2; ++ai)
#pragma unroll
                for (int m = 0; m < 4; ++m) {
                    const int row = row0 + ai * 128 + m * 16;
                    float rinv = 1.f;
                    if (nrm) { float ss = 0.f;
#pragma unroll
                        for (int bj = 0; bj < 2; ++bj)
#pragma unroll
                            for (int n = 0; n < 2; ++n) { const f32x4 x = acc[ai][bj][m][n]; ss += (x[0] * x[0] + x[1] * x[1]) + (x[2] * x[2] + x[3] * x[3]); }
                        ss += __shfl_xor(ss, 16); ss += __shfl_xor(ss, 32);
                        rinv = rsqrtf(ss * (1.f / 64.f) + EPS) * osc; }
                    bf16_t* dst;
                    if (isq) dst = YO + (size_t)row * 2048 + 1024 + (t * 4 + wc) * 64 + 8 * fq;
                    else { const int b = row >> 12, s = row & 4095; dst = KVB + (size_t)(t - 4) * KVBUF + ((size_t)(b * 4 + wc) * 4096 + s) * 64 + 8 * fq; }
#pragma unroll
                    for (int bj = 0; bj < 2; ++bj) { const f32x4 g0 = gvv[bj][0], g1 = gvv[bj][1];
                        const f32x4 v0 = acc[ai][bj][m][0] * rinv * g0, v1 = acc[ai][bj][m][1] * rinv * g1;
                        *(u32x4*)(dst + 32 * bj) = pack8(v0, v1); }
                }
        } else if (t < 18) {
#pragma unroll
            for (int ai = 0; ai < 2; ++ai)
#pragma unroll
                for (int m = 0; m < 4; ++m) { bf16_t* dst = MG + (size_t)(row0 + ai * 128 + m * 16) * 2048 + (t - 10) * 256 + 64 * wc + 8 * fq;
#pragma unroll
                    for (int bj = 0; bj < 2; ++bj) { f32x4 v0 = acc[ai][bj][m][0], v1 = acc[ai][bj][m][1];
#pragma unroll
                        for (int i = 0; i < 4; ++i) { v0[i] = sigm(v0[i]); v1[i] = sigm(v1[i]); }
                        *(u32x4*)(dst + 32 * bj) = pack8(v0, v1); } }
        } else if (wc == 0) {
#pragma unroll
            for (int ai = 0; ai < 2; ++ai)
#pragma unroll
                for (int m = 0; m < 4; ++m) { float* dst = NG + (size_t)(row0 + ai * 128 + m * 16) * 64 + 8 * fq;
#pragma unroll
                    for (int bj = 0; bj < 2; ++bj)
#pragma unroll
                        for (int n = 0; n < 2; ++n) { f32x4 v = acc[ai][bj][m][n];
#pragma unroll
                            for (int i = 0; i < 4; ++i) v[i] = sigm(v[i]);
                            *(f32x4*)(dst + 32 * bj + 4 * n) = v; } }
        }
    }
};
struct EpiGate {
    static constexpr bool PERM = true, MID = false;
    const bf16_t* XR; bf16_t* LA; bf16_t* U; const float* ba; const float* bi; const float* lam;
    __device__ __forceinline__ void operator()(AccRef acc, const Unit& u, int wr, int wc, int fr, int fq) const {
        const int row0 = u.pm * 256 + wr * 64 + fr;
#pragma unroll
        for (int n = 0; n < 2; ++n) {
            const int ch0 = u.pn * 128 + wc * 32 + 8 * fq + 4 * n;
            const f32x4 bav = *(const f32x4*)(ba + ch0), biv = *(const f32x4*)(bi + ch0), spv = *(const f32x4*)(lam + ch0);
#pragma unroll
            for (int ai = 0; ai < 2; ++ai) {
                u32x2 xwv[4];
#pragma unroll
                for (int m = 0; m < 4; ++m) xwv[m] = *(const u32x2*)(XR + (size_t)(row0 + ai * 128 + m * 16) * 1024 + ch0);
#pragma unroll
                for (int m = 0; m < 4; ++m) { const int row = row0 + ai * 128 + m * 16; const bool first = (row & 4095) == 0;
                    const u32x2 xw = xwv[m];
                    const float xv[4] = {bf_lo(xw.x), bf_hi(xw.x), bf_lo(xw.y), bf_hi(xw.y)};
                    float la[4], uu[4];
#pragma unroll
                    for (int i = 0; i < 4; ++i) { const float rp = acc[ai][0][m][n][i] + bav[i], ip = acc[ai][1][m][n][i] + biv[i];
                        const float l2 = sigm(rp) * spv[i];
                        const float a2 = ex2(2.f * l2); float mult = __builtin_amdgcn_sqrtf(fmaxf(1.f - a2, 0.f)); if (first) mult = 1.f;
                        la[i] = l2; uu[i] = mult * sigm(ip) * xv[i]; }
                    u32x2 w0, w1; w0.x = pk_bf16(la[0], la[1]); w0.y = pk_bf16(la[2], la[3]); w1.x = pk_bf16(uu[0], uu[1]); w1.y = pk_bf16(uu[2], uu[3]);
                    *(u32x2*)(LA + (size_t)row * 1024 + ch0) = w0; *(u32x2*)(U + (size_t)row * 1024 + ch0) = w1; } }
        }
    }
};
struct EpiCmp1 {
    static constexpr bool PERM = true, MID = false;
    bf16_t* HID; const float* bias1;
    __device__ __forceinline__ void operator()(AccRef acc, const Unit& u, int wr, int wc, int fr, int fq) const {
        const int which = u.pm >> 5; const int row0 = u.pm * 256 + wr * 64 + fr;
#pragma unroll
        for (int ai = 0; ai < 2; ++ai)
#pragma unroll
            for (int m = 0; m < 4; ++m) { bf16_t* dst = HID + (size_t)(row0 + ai * 128 + m * 16) * 256 + wc * 32 + 8 * fq;
#pragma unroll
                for (int bj = 0; bj < 2; ++bj) { const float* bp = bias1 + which * 256 + bj * 128 + wc * 32 + 8 * fq;
                    f32x4 v0 = acc[ai][bj][m][0] + *(const f32x4*)bp, v1 = acc[ai][bj][m][1] + *(const f32x4*)(bp + 4);
#pragma unroll
                    for (int i = 0; i < 4; ++i) { v0[i] = gelu_t(v0[i]); v1[i] = gelu_t(v1[i]); }
                    *(u32x4*)(dst + bj * 128) = pack8(v0, v1); } }
    }
};
template <int ADD> struct EpiMix {
    static constexpr bool PERM = true, MID = false;
    bf16_t* MB; const bf16_t* MG; int sel;
    __device__ __forceinline__ void operator()(AccRef acc, const Unit& u, int wr, int wc, int fr, int fq) const {
        const int row0 = u.pm * 256 + wr * 64 + fr, col0 = u.pn * 256 + wc * 32 + 8 * fq;
#pragma unroll
        for (int ai = 0; ai < 2; ++ai)
#pragma unroll
            for (int mp = 0; mp < 2; ++mp) {
                u32x4 gwv[2][2], owv[2][2];
#pragma unroll
                for (int mm = 0; mm < 2; ++mm)
#pragma unroll
                    for (int bj = 0; bj < 2; ++bj) { const int row = row0 + ai * 128 + (2 * mp + mm) * 16, col = col0 + bj * 128;
                        gwv[mm][bj] = *(const u32x4*)(MG + (size_t)row * 2048 + sel * 1024 + col);
                        owv[mm][bj] = ADD ? *(const u32x4*)(MB + (size_t)row * 1024 + col) : (u32x4){0u, 0u, 0u, 0u}; }
#pragma unroll
                for (int mm = 0; mm < 2; ++mm)
#pragma unroll
                    for (int bj = 0; bj < 2; ++bj) { const int row = row0 + ai * 128 + (2 * mp + mm) * 16, col = col0 + bj * 128; const u32x4 gw = gwv[mm][bj], ow = owv[mm][bj];
                        f32x4 v0 = acc[ai][bj][2 * mp + mm][0], v1 = acc[ai][bj][2 * mp + mm][1];
                        v0[0] *= bf_lo(gw.x); v0[1] *= bf_hi(gw.x); v0[2] *= bf_lo(gw.y); v0[3] *= bf_hi(gw.y);
                        v1[0] *= bf_lo(gw.z); v1[1] *= bf_hi(gw.z); v1[2] *= bf_lo(gw.w); v1[3] *= bf_hi(gw.w);
                        if (ADD) { v0[0] += bf_lo(ow.x); v0[1] += bf_hi(ow.x); v0[2] += bf_lo(ow.y); v0[3] += bf_hi(ow.y);
                            v1[0] += bf_lo(ow.z); v1[1] += bf_hi(ow.z); v1[2] += bf_lo(ow.w); v1[3] += bf_hi(ow.w); }
                        *(u32x4*)(MB + (size_t)row * 1024 + col) = pack8(v0, v1); } }
    }
};
struct EpiMixM {
    static constexpr bool PERM = true, MID = true;
    bf16_t* MB; const bf16_t* MG;
    __device__ __forceinline__ void mid(f32x4 (&acc)[2][2][4][2], const Unit& u, int wr, int wc, int fr, int fq) const {
        int row0 = u.pm * 256 + wr * 64 + fr, col0 = u.pn * 256 + wc * 32 + 8 * fq; asm volatile("" : "+v"(row0), "+v"(col0));
#pragma unroll
        for (int ai = 0; ai < 2; ++ai)
#pragma unroll
            for (int m = 0; m < 4; ++m)
#pragma unroll
                for (int bj = 0; bj < 2; ++bj) { const bf16_t* gp = MG + (size_t)(row0 + ai * 128 + m * 16) * 2048 + col0 + bj * 128;
                    const u32x4 g0 = *(const u32x4*)gp, g1 = *(const u32x4*)(gp + 1024);
                    f32x4 r0, r1;
                    r0[0] = bf_lo(g0.x) * __builtin_amdgcn_rcpf(bf_lo(g1.x)); r0[1] = bf_hi(g0.x) * __builtin_amdgcn_rcpf(bf_hi(g1.x)); r0[2] = bf_lo(g0.y) * __builtin_amdgcn_rcpf(bf_lo(g1.y)); r0[3] = bf_hi(g0.y) * __builtin_amdgcn_rcpf(bf_hi(g1.y));
                    r1[0] = bf_lo(g0.z) * __builtin_amdgcn_rcpf(bf_lo(g1.z)); r1[1] = bf_hi(g0.z) * __builtin_amdgcn_rcpf(bf_hi(g1.z)); r1[2] = bf_lo(g0.w) * __builtin_amdgcn_rcpf(bf_lo(g1.w)); r1[3] = bf_hi(g0.w) * __builtin_amdgcn_rcpf(bf_hi(g1.w));
                    acc[ai][bj][m][0] *= r0; acc[ai][bj][m][1] *= r1; }
    }
    __device__ __forceinline__ void operator()(AccRef acc, const Unit& u, int wr, int wc, int fr, int fq) const {
        const int row0 = u.pm * 256 + wr * 64 + fr, col0 = u.pn * 256 + wc * 32 + 8 * fq;
#pragma unroll
        for (int ai = 0; ai < 2; ++ai) {
            u32x4 gwv[4][2];
#pragma unroll
            for (int m = 0; m < 4; ++m)
#pragma unroll
                for (int bj = 0; bj < 2; ++bj) gwv[m][bj] = *(const u32x4*)(MG + (size_t)(row0 + ai * 128 + m * 16) * 2048 + 1024 + col0 + bj * 128);
#pragma unroll
            for (int m = 0; m < 4; ++m)
#pragma unroll
                for (int bj = 0; bj < 2; ++bj) { const int row = row0 + ai * 128 + m * 16, col = col0 + bj * 128; const u32x4 gw = gwv[m][bj];
                    f32x4 v0 = acc[ai][bj][m][0], v1 = acc[ai][bj][m][1];
                    v0[0] *= bf_lo(gw.x); v0[1] *= bf_hi(gw.x); v0[2] *= bf_lo(gw.y); v0[3] *= bf_hi(gw.y);
                    v1[0] *= bf_lo(gw.z); v1[1] *= bf_hi(gw.z); v1[2] *= bf_lo(gw.w); v1[3] *= bf_hi(gw.w);
                    *(u32x4*)(MB + (size_t)row * 1024 + col) = pack8(v0, v1); } }
    }
};
struct EpiRes {
    static constexpr bool PERM = false, MID = false;
    const float* base; float* out;
    __device__ __forceinline__ void operator()(AccRef acc, const Unit& u, int wr, int wc, int fr, int fq) const {
        const int row0 = u.pm * 256 + wr * 64 + fr, col0 = u.pn * 256 + wc * 32 + 4 * fq;
#pragma unroll
        for (int ai = 0; ai < 2; ++ai)
#pragma unroll
            for (int mp = 0; mp < 2; ++mp) {
                f32x4 bs[2][2][2];
#pragma unroll
                for (int mm = 0; mm < 2; ++mm) { const size_t off = (size_t)(row0 + ai * 128 + (2 * mp + mm) * 16) * 1024 + col0;
#pragma unroll
                    for (int bj = 0; bj < 2; ++bj)
#pragma unroll
                        for (int n = 0; n < 2; ++n) bs[mm][bj][n] = *(const f32x4*)(base + off + bj * 128 + n * 16); }
#pragma unroll
                for (int mm = 0; mm < 2; ++mm) { const size_t off = (size_t)(row0 + ai * 128 + (2 * mp + mm) * 16) * 1024 + col0;
#pragma unroll
                    for (int bj = 0; bj < 2; ++bj)
#pragma unroll
                        for (int n = 0; n < 2; ++n) *(f32x4*)(out + off + bj * 128 + n * 16) = bs[mm][bj][n] + acc[ai][bj][2 * mp + mm][n]; } }
    }
};
struct EpiSwi {
    static constexpr bool PERM = true, MID = false;
    bf16_t* ACT;
    __device__ __forceinline__ void operator()(AccRef acc, const Unit& u, int wr, int wc, int fr, int fq) const {
        const int row0 = u.pm * 256 + wr * 64 + fr, ch0 = u.pn * 128 + wc * 32 + 8 * fq;
#pragma unroll
        for (int ai = 0; ai < 2; ++ai)
#pragma unroll
            for (int m = 0; m < 4; ++m) { f32x4 v0, v1;
#pragma unroll
                for (int i = 0; i < 4; ++i) { const float g0 = acc[ai][0][m][0][i], g1 = acc[ai][0][m][1][i];
                    v0[i] = g0 * sigm(g0) * acc[ai][1][m][0][i]; v1[i] = g1 * sigm(g1) * acc[ai][1][m][1][i]; }
                *(u32x4*)(ACT + (size_t)(row0 + ai * 128 + m * 16) * D_FF + ch0) = pack8(v0, v1); }
    }
};

__device__ __forceinline__ void xpose_item(const float* W, int Ns, int col0, int valid, bf16_t* dst, int K, int k0, LAS float* scr, int lane) {
#pragma unroll
    for (int i = 0; i < 32; ++i) { const int kk = 2 * i + (lane >> 5), n = lane & 31; scr[kk * 33 + n] = (n < valid) ? W[(size_t)(k0 + kk) * Ns + col0 + n] : 0.f; }
    asm volatile("s_waitcnt lgkmcnt(0)" ::: "memory");
    const int c = lane & 7;
#pragma unroll
    for (int j = 0; j < 4; ++j) { const int n = (lane >> 3) + 8 * j; const LAS float* s = scr + (8 * c) * 33 + n;
        u32x4 o; o.x = pk_bf16(s[0 * 33], s[1 * 33]); o.y = pk_bf16(s[2 * 33], s[3 * 33]); o.z = pk_bf16(s[4 * 33], s[5 * 33]); o.w = pk_bf16(s[6 * 33], s[7 * 33]);
        *(u32x4*)(dst + (size_t)n * K + k0 + 8 * c) = o; }
    asm volatile("s_waitcnt lgkmcnt(0)" ::: "memory");
}

struct Args { const float* in[25]; float* out; unsigned char* ws; int ph_lo, ph_hi; };
__device__ __forceinline__ unsigned char* opq(unsigned char* p);

struct XDesc { const float* W; bf16_t* dst; int Ns, col0, valid, K, k0; };
__device__ __forceinline__ XDesc xdesc(const Args& a, int l, bf16_t* Wb, int it) {
    const float* w_in = a.in[2] + (size_t)l * 1024 * D_IN;
    constexpr int I1 = 16 * 64, I2 = 16 * 152, I3 = 4 * 64, I4 = 32 * 16, I5 = 16 * 32, I6 = 16 * 176;
    int r = it;
    if (r < I1) { const int kb = r / 64, gi = r % 64; return XDesc{w_in, Wb + W_INA / 2 + (size_t)(32 * gi) * 1024, D_IN, 32 * gi, 32, 1024, 64 * kb}; } r -= I1;
    if (r < I2) { const int kb = r / 152, gi = r % 152; const int t = gi >> 3, gl = gi & 7, ca = 64 * (gl & 3) + 32 * (gl >> 2);
        int col0, valid = 32;
        if (t < 10) col0 = 2048 + 256 * t + ca; else if (t < 18) col0 = 4656 + 256 * (t - 10) + ca; else { col0 = 4608 + ca; valid = 48 - ca; valid = valid < 0 ? 0 : (valid > 32 ? 32 : valid); }
        return XDesc{w_in, Wb + W_INB / 2 + (size_t)(32 * gi) * 1024, D_IN, col0, valid, 1024, 64 * kb}; } r -= I2;
    if (r < I3) { const int kb = r / 64, gi = r % 64; const int pn = gi >> 3, gl = gi & 7, bj = gl >> 2, ch = 128 * pn + 32 * (gl & 3);
        const float* W = (bj ? a.in[7] : a.in[5]) + (size_t)l * 4 * 65536 + (size_t)(ch >> 8) * 65536;
        return XDesc{W, Wb + W_G / 2 + (size_t)(32 * gi) * 256, 256, ch & 255, 32, 256, 64 * kb}; } r -= I3;
    if (r < I4) { const int kb = r / 16, gi = r % 16; const float* W = ((gi >> 3) ? a.in[16] : a.in[14]) + (size_t)l * 2048 * 256;
        return XDesc{W, Wb + W_C1 / 2 + (size_t)(32 * gi) * 2048, 256, 32 * (gi & 7), 32, 2048, 64 * kb}; } r -= I4;
    if (r < 3 * I5) { const int which = r / I5; r -= which * I5; const int kb = r / 32, gi = r % 32;
        const float* W = a.in[18 + which] + (size_t)l * 1024 * 1024;
        if (which < 2) return XDesc{W, Wb + W_YA / 2 + (size_t)(32 * gi) * 2048 + which * 1024, 1024, 32 * gi, 32, 2048, 64 * kb};
        return XDesc{W, Wb + W_O / 2 + (size_t)(32 * gi) * 1024, 1024, 32 * gi, 32, 1024, 64 * kb}; } r -= 3 * I5;
    if (r < I6) { const int kb = r / 176, gi = r % 176; const int pn = gi >> 3, gl = gi & 7, bj = gl >> 2;
        const float* W = (bj ? a.in[23] : a.in[22]) + (size_t)l * 1024 * D_FF;
        return XDesc{W, Wb + W_GU / 2 + (size_t)(32 * gi) * 1024, D_FF, 128 * pn + 32 * (gl & 3), 32, 1024, 64 * kb}; } r -= I6;
    { const int kb = r / 32, gi = r % 32; const float* W = a.in[24] + (size_t)l * D_FF * 1024;
        return XDesc{W, Wb + W_D / 2 + (size_t)(32 * gi) * D_FF, 1024, 32 * gi, 32, D_FF, 64 * kb}; }
}
__device__ __forceinline__ void weights_phase(const Args& a, int l, LAS unsigned char* lds, int gw, int ngw, int wave, int lane) {
    LAS float* scr = (LAS float*)(lds + wave * 16384);
    bf16_t* Wb = (bf16_t*)(opq(a.ws) + WS_W);
    constexpr int NIT = 16 * 64 + 16 * 152 + 4 * 64 + 32 * 16 + 3 * 16 * 32 + 16 * 176 + 44 * 32;
    if (gw >= NIT) return;
    const int n = lane & 31, kh = lane >> 5;
    float vc[32];
    XDesc dc = xdesc(a, l, Wb, gw);
#pragma unroll
    for (int i = 0; i < 32; ++i) vc[i] = (n < dc.valid) ? dc.W[(size_t)(dc.k0 + 2 * i + kh) * dc.Ns + dc.col0 + n] : 0.f;
    for (int it = gw; it < NIT; it += ngw) {
        const int itn = it + ngw; const bool hasn = itn < NIT;
        float vn[32]; XDesc dn = dc;
        if (hasn) { dn = xdesc(a, l, Wb, itn);
#pragma unroll
            for (int i = 0; i < 32; ++i) vn[i] = (n < dn.valid) ? dn.W[(size_t)(dn.k0 + 2 * i + kh) * dn.Ns + dn.col0 + n] : 0.f; }
        else {
#pragma unroll
            for (int i = 0; i < 32; ++i) vn[i] = 0.f; }
#pragma unroll
        for (int i = 0; i < 32; ++i) scr[(2 * i + kh) * 33 + n] = vc[i];
        asm volatile("s_waitcnt lgkmcnt(0)" ::: "memory");
        const int c = lane & 7;
#pragma unroll
        for (int j = 0; j < 4; ++j) { const int nn = (lane >> 3) + 8 * j; const LAS float* s = scr + (8 * c) * 33 + nn;
            u32x4 o; o.x = pk_bf16(s[0 * 33], s[1 * 33]); o.y = pk_bf16(s[2 * 33], s[3 * 33]); o.z = pk_bf16(s[4 * 33], s[5 * 33]); o.w = pk_bf16(s[6 * 33], s[7 * 33]);
            *(u32x4*)(dc.dst + (size_t)nn * dc.K + dc.k0 + 8 * c) = o; }
        asm volatile("s_waitcnt lgkmcnt(0)" ::: "memory");
#pragma unroll
        for (int i = 0; i < 32; ++i) vc[i] = vn[i];
        dc = dn;
    }
}

__device__ __forceinline__ void rms_phase(const float* x, const float* g, bf16_t* out, int gw, int ngw, int lane) {
    f32x4 gv[4];
#pragma unroll
    for (int j = 0; j < 4; ++j) gv[j] = ((const f32x4*)g)[lane + 64 * j];
    for (int m0 = gw; m0 < MTOK; m0 += 4 * ngw) {
        f32x4 v[4][4];
#pragma unroll
        for (int e = 0; e < 4; ++e) { const int m = m0 + e * ngw; const f32x4* xr = (const f32x4*)(x + (size_t)(m < MTOK ? m : m0) * 1024) + lane;
#pragma unroll
            for (int j = 0; j < 4; ++j) v[e][j] = xr[64 * j]; }
#pragma unroll
        for (int e = 0; e < 4; ++e) { const int m = m0 + e * ngw; float s = 0.f;
#pragma unroll
            for (int j = 0; j < 4; ++j) s += (v[e][j][0] * v[e][j][0] + v[e][j][1] * v[e][j][1]) + (v[e][j][2] * v[e][j][2] + v[e][j][3] * v[e][j][3]);
            const float rinv = rsqrtf(wave_sum(s) * (1.f / 1024.f) + EPS);
            if (m < MTOK) { u32x2* o8 = (u32x2*)(out + (size_t)m * 1024) + lane;
#pragma unroll
                for (int j = 0; j < 4; ++j) { u32x2 w; w.x = pk_bf16(v[e][j][0] * rinv * gv[j][0], v[e][j][1] * rinv * gv[j][1]); w.y = pk_bf16(v[e][j][2] * rinv * gv[j][2], v[e][j][3] * rinv * gv[j][3]); o8[64 * j] = w; } } }
    }
}

namespace att {
constexpr int NST = 5, DEPTH_INFLIGHT = 4;
constexpr int STAGE = 16384;
constexpr int OFF_WS = NST * STAGE, WS_PER_WAVE = 8192 + 256;
__device__ __forceinline__ int crow(int r, int hi) { return (r & 3) + 8 * (r >> 2) + 4 * hi; }
__device__ __forceinline__ s16x4 vtr(const LAS unsigned char* p) { typedef short v4i16_t __attribute__((ext_vector_type(4))); return __builtin_bit_cast(s16x4, __builtin_amdgcn_ds_read_tr16_b64_v4i16((LAS v4i16_t*)p)); }

__device__ __forceinline__ void job_decode(int j, int nct, int qi, int kt0, int& type, int& tile) {
    if (j < nct) { type = 1; tile = j; } else if (j < nct + qi + 1) { type = 2; tile = j - nct; } else { type = 3; tile = kt0 + (j - nct - qi - 1); }
}

__device__ __forceinline__ void attn_phase(LAS unsigned char* lds, const bf16_t* KVB, const bf16_t* KC, const bf16_t* VC, const bf16_t* YO, bf16_t* OUT, int ldo, const float* NG, const float* qn, const float* kn) {
    const int tid = tid_opq(), lane = tid & 63, w = __builtin_amdgcn_readfirstlane(tid >> 6), q = lane & 31, hi = lane >> 5, hh = q >> 3, tl = q & 7;
    LAS float* impw = (LAS float*)(lds + OFF_WS + w * WS_PER_WAVE);
    LAS float* rs = impw + 2048;
    LAS float* rs2 = rs + 32;
    const float gq = wave_max(fabsf(qn[lane]));
    const float nB0 = -8.5f * LOG2E * gq * wave_max(fabsf(kn[lane]));
    const float nB1 = -8.5f * LOG2E * gq * wave_max(fabsf(kn[64 + lane]));
    const float nB2 = -8.5f * LOG2E * gq * wave_max(fabsf(kn[128 + lane]));
    const int G = gd_opq(), bx = bx_opq();
    const int drow = 8 * w + (lane >> 3), dsl = lane & 7;
    const unsigned dkoff = (unsigned)(drow * 128 + ((dsl ^ ((drow >> 1) & 7)) * 16));
    const unsigned dvoff = (unsigned)(drow * 128 + ((dsl ^ (4 * ((drow >> 1) & 1))) * 16));
    const unsigned ldsw = (unsigned)w * 1024u;
    const int kfx = (q >> 1) & 7;
    const int qrow = (lane & 15) >> 2, pcol = lane & 3, cgp = (lane >> 4) & 1, fbit = (qrow >> 1) & 1;
    const int vbase = (4 * hi + qrow) * 128 + (2 * cgp + (pcol >> 1)) * 16 + 8 * (pcol & 1);
    const int vb0 = vbase + fbit * 64, vb1 = vbase + (fbit ^ 1) * 64;
#define ATT_WAIT_BAR(N) asm volatile("s_waitcnt vmcnt(" #N ") lgkmcnt(0)\n\ts_barrier" ::: "memory")
    for (int it = 0;; ++it) {
        int qi, bg;
        if (G == 256) { if (it >= 8) break; const int r = bx >> 5; qi = 8 * (7 - it) + ((it & 1) ? r : 7 - r); bg = bx & 31; }
        else { const int idx = it * G + bx; if (idx >= 2048) break; qi = 63 - (idx >> 5); bg = idx & 31; }
        const int b = bg >> 2, g = bg & 3;
        const int tt = w * 8 + tl, tq = qi * 64 + tt;
        const size_t row = (size_t)b * 4096 + tq;
        const int head = g * 4 + hh;
        bf16x8 qf[4];
#pragma unroll
        for (int d0 = 0; d0 < 4; ++d0) qf[d0] = *(const bf16x8*)(YO + row * 2048 + 1024 + head * 64 + 16 * d0 + 8 * hi);
        const int cmaxq = (tq - 31) >> 4;
        const int nct = (4 * qi + 2) / 64 + 1;
        const int nw = (qi < 8 ? qi : 8) + 1, kt0 = qi - (nw - 1);
        const int NJ = nct + (qi + 1) + nw;
        const char* kcb = (const char*)(KC + (size_t)bg * 256 * 64); const char* vcb = (const char*)(VC + (size_t)bg * 256 * 64);
        const char* ksb = (const char*)(KVB + 2 * KVBUF + (size_t)bg * 4096 * 64); const char* vsb = (const char*)(KVB + 3 * KVBUF + (size_t)bg * 4096 * 64);
        const char* kwb = (const char*)(KVB + 4 * KVBUF + (size_t)bg * 4096 * 64); const char* vwb = (const char*)(KVB + 5 * KVBUF + (size_t)bg * 4096 * 64);
#define ATT_ISSUE(j_, st_) do { int ty_, tile_; job_decode((j_) < NJ ? (j_) : NJ - 1, nct, qi, kt0, ty_, tile_); \
            const char* kp_ = (ty_ < 2 ? kcb : (ty_ == 2 ? ksb : kwb)) + (size_t)tile_ * 8192; const char* vp_ = (ty_ < 2 ? vcb : (ty_ == 2 ? vsb : vwb)) + (size_t)tile_ * 8192; \
            __builtin_amdgcn_global_load_lds((const unsigned*)(kp_ + dkoff), (LAS unsigned*)(lds + (st_) * STAGE + ldsw), 16, 0, 0); \
            __builtin_amdgcn_global_load_lds((const unsigned*)(vp_ + dvoff), (LAS unsigned*)(lds + (st_) * STAGE + 8192 + ldsw), 16, 0, 0); } while (0)
        ATT_ISSUE(0, 0); ATT_ISSUE(1, 1); ATT_ISSUE(2, 2);
        f32x16 ofin[2], ocur[2];
#pragma unroll
        for (int r = 0; r < 16; ++r) { ofin[0][r] = 0.f; ofin[1][r] = 0.f; ocur[0][r] = 0.f; ocur[1][r] = 0.f; }
        float lsum = 0.f, carry = 0.f;
        unsigned long long mymask = (2ull << qi) - 1ull, unionmask = mymask;
        int st_cur = 0, st_iss = 3;
        for (int jp = 0; jp < NJ; jp += 2) {
            ATT_WAIT_BAR(2);
            ATT_ISSUE(jp + 3, st_iss); st_iss = (st_iss == NST - 1) ? 0 : st_iss + 1;
            ATT_ISSUE(jp + 4, st_iss); st_iss = (st_iss == NST - 1) ? 0 : st_iss + 1;
          for (int half = 0; half < 2; ++half) {
            const int j = jp + half; if (j >= NJ) break;
            int type, tile; job_decode(j, nct, qi, kt0, type, tile);
            const LAS unsigned char* Kb = lds + st_cur * STAGE;
            const LAS unsigned char* Vb = Kb + 8192;
            st_cur = (st_cur == NST - 1) ? 0 : st_cur + 1;
            const bool skip = (type == 2) && (((unionmask >> tile) & 1ull) == 0ull);
            if (!skip) {
                const float nbT = type < 2 ? nB0 : (type == 2 ? nB1 : nB2);
                const unsigned long long msel = (type == 2) ? mymask : ~0ull;
                const float rowsel = (float)(unsigned)((msel >> tile) & 1ull);
                const float nB = fmaf(rowsel, nbT, fmaf(rowsel, 30000.f, -30000.f));
                f32x16 p0, p1, cin;
#pragma unroll
                for (int r = 0; r < 16; ++r) cin[r] = nB;
#define ATT_QK2() do { \
                p0 = __builtin_amdgcn_mfma_f32_32x32x16_bf16(*(const LAS bf16x8*)(Kb + q * 128 + (hi ^ kfx) * 16), qf[0], cin, 0, 0, 0); \
                _Pragma("unroll") for (int d0 = 1; d0 < 4; ++d0) p0 = __builtin_amdgcn_mfma_f32_32x32x16_bf16(*(const LAS bf16x8*)(Kb + q * 128 + ((2 * d0 + hi) ^ kfx) * 16), qf[d0], p0, 0, 0, 0); \
                p1 = __builtin_amdgcn_mfma_f32_32x32x16_bf16(*(const LAS bf16x8*)(Kb + (32 + q) * 128 + (hi ^ kfx) * 16), qf[0], cin, 0, 0, 0); \
                _Pragma("unroll") for (int d0 = 1; d0 < 4; ++d0) p1 = __builtin_amdgcn_mfma_f32_32x32x16_bf16(*(const LAS bf16x8*)(Kb + (32 + q) * 128 + ((2 * d0 + hi) ^ kfx) * 16), qf[d0], p1, 0, 0, 0); } while (0)
#define ATT_PV2() do { _Pragma("unroll") for (int s = 0; s < 4; ++s) { u32x4 pw; \
                    if (s < 2) { pw.x = pk_bf16(p0[8 * s], p0[8 * s + 1]); pw.y = pk_bf16(p0[8 * s + 2], p0[8 * s + 3]); pw.z = pk_bf16(p0[8 * s + 4], p0[8 * s + 5]); pw.w = pk_bf16(p0[8 * s + 6], p0[8 * s + 7]); } \
                    else { const int s2 = s - 2; pw.x = pk_bf16(p1[8 * s2], p1[8 * s2 + 1]); pw.y = pk_bf16(p1[8 * s2 + 2], p1[8 * s2 + 3]); pw.z = pk_bf16(p1[8 * s2 + 4], p1[8 * s2 + 5]); pw.w = pk_bf16(p1[8 * s2 + 6], p1[8 * s2 + 7]); } \
                    const bf16x8 pa = __builtin_bit_cast(bf16x8, pw); \
                    { const s16x4 vlo = vtr(Vb + s * 2048 + vb0), vhi = vtr(Vb + s * 2048 + 1024 + vb0); \
                      const bf16x8 vf = (bf16x8){vlo[0], vlo[1], vlo[2], vlo[3], vhi[0], vhi[1], vhi[2], vhi[3]}; ocur[0] = __builtin_amdgcn_mfma_f32_32x32x16_bf16(pa, vf, ocur[0], 0, 0, 0); } \
                    { const s16x4 vlo = vtr(Vb + s * 2048 + vb1), vhi = vtr(Vb + s * 2048 + 1024 + vb1); \
                      const bf16x8 vf = (bf16x8){vlo[0], vlo[1], vlo[2], vlo[3], vhi[0], vhi[1], vhi[2], vhi[3]}; ocur[1] = __builtin_amdgcn_mfma_f32_32x32x16_bf16(pa, vf, ocur[1], 0, 0, 0); } } } while (0)
                const bool interior = (type == 2 && tile < qi) || (type == 3 && tile > qi - 8 && tile < qi);
                if (interior) {
                    ATT_QK2();
                    float ps = 0.f, ps1 = 0.f;
#pragma unroll
                    for (int r = 0; r < 16; ++r) { p0[r] = ex2(p0[r]); ps += p0[r]; }
#pragma unroll
                    for (int r = 0; r < 16; ++r) { p1[r] = ex2(p1[r]); ps1 += p1[r]; }
                    lsum += ps + ps1;
                    ATT_PV2();
                } else {
                    ATT_QK2();
                    int lo = 0, hiq = 63;
                    if (type < 2) hiq = cmaxq - 64 * tile;
                    else if (type == 2) { if (tile == qi) hiq = tt; }
                    else { if (tile == qi - 8) lo = tt + 1; if (tile == qi) hiq = tt; }
                    float ps = 0.f;
#pragma unroll
                    for (int r = 0; r < 16; ++r) { const int k0i = crow(r, hi), k1i = k0i + 32;
                        p0[r] = (k0i >= lo && k0i <= hiq) ? ex2(p0[r]) : 0.f; p1[r] = (k1i >= lo && k1i <= hiq) ? ex2(p1[r]) : 0.f; ps += p0[r] + p1[r]; }
                    lsum += ps;
                    if (type == 1 && qi >= 16) {
                        float s4[8], b3[8], pb[8];
#pragma unroll
                        for (int a = 0; a < 4; ++a) { s4[a] = (p0[4 * a] + p0[4 * a + 1]) + (p0[4 * a + 2] + p0[4 * a + 3]); b3[a] = p0[4 * a + 3];
                            s4[4 + a] = (p1[4 * a] + p1[4 * a + 1]) + (p1[4 * a + 2] + p1[4 * a + 3]); b3[4 + a] = p1[4 * a + 3]; }
#pragma unroll
                        for (int x = 0; x < 8; ++x) pb[x] = __shfl_xor(b3[x], 32);
#pragma unroll
                        for (int x = 0; x < 8; ++x) { const float extra = hi ? pb[x] : (x == 0 ? carry : pb[x == 0 ? 0 : x - 1]);
                            const int n = 16 * tile + 2 * (x & 3) + hi + 8 * (x >> 2);
                            impw[q * 64 + n] = s4[x] + extra; }
                        carry = pb[7];
                    }
                    ATT_PV2();
                }
#undef ATT_QK2
#undef ATT_PV2
            }
            const bool end_c2 = (type == 1 && tile == nct - 1), end_s = (type == 2 && tile == qi), end_w = (type == 3 && tile == qi);
            if (end_c2 || end_s || end_w) {
                const float l = lsum + __shfl_xor(lsum, 32);
                const float gt_ = NG[row * 64 + (end_c2 ? 0 : (end_s ? 16 : 32)) + head];
                const float linv = l > 0.f ? 1.f / l : 0.f;
                const float sc = gt_ * linv;
                if (hi == 0) { rs[q] = sc; if (end_c2) rs2[q] = linv; }
#pragma unroll
                for (int r = 0; r < 16; ++r) { const float f = rs[crow(r, hi)]; ofin[0][r] += f * ocur[0][r]; ofin[1][r] += f * ocur[1][r]; ocur[0][r] = 0.f; ocur[1][r] = 0.f; }
                lsum = 0.f;
            }
            if (end_c2 && qi >= 16) {
                unionmask = 0ull; mymask = 0ull;
                for (int i = 0; i < 8; ++i) {
                    const int n = lane; const bool valid = n <= qi, forced = (n == 0) || (n == qi) || (n == qi - 1);
                    const float sc = forced ? 1e6f : (impw[i * 64 + n] * rs2[i] + impw[(8 + i) * 64 + n] * rs2[8 + i]) + (impw[(16 + i) * 64 + n] * rs2[16 + i] + impw[(24 + i) * 64 + n] * rs2[24 + i]);
                    const unsigned key = valid ? ((__float_as_uint(sc) & ~63u) | (unsigned)(63 - n)) : 0u;
                    unsigned T = 0u;
#pragma unroll
                    for (int bit = 30; bit >= 0; --bit) { const unsigned cand = T | (1u << bit); const unsigned long long bm = __ballot(key >= cand); if (__popcll(bm) >= 16) T = cand; }
                    const unsigned long long mk = __ballot(valid && key >= T);
                    unionmask |= mk; if (tl == i) mymask = mk;
                }
            }
          }
        }
#pragma unroll
        for (int r = 0; r < 16; ++r) { const int qq = crow(r, hi); const size_t orow = (size_t)b * 4096 + qi * 64 + w * 8 + (qq & 7);
            bf16_t* op = OUT + orow * ldo + (g * 4 + (qq >> 3)) * 64 + q;
            op[0] = (bf16_t)(pk_bf16(ofin[0][r], 0.f) & 0xffffu); op[32] = (bf16_t)(pk_bf16(ofin[1][r], 0.f) & 0xffffu); }
        ATT_WAIT_BAR(0);
#undef ATT_ISSUE
    }
#undef ATT_WAIT_BAR
}
}


#define XB_TMO      128
#define XB_XCNT(j)  (256  + 64 * (j))
#define XB_XSUB(j)  (1280 + 64 * (j))
#define XB_XGEN(j)  (2304 + 64 * (j))
#define XB_TOP      3328
#define XB_TOPGEN   3392
#define XCD_BAR_WORDS 3456
#define XB_SPIN_CAP (1u << 22)
__device__ __forceinline__ unsigned xb_ld(unsigned* p)              { return __hip_atomic_load(p, __ATOMIC_RELAXED, __HIP_MEMORY_SCOPE_AGENT); }
__device__ __forceinline__ unsigned xb_add(unsigned* p, unsigned v) { return __hip_atomic_fetch_add(p, v, __ATOMIC_RELAXED, __HIP_MEMORY_SCOPE_AGENT); }
__device__ __forceinline__ unsigned xb_xcc_id() { return (unsigned)__builtin_amdgcn_s_getreg((3 << 11) | 20) & 0xFu; }
#define XB_SPIN(cond, bar) do { unsigned _sp = 0; while (cond) { __builtin_amdgcn_s_sleep(1); \
    if ((++_sp & 255u) == 0u) { if (xb_ld(&(bar)[XB_TMO])) break; if (_sp > XB_SPIN_CAP) { atomicAdd(&(bar)[XB_TMO], 1u); break; } } } } while (0)
struct XcdBarrier { unsigned* bar; unsigned x; volatile LAS unsigned* st; };
__device__ __forceinline__ void xcd_barrier_complete(unsigned* bar, unsigned x, unsigned& nloc, unsigned& nx) {
    const unsigned G = gridDim.x * gridDim.y * gridDim.z;
    unsigned sum, cnt, mine, sp = 0u;
    for (;;) {
        sum = 0u; cnt = 0u; mine = 0u;
#pragma unroll
        for (unsigned j = 0; j < 16; ++j) { const unsigned c = xb_ld(&bar[XB_XCNT(j)]); sum += c; cnt += (c > 0u) ? 1u : 0u; mine = (j == x) ? c : mine; }
        if (sum == G) break;
        __builtin_amdgcn_s_sleep(1);
        if ((++sp & 255u) == 0u) { if (xb_ld(&bar[XB_TMO])) break; if (sp > XB_SPIN_CAP) { atomicAdd(&bar[XB_TMO], 1u); break; } }
    }
    nloc = mine > 0u ? mine : 1u; nx = cnt > 0u ? cnt : 1u;
}
__device__ __forceinline__ void xcd_barrier(unsigned* bar, volatile LAS unsigned* st) {
    asm volatile("s_waitcnt vmcnt(0)" ::: "memory");
    __syncthreads();
    if (threadIdx.x == 0) {
        const unsigned x = xb_xcc_id();
        __builtin_amdgcn_s_waitcnt(0);
        unsigned nloc = st[0], nx = st[1];
        if (nloc == 0u) { xcd_barrier_complete(bar, x, nloc, nx); st[0] = nloc; st[1] = nx; }
        const unsigned old = xb_add(&bar[XB_XSUB(x)], 1u);
        const unsigned gen = old / nloc;
        if (old + 1u == (gen + 1u) * nloc) {
            __builtin_amdgcn_fence(__ATOMIC_RELEASE, "agent");
            asm volatile("s_waitcnt vmcnt(0)" ::: "memory");
            const unsigned og = xb_add(&bar[XB_TOP], 1u);
            const unsigned tg = og / nx;
            if (og + 1u == (tg + 1u) * nx) xb_add(&bar[XB_TOPGEN], 1u);
            else XB_SPIN(xb_ld(&bar[XB_TOPGEN]) == tg, bar);
            __builtin_amdgcn_fence(__ATOMIC_ACQUIRE, "agent");
            xb_add(&bar[XB_XGEN(x)], 1u);
            asm volatile("s_waitcnt vmcnt(0)" ::: "memory");
        } else {
            XB_SPIN(xb_ld(&bar[XB_XGEN(x)]) == gen, bar);
            __builtin_amdgcn_fence(__ATOMIC_ACQUIRE, "agent");
            asm volatile("s_waitcnt vmcnt(0)" ::: "memory");
        }
    }
    __syncthreads();
}

constexpr int LDS_BYTES = 155648;
constexpr int NPH = 16;

__device__ __forceinline__ unsigned char* opq(unsigned char* p) { asm volatile("" : "+s"(p)); return p; }
#define WSP(off) ((bf16_t*)(opq(a.ws) + (off)))
#define WSF(off) ((float*)(opq(a.ws) + (off)))

__global__ void __launch_bounds__(512, 2) mega(Args a) {
    extern __shared__ __attribute__((aligned(16))) unsigned char lds_raw[];
    LAS unsigned char* lds = (LAS unsigned char*)lds_raw;
    cg::grid_group grid = cg::this_grid();
    const int lo = a.ph_lo, hi = a.ph_hi;
    volatile LAS unsigned* xst = (volatile LAS unsigned*)(lds + 155648 - 64);
    if (threadIdx.x == 0) { xst[0] = 0u; xst[1] = 0u; if (hi - lo > 1) (void)xb_add(&((unsigned*)(a.ws + WS_BAR))[XB_XCNT(xb_xcc_id())], 1u); }
    __syncthreads();
#define IDS const int tid = tid_opq(), lane = tid & 63, wave = __builtin_amdgcn_readfirstlane(tid >> 6); const int G = gd_opq(), bx = bx_opq(); \
    const int gw = bx * 8 + wave, ngw = G * 8, gt = bx * 512 + tid, ngt = G * 512; (void)lane; (void)gw; (void)ngw; (void)gt; (void)ngt;
#define IN(k) (lo <= (l * NPH + (k)) && (l * NPH + (k)) < hi)
#define SEAM(k) do { if (lo <= (l * NPH + (k)) && (l * NPH + (k)) + 1 < hi) { if (hi < 0) grid.sync(); xcd_barrier((unsigned*)(opq(a.ws) + WS_BAR), xst); if (PROBE_SYNC2) xcd_barrier((unsigned*)(opq(a.ws) + WS_BAR), xst); } } while (0)
    for (int l = 0; l < DEPTH; ++l) {
        for (int rep_ = 0; rep_ < ((PROBE_DUP >> 0) & 1) + 1; ++rep_) if (IN(0)) {
            IDS
            weights_phase(a, l, lds, gw, ngw, wave, lane);
            rms_phase((l == 0) ? a.in[0] : a.out, a.in[1] + l * 1024, WSP(WS_H), gw, ngw, lane);
        }
        SEAM(0);
        for (int rep_ = 0; rep_ < ((PROBE_DUP >> 1) & 1) + 1; ++rep_) if (IN(1)) {
            pg8::StaticOrder S; pg8::Gemm g{WSP(WS_H), WSP(WS_W + W_INA), MTOK, 2048, 1024, 1024, 0, 0}; S.init(MTOK, 2048, gd_opq(), bx_opq());
            EpiInA E{WSP(WS_RX), WSP(WS_YO)}; pg8::gemm_phase<EpiInA>(lds, g, S, E);
        }
        SEAM(1);
        for (int rep_ = 0; rep_ < ((PROBE_DUP >> 2) & 1) + 1; ++rep_) if (IN(2)) {
            IDS
            const bf16_t* RX = WSP(WS_RX); bf16_t* XR = WSP(WS_XR); const bf16_t* Wc1 = WSP(WS_W + W_C1); float* bias1 = WSF(WS_CTL);
            const float* cw = a.in[3] + l * 4 * 1024; const float* cb = a.in[4] + l * 1024;
            {
                const int ch = (gt & 127) * 8;
                f32x4 cwv[4][2]; f32x4 cbv[2];
#pragma unroll
                for (int kk = 0; kk < 4; ++kk) { cwv[kk][0] = *(const f32x4*)(cw + kk * 1024 + ch); cwv[kk][1] = *(const f32x4*)(cw + kk * 1024 + ch + 4); }
                cbv[0] = *(const f32x4*)(cb + ch); cbv[1] = *(const f32x4*)(cb + ch + 4);
                const bool chfix = (ngt & 127) == 0;
                for (int it0 = gt; it0 < MTOK * 128; it0 += 4 * ngt) {
                    u32x4 xw[4][4]; int rowv[4]; bool ok[4];
#pragma unroll
                    for (int e = 0; e < 4; ++e) { const int it = it0 + e * ngt; ok[e] = it < MTOK * 128; const int itc = ok[e] ? it : it0; rowv[e] = itc >> 7; const int s = rowv[e] & 4095;
#pragma unroll
                        for (int kk = 0; kk < 4; ++kk) xw[e][kk] = (s - 3 + kk >= 0) ? *(const u32x4*)(RX + (size_t)(rowv[e] - 3 + kk) * 1024 + ch) : (u32x4){0u, 0u, 0u, 0u}; }
#pragma unroll
                    for (int e = 0; e < 4; ++e) {
                        float acc[8] = {cbv[0][0], cbv[0][1], cbv[0][2], cbv[0][3], cbv[1][0], cbv[1][1], cbv[1][2], cbv[1][3]};
#pragma unroll
                        for (int kk = 0; kk < 4; ++kk) { const u32x4 w4 = xw[e][kk]; const f32x4 c0 = cwv[kk][0], c1 = cwv[kk][1];
                            acc[0] += c0[0] * bf_lo(w4.x); acc[1] += c0[1] * bf_hi(w4.x); acc[2] += c0[2] * bf_lo(w4.y); acc[3] += c0[3] * bf_hi(w4.y);
                            acc[4] += c1[0] * bf_lo(w4.z); acc[5] += c1[1] * bf_hi(w4.z); acc[6] += c1[2] * bf_lo(w4.w); acc[7] += c1[3] * bf_hi(w4.w); }
                        u32x4 o; o.x = pk_bf16(acc[0], acc[1]); o.y = pk_bf16(acc[2], acc[3]); o.z = pk_bf16(acc[4], acc[5]); o.w = pk_bf16(acc[6], acc[7]);
                        if (ok[e] && chfix) *(u32x4*)(XR + (size_t)rowv[e] * 1024 + ch) = o; } }
                if (!chfix) {
                    for (int it = gt; it < MTOK * 128; it += ngt) { const int row = it >> 7, c2 = (it & 127) * 8, s = row & 4095; float acc[8];
#pragma unroll
                        for (int i = 0; i < 8; ++i) acc[i] = cb[c2 + i];
#pragma unroll
                        for (int kk = 0; kk < 4; ++kk) if (s - 3 + kk >= 0) { const u32x4 w4 = *(const u32x4*)(RX + (size_t)(row - 3 + kk) * 1024 + c2); const f32x4 c0 = *(const f32x4*)(cw + kk * 1024 + c2), c1 = *(const f32x4*)(cw + kk * 1024 + c2 + 4);
                            acc[0] += c0[0] * bf_lo(w4.x); acc[1] += c0[1] * bf_hi(w4.x); acc[2] += c0[2] * bf_lo(w4.y); acc[3] += c0[3] * bf_hi(w4.y);
                            acc[4] += c1[0] * bf_lo(w4.z); acc[5] += c1[1] * bf_hi(w4.z); acc[6] += c1[2] * bf_lo(w4.w); acc[7] += c1[3] * bf_hi(w4.w); }
                        u32x4 o; o.x = pk_bf16(acc[0], acc[1]); o.y = pk_bf16(acc[2], acc[3]); o.z = pk_bf16(acc[4], acc[5]); o.w = pk_bf16(acc[6], acc[7]);
                        *(u32x4*)(XR + (size_t)row * 1024 + c2) = o; } }
            }
            if (gt < 1024) { const float lm = a.in[9][l * 1024 + gt]; const float e = __expf(-fabsf(lm)); const float lp = e < 0.03f ? e * (1.f - e * (0.5f - e * (0.33333333f - 0.25f * e))) : __logf(1.f + e); bias1[1024 + gt] = -8.f * LOG2E * (fmaxf(-lm, 0.f) + lp); }
            for (int j = gw; j < 512; j += ngw) { const float* pos = (j >> 8 ? a.in[13] : a.in[12]) + l * 2048; const bf16_t* wr_ = Wc1 + (size_t)j * 2048;
                float s = 0.f;
                for (int kk = lane; kk < 2048; kk += 64) s += pos[kk] * __uint_as_float((unsigned)wr_[kk] << 16);
                s = wave_sum(s); if (lane == 0) bias1[j] = s; }
        }
        SEAM(2);
        for (int rep_ = 0; rep_ < ((PROBE_DUP >> 3) & 1) + 1; ++rep_) if (IN(3)) {
            pg8::StaticOrder S; pg8::Gemm g{WSP(WS_XR), WSP(WS_W + W_G), MTOK, 2048, 256, 1024, 2, 0}; S.init(MTOK, 2048, gd_opq(), bx_opq());
            EpiGate E{WSP(WS_XR), WSP(WS_LA), WSP(WS_U), a.in[6] + l * 1024, a.in[8] + l * 1024, WSF(WS_CTL) + 1024}; pg8::gemm_phase<EpiGate>(lds, g, S, E);
        }
        SEAM(3);
        for (int rep_ = 0; rep_ < ((PROBE_DUP >> 4) & 1) + 1; ++rep_) if (IN(4)) {
            IDS
            const bf16_t* LA = WSP(WS_LA); const bf16_t* U = WSP(WS_U); float* AGA = WSF(WS_AGG); float* AGH = AGA + 8 * 64 * 1024;
            for (int it = gt; it < 8 * 64 * 256; it += ngt) { const int cq = it & 255, bc = it >> 8; const int ch = 4 * cq; const size_t row0 = (size_t)bc * 64;
                float s[4] = {0.f, 0.f, 0.f, 0.f}, h[4] = {0.f, 0.f, 0.f, 0.f};
#pragma unroll 8
                for (int t = 0; t < 64; ++t) { const u32x2 wl = *(const u32x2*)(LA + (row0 + t) * 1024 + ch), wu = *(const u32x2*)(U + (row0 + t) * 1024 + ch);
                    const float l0 = bf_lo(wl.x), l1 = bf_hi(wl.x), l2 = bf_lo(wl.y), l3 = bf_hi(wl.y); s[0] += l0; s[1] += l1; s[2] += l2; s[3] += l3;
                    h[0] = ex2(l0) * h[0] + bf_lo(wu.x); h[1] = ex2(l1) * h[1] + bf_hi(wu.x); h[2] = ex2(l2) * h[2] + bf_lo(wu.y); h[3] = ex2(l3) * h[3] + bf_hi(wu.y); }
                *(f32x4*)(AGA + (size_t)bc * 1024 + ch) = (f32x4){ex2(s[0]), ex2(s[1]), ex2(s[2]), ex2(s[3])}; *(f32x4*)(AGH + (size_t)bc * 1024 + ch) = (f32x4){h[0], h[1], h[2], h[3]}; }
        }
        SEAM(4);
        if (IN(5)) {
            IDS
            const bf16_t* LA = WSP(WS_LA); const bf16_t* U = WSP(WS_U); bf16_t* YO = WSP(WS_YO); const float* AGA = WSF(WS_AGG); const float* AGH = AGA + 8 * 64 * 1024;
            for (int it = gt; it < 8 * 64 * 256; it += ngt) { const int cq = it & 255, bc = it >> 8; const int ch = 4 * cq; const size_t row0 = (size_t)bc * 64; const int c = bc & 63, b0 = bc - c;
                f32x4 h = (f32x4){0.f, 0.f, 0.f, 0.f};
                {   int cc = 0;
                    for (; cc + 8 <= c; cc += 8) { f32x4 A[8], Hh[8];
#pragma unroll
                        for (int k = 0; k < 8; ++k) { A[k] = *(const f32x4*)(AGA + (size_t)(b0 + cc + k) * 1024 + ch); Hh[k] = *(const f32x4*)(AGH + (size_t)(b0 + cc + k) * 1024 + ch); }
#pragma unroll
                        for (int k = 0; k < 8; ++k) h = A[k] * h + Hh[k]; }
                    for (; cc < c; ++cc) { const f32x4 A = *(const f32x4*)(AGA + (size_t)(b0 + cc) * 1024 + ch), Hh = *(const f32x4*)(AGH + (size_t)(b0 + cc) * 1024 + ch); h = A * h + Hh; } }
                for (int t0 = 0; t0 < 64; t0 += 8) { u32x2 wl[8], wu[8], gy[8];
#pragma unroll
                    for (int k = 0; k < 8; ++k) { wl[k] = *(const u32x2*)(LA + (row0 + t0 + k) * 1024 + ch); wu[k] = *(const u32x2*)(U + (row0 + t0 + k) * 1024 + ch); gy[k] = *(const u32x2*)(YO + (row0 + t0 + k) * 2048 + ch); }
#pragma unroll
                    for (int k = 0; k < 8; ++k) { h[0] = ex2(bf_lo(wl[k].x)) * h[0] + bf_lo(wu[k].x); h[1] = ex2(bf_hi(wl[k].x)) * h[1] + bf_hi(wu[k].x); h[2] = ex2(bf_lo(wl[k].y)) * h[2] + bf_lo(wu[k].y); h[3] = ex2(bf_hi(wl[k].y)) * h[3] + bf_hi(wu[k].y);
                        u32x2 o; o.x = pk_bf16(h[0] * bf_lo(gy[k].x), h[1] * bf_hi(gy[k].x)); o.y = pk_bf16(h[2] * bf_lo(gy[k].y), h[3] * bf_hi(gy[k].y)); gy[k] = o; }
#pragma unroll
                    for (int k = 0; k < 8; ++k) *(u32x2*)(YO + (row0 + t0 + k) * 2048 + ch) = gy[k]; }
            }
        }
        SEAM(5);
        for (int rep_ = 0; rep_ < ((PROBE_DUP >> 6) & 1) + 1; ++rep_) if (IN(6)) {
            pg8::StaticOrder S; pg8::Gemm g{WSP(WS_H), WSP(WS_W + W_INB), MTOK, 4864, 1024, 1024, 0, 0}; S.init(MTOK, 4864, gd_opq(), bx_opq());
            EpiInB E{WSP(WS_YO), WSP(WS_RX), WSP(WS_LA), WSF(WS_NG), a.in[10] + l * 64, a.in[11] + l * 192}; pg8::gemm_phase<EpiInB>(lds, g, S, E);
        }
        SEAM(6);
        for (int rep_ = 0; rep_ < ((PROBE_DUP >> 7) & 1) + 1; ++rep_) if (IN(7)) {
            pg8::StaticOrder S; pg8::Gemm g{WSP(WS_RX), WSP(WS_W + W_C1), 16384, 256, 2048, 1024, 0, 32}; S.init(16384, 256, gd_opq(), bx_opq());
            EpiCmp1 E{WSP(WS_HID), WSF(WS_CTL)}; pg8::gemm_phase<EpiCmp1>(lds, g, S, E);
        }
        SEAM(7);
        for (int rep_ = 0; rep_ < ((PROBE_DUP >> 8) & 1) + 1; ++rep_) if (IN(8)) {
            IDS
            const bf16_t* HID = WSP(WS_HID); bf16_t* KC = WSP(WS_KC); bf16_t* VC = WSP(WS_VC);
            const float* kn0 = a.in[11] + l * 192;
            LAS float* w2s = (LAS float*)lds;
            for (int i = tid; i < 2 * 4096; i += 512) { const f32x4 v = (i < 4096) ? ((const f32x4*)(a.in[15] + (size_t)l * 16384))[i] : ((const f32x4*)(a.in[17] + (size_t)l * 16384))[i - 4096]; *(LAS f32x4*)(w2s + 4 * i) = v; }
            __syncthreads();
            for (int r0 = gw * 4; r0 < 16384; r0 += ngw * 4) {
                const int which = r0 >> 13;
                const LAS float* wq = w2s + which * 16384 + lane;
                const unsigned* hp = (const unsigned*)(HID + (size_t)r0 * 256);
                float acc0 = 0.f, acc1 = 0.f, acc2 = 0.f, acc3 = 0.f;
#pragma unroll 4
                for (int h2 = 0; h2 < 128; ++h2) {
                    const float w0 = wq[(2 * h2) * 64], w1 = wq[(2 * h2 + 1) * 64];
                    const unsigned x0 = hp[h2], x1 = hp[128 + h2], x2 = hp[256 + h2], x3 = hp[384 + h2];
                    acc0 += bf_lo(x0) * w0 + bf_hi(x0) * w1; acc1 += bf_lo(x1) * w0 + bf_hi(x1) * w1;
                    acc2 += bf_lo(x2) * w0 + bf_hi(x2) * w1; acc3 += bf_lo(x3) * w0 + bf_hi(x3) * w1; }
                float accv[4] = {acc0, acc1, acc2, acc3};
#pragma unroll
                for (int e = 0; e < 4; ++e) { const int r = r0 + e, rr = r & 8191, c = rr & 255, bgi = rr >> 8;
                    bf16_t* dst = (which ? VC : KC) + ((size_t)bgi * 256 + c) * 64;
                    float v = accv[e];
                    if (!which) { const float ss = wave_sum(v * v); v *= rsqrtf(ss * (1.f / 64.f) + EPS) * kn0[lane]; }
                    if (c == 255) v = 0.f;
                    dst[lane] = (bf16_t)(pk_bf16(v, 0.f) & 0xffffu); }
            }
            __syncthreads();
        }
        SEAM(8);
        if (IN(9)) {
            if (PROBE_DUP & (1 << 9)) att::attn_phase(lds, WSP(WS_RX), WSP(WS_KC), WSP(WS_VC), WSP(WS_YO), WSP(WS_H), 1024, WSF(WS_NG), a.in[10] + l * 64, a.in[11] + l * 192);
            att::attn_phase(lds, WSP(WS_RX), WSP(WS_KC), WSP(WS_VC), WSP(WS_YO), WSP(WS_YO) + 1024, 2048, WSF(WS_NG), a.in[10] + l * 64, a.in[11] + l * 192);
        }
        SEAM(9);
        if (IN(10)) {
            pg8::StaticOrder S; pg8::Gemm g{WSP(WS_YO), WSP(WS_W + W_YA), MTOK, 1024, 2048, 2048, 0, 0}; S.init(MTOK, 1024, gd_opq(), bx_opq());
            EpiMixM E{WSP(WS_H), WSP(WS_LA)}; pg8::gemm_phase<EpiMixM>(lds, g, S, E);
        }
        SEAM(10);
        if (IN(12)) {
            pg8::StaticOrder S; pg8::Gemm g{WSP(WS_H), WSP(WS_W + W_O), MTOK, 1024, 1024, 1024, 0, 0}; S.init(MTOK, 1024, gd_opq(), bx_opq());
            EpiRes E{(l == 0) ? a.in[0] : a.out, a.out}; pg8::gemm_phase<EpiRes>(lds, g, S, E);
        }
        SEAM(12);
        for (int rep_ = 0; rep_ < ((PROBE_DUP >> 13) & 1) + 1; ++rep_) if (IN(13)) {
            IDS
            rms_phase(a.out, a.in[21] + l * 1024, WSP(WS_H), gw, ngw, lane);
        }
        SEAM(13);
        for (int rep_ = 0; rep_ < ((PROBE_DUP >> 14) & 1) + 1; ++rep_) if (IN(14)) {
            pg8::StaticOrder S; pg8::Gemm g{WSP(WS_H), WSP(WS_W + W_GU), MTOK, 5632, 1024, 1024, 0, 0}; S.init(MTOK, 5632, gd_opq(), bx_opq());
            EpiSwi E{WSP(WS_RX)}; pg8::gemm_phase<EpiSwi>(lds, g, S, E);
        }
        SEAM(14);
        if (IN(15)) {
            pg8::StaticOrder S; pg8::Gemm g{WSP(WS_RX), WSP(WS_W + W_D), MTOK, 1024, D_FF, D_FF, 0, 0}; S.init(MTOK, 1024, gd_opq(), bx_opq());
            EpiRes E{a.out, a.out}; pg8::gemm_phase<EpiRes>(lds, g, S, E);
        }
        SEAM(15);
    }
#undef IDS
#undef IN
#undef SEAM
}

extern "C" void kernel_launch(void* const* d_in, const int* in_sizes, int n_in, void* d_out, int out_size, void* d_ws, size_t ws_size, hipStream_t stream) {
    static int grid = 0;
    if (grid == 0) {
        if (n_in != 25 || out_size != MTOK * DM || ws_size < WS_END) { fprintf(stderr, "kernel_launch: unexpected problem (n_in %d, out %d, ws %zu)\n", n_in, out_size, ws_size); grid = -1; return; }
        int dev = 0, cus = 0, per_cu = 0;
        hipGetDevice(&dev); hipDeviceGetAttribute(&cus, hipDeviceAttributeMultiprocessorCount, dev);
        hipFuncSetAttribute((const void*)mega, hipFuncAttributeMaxDynamicSharedMemorySize, LDS_BYTES);
        if (hipOccupancyMaxActiveBlocksPerMultiprocessor(&per_cu, (const void*)mega, 512, LDS_BYTES) != hipSuccess || per_cu < 1) per_cu = 1;
        (void)hipGetLastError();
        grid = cus * per_cu;
        if (grid <= 0) grid = 256;
    }
    if (grid < 0) return;
    Args a{};
    for (int i = 0; i < 25; ++i) a.in[i] = (const float*)d_in[i];
    a.out = (float*)d_out; a.ws = (unsigned char*)d_ws;
#if MK_MULTI
    for (int p = 0; p < DEPTH * NPH; ++p) { a.ph_lo = p; a.ph_hi = p + 1; hipLaunchKernelGGL(mega, dim3(grid), dim3(512), LDS_BYTES, stream, a); }
#else
    a.ph_lo = 0; a.ph_hi = DEPTH * NPH;
    (void)hipMemsetAsync((char*)d_ws + WS_BAR, 0, 16384, stream);
    void* args[] = {&a};
    hipError_t e = hipLaunchCooperativeKernel((const void*)mega, dim3(grid), dim3(512), args, LDS_BYTES, stream);
    if (e != hipSuccess) fprintf(stderr, "cooperative launch failed: %s (grid %d)\n", hipGetErrorString(e), grid);
#endif
}
```
